# Optimizing an MI355X kernel written in HIP

```python
import jax, jax.numpy as jnp
from jax import lax
import numpy as np


D_MODEL = 1024
BATCH = 2
SEQ = 8192
DEPTH = 2

GRID_W = 64
CTX_LEN = 256
N_Q_HEADS = 8
N_KV_HEADS = 2
HEAD_DIM = 128
ROPE_THETA = 10000.0
Q_BLOCK = 128
N_FOURIER_GROUPS = 4
FOURIER_GROUP_DIM = 128
N_SGU_GROUPS = 4
SGU_GROUP_DIM = 128
SGU_CHUNK = 128
N_BRANCHES = 3
N_EXPERTS = 32
TOP_K = 4
D_EXPERT = D_MODEL
SWIGLU_LIMIT = 7.0
SWIGLU_ALPHA = 1.702
EPS = 1e-6

Q_DIM = N_Q_HEADS * HEAD_DIM
KV_DIM = N_KV_HEADS * HEAD_DIM
F_DIM = N_FOURIER_GROUPS * FOURIER_GROUP_DIM
SGU_DIM = N_SGU_GROUPS * SGU_GROUP_DIM
Q_OFF = 0
K_OFF = Q_OFF + Q_DIM
F_OFF = K_OFF + 2 * KV_DIM
U_OFF = F_OFF + F_DIM
VG_OFF = U_OFF + SGU_DIM
G_OFF = VG_OFF + SGU_DIM
IN_DIM = G_OFF + N_BRANCHES * D_MODEL

kernel_name = 'hybrid_gqa_fnet_gmlp_moe_dit'


def _rmsnorm(t):
    tf = t.astype(jnp.float32)
    tf = tf * lax.rsqrt(jnp.mean(tf * tf, axis=-1, keepdims=True) + EPS)
    return tf.astype(t.dtype)


def _modulate(h, shift, scale):
    return h * (1 + scale) + shift


def _axial_rope_tables(row, col):
    n_freq = HEAD_DIM // 4
    inv_freq = 1.0 / (ROPE_THETA ** (jnp.arange(n_freq, dtype=jnp.float32) / n_freq))
    ang = jnp.stack([row[:, None] * inv_freq, col[:, None] * inv_freq], axis=1)
    return jnp.cos(ang), jnp.sin(ang)


def _rope(t, cos, sin):
    B, S, H, Dh = t.shape
    tf = t.astype(jnp.float32).reshape(B, S, H, 2, 2, Dh // 4)
    x1, x2 = tf[..., 0, :], tf[..., 1, :]
    cs, sn = cos[None, :, None], sin[None, :, None]
    out = jnp.stack([x1 * cs - x2 * sn, x2 * cs + x1 * sn], axis=-2)
    return out.reshape(B, S, H, Dh).astype(t.dtype)


def _keys_values(p_kv, k_gain):
    B, L, _ = p_kv.shape
    k = _rmsnorm(p_kv[..., :KV_DIM].reshape(B, L, N_KV_HEADS, HEAD_DIM)) * k_gain
    v = p_kv[..., KV_DIM:].reshape(B, L, N_KV_HEADS, HEAD_DIM)
    return k, v


def _block_attention(q, k_all, v_all):
    B, L = q.shape[:2]
    nb = L // Q_BLOCK
    groups = N_Q_HEADS // N_KV_HEADS
    qb = q.reshape(B, nb, Q_BLOCK, N_KV_HEADS, groups, HEAD_DIM).transpose(1, 0, 2, 3, 4, 5)
    scale = HEAD_DIM ** -0.5

    def one_block(qblk):
        s = jnp.einsum('bqhgd,bkhd->bhgqk', qblk, k_all).astype(jnp.float32) * scale
        p = jax.nn.softmax(s, axis=-1).astype(v_all.dtype)
        return jnp.einsum('bhgqk,bkhd->bqhgd', p, v_all)

    ob = lax.map(one_block, qb)
    return ob.transpose(1, 0, 2, 3, 4, 5).reshape(B, L, Q_DIM)


def _fourier_mix(f):
    B, L, _ = f.shape
    fg = f.astype(jnp.float32).reshape(B, L, N_FOURIER_GROUPS, FOURIER_GROUP_DIM)
    y = jnp.fft.fft2(fg, axes=(1, 3), norm='ortho').real
    return y.reshape(B, L, F_DIM).astype(f.dtype)


def _spatial_gating(u, v, gain, w_s, b_s):
    B, L, _ = u.shape
    u = jax.nn.gelu(u)
    v = _rmsnorm(jax.nn.gelu(v).reshape(B, L, N_SGU_GROUPS, SGU_GROUP_DIM)) * gain
    v = v.reshape(B, L // SGU_CHUNK, SGU_CHUNK, N_SGU_GROUPS, SGU_GROUP_DIM)
    v = jnp.einsum('gpq,bnqgc->bnpgc', w_s, v) + b_s.T[:, :, None]
    return u * v.reshape(B, L, SGU_DIM)


def _mixer_block(p, q, k_all, v_all, b_gate, sgu_gain, w_spatial, b_spatial, w_attn_o, w_fourier, w_sgu_o, w_out):
    B, L, _ = p.shape
    attn = _block_attention(q, k_all, v_all)
    four = _fourier_mix(p[..., F_OFF:U_OFF])
    sgu = _spatial_gating(p[..., U_OFF:VG_OFF], p[..., VG_OFF:G_OFF], sgu_gain, w_spatial, b_spatial)
    gates = jax.nn.sigmoid(p[..., G_OFF:].reshape(B, L, N_BRANCHES, D_MODEL) + b_gate)
    merged = (gates[..., 0, :] * (attn @ w_attn_o)
              + gates[..., 1, :] * (four @ w_fourier)
              + gates[..., 2, :] * (sgu @ w_sgu_o))
    return merged @ w_out


def _moe(t, w_r, b_r, w_gu, b_gu, w_dn, b_dn):
    logits = (t @ w_r + b_r).astype(jnp.float32)
    top_val, top_idx = lax.top_k(logits, TOP_K)
    wts = jax.nn.softmax(top_val, axis=-1)
    combine = jnp.einsum('nk,nke->ne', wts, jax.nn.one_hot(top_idx, N_EXPERTS, dtype=jnp.float32)).astype(t.dtype)
    out = jnp.zeros_like(t)
    for e in range(N_EXPERTS):
        gu = t @ w_gu[e] + b_gu[e]
        gate = jnp.minimum(gu[:, :D_EXPERT], SWIGLU_LIMIT)
        up = jnp.clip(gu[:, D_EXPERT:], -SWIGLU_LIMIT, SWIGLU_LIMIT)
        hidden = (up + 1) * gate * jax.nn.sigmoid(SWIGLU_ALPHA * gate)
        out = out + combine[:, e:e + 1] * (hidden @ w_dn[e] + b_dn[e])
    return out


def setup_inputs(seed: int = 0) -> dict:
    key = jax.random.key(seed)
    ks = jax.random.split(key, 24)
    f32 = jnp.float32
    D = D_MODEL

    def nrm(k, shape, scale):
        return jax.random.normal(k, shape, f32) * scale

    return {
        'x': nrm(ks[0], (BATCH, SEQ, D), 1.0),
        'c': nrm(ks[1], (BATCH, D), 1.0),
        'ctx': nrm(ks[2], (BATCH, CTX_LEN, D), 1.0),
        'c_ctx': nrm(ks[3], (D,), 1.0),
        'w_mod': nrm(ks[4], (DEPTH, D, 6 * D), 0.5 * D ** -0.5),
        'b_mod': nrm(ks[5], (DEPTH, 6 * D), 0.02),
        'w_in': nrm(ks[6], (DEPTH, D, IN_DIM), D ** -0.5),
        'b_gate': nrm(ks[7], (DEPTH, N_BRANCHES, D), 0.02),
        'q_gain': 1.0 + nrm(ks[8], (DEPTH, HEAD_DIM), 0.02),
        'k_gain': 1.0 + nrm(ks[9], (DEPTH, HEAD_DIM), 0.02),
        'w_attn_o': nrm(ks[10], (DEPTH, Q_DIM, D), Q_DIM ** -0.5),
        'w_fourier': nrm(ks[11], (DEPTH, F_DIM, D), F_DIM ** -0.5),
        'sgu_gain': 1.0 + nrm(ks[12], (DEPTH, N_SGU_GROUPS, SGU_GROUP_DIM), 0.02),
        'w_spatial': nrm(ks[13], (DEPTH, N_SGU_GROUPS, SGU_CHUNK, SGU_CHUNK), SGU_CHUNK ** -0.5),
        'b_spatial': 1.0 + nrm(ks[14], (DEPTH, N_SGU_GROUPS, SGU_CHUNK), 0.02),
        'w_sgu_o': nrm(ks[15], (DEPTH, SGU_DIM, D), SGU_DIM ** -0.5),
        'w_out': nrm(ks[16], (DEPTH, D, D), D ** -0.5),
        'w_router': nrm(ks[17], (DEPTH, D, N_EXPERTS), D ** -0.5),
        'b_router': nrm(ks[18], (DEPTH, N_EXPERTS), 0.01),
        'w_gate_up': nrm(ks[19], (DEPTH, N_EXPERTS, D, 2 * D_EXPERT), D ** -0.5),
        'b_gate_up': nrm(ks[20], (DEPTH, N_EXPERTS, 2 * D_EXPERT), 0.02),
        'w_down': nrm(ks[21], (DEPTH, N_EXPERTS, D_EXPERT, D), D_EXPERT ** -0.5),
        'b_down': nrm(ks[22], (DEPTH, N_EXPERTS, D), 0.02),
    }


def reference(x, c, ctx, c_ctx, w_mod, b_mod, w_in, b_gate, q_gain, k_gain, w_attn_o, w_fourier,
              sgu_gain, w_spatial, b_spatial, w_sgu_o, w_out, w_router, b_router, w_gate_up,
              b_gate_up, w_down, b_down):
    B, S, D = x.shape
    C = ctx.shape[1]
    rows = S // GRID_W
    row = jnp.repeat(jnp.arange(rows, dtype=jnp.float32), GRID_W)
    col = jnp.tile(jnp.arange(GRID_W, dtype=jnp.float32), rows)
    cos, sin = _axial_rope_tables(row, col)
    xc = ctx
    for l in range(DEPTH):
        last = l == DEPTH - 1
        mx = jax.nn.silu(c) @ w_mod[l] + b_mod[l]
        mc = jax.nn.silu(c_ctx) @ w_mod[l] + b_mod[l]
        sh1, sc1, g1, sh2, sc2, g2 = [m[:, None, :] for m in jnp.split(mx, 6, axis=-1)]
        sh1c, sc1c, g1c, sh2c, sc2c, g2c = jnp.split(mc, 6, axis=-1)

        hx = _modulate(_rmsnorm(x), sh1, sc1)
        hc = _modulate(_rmsnorm(xc), sh1c, sc1c)
        px = hx @ w_in[l]
        if last:
            pc_kv = hc @ w_in[l, :, K_OFF:F_OFF]
        else:
            pc = hc @ w_in[l]
            pc_kv = pc[..., K_OFF:F_OFF]
        kc, vc = _keys_values(pc_kv, k_gain[l])

        q = _rope(_rmsnorm(px[..., Q_OFF:K_OFF].reshape(B, S, N_Q_HEADS, HEAD_DIM)) * q_gain[l], cos, sin)
        k, v = _keys_values(px[..., K_OFF:F_OFF], k_gain[l])
        k = _rope(k, cos, sin)
        k_all = jnp.concatenate([k, kc], axis=1)
        v_all = jnp.concatenate([v, vc], axis=1)
        mix_x = _mixer_block(px, q, k_all, v_all, b_gate[l], sgu_gain[l], w_spatial[l], b_spatial[l],
                             w_attn_o[l], w_fourier[l], w_sgu_o[l], w_out[l])
        x = x + g1 * mix_x
        if not last:
            qc = _rmsnorm(pc[..., Q_OFF:K_OFF].reshape(B, C, N_Q_HEADS, HEAD_DIM)) * q_gain[l]
            mix_c = _mixer_block(pc, qc, kc, vc, b_gate[l], sgu_gain[l], w_spatial[l], b_spatial[l],
                                 w_attn_o[l], w_fourier[l], w_sgu_o[l], w_out[l])
            xc = xc + g1c * mix_c

        hx2 = _modulate(_rmsnorm(x), sh2, sc2).reshape(B * S, D)
        if last:
            y = _moe(hx2, w_router[l], b_router[l], w_gate_up[l], b_gate_up[l], w_down[l], b_down[l])
            x = x + g2 * y.reshape(B, S, D)
        else:
            hc2 = _modulate(_rmsnorm(xc), sh2c, sc2c).reshape(B * C, D)
            y = _moe(jnp.concatenate([hx2, hc2], axis=0), w_router[l], b_router[l], w_gate_up[l],
                     b_gate_up[l], w_down[l], b_down[l])
            x = x + g2 * y[:B * S].reshape(B, S, D)
            xc = xc + g2c * y[B * S:].reshape(B, C, D)
    return x
```

```cpp
#include <hip/hip_runtime.h>
#include <cstdio>
#include <cstdint>

#define LAS __attribute__((address_space(3)))
#define GAS __attribute__((address_space(1)))
typedef unsigned short bf16_t;
typedef short bf16x8 __attribute__((ext_vector_type(8)));
typedef int v8i __attribute__((ext_vector_type(8)));
typedef int v4i __attribute__((ext_vector_type(4)));
typedef short s16x4 __attribute__((ext_vector_type(4)));
typedef float f32x2 __attribute__((ext_vector_type(2)));
typedef float f32x4 __attribute__((ext_vector_type(4)));
typedef float f32x16 __attribute__((ext_vector_type(16)));
typedef unsigned u32x2 __attribute__((ext_vector_type(2)));
typedef unsigned u32x4 __attribute__((ext_vector_type(4)));

constexpr int DM = 1024, NB = 2, SEQ = 8192, CTX = 256, DEPTH = 2;
constexpr int NXR = NB * SEQ;
constexpr int NCR = NB * CTX;
constexpr int NROW = NXR + NCR;
constexpr int LK = SEQ + CTX;
constexpr int IN_DIM = 6144, Q_OFF = 0, K_OFF = 1024, V_OFF = 1280, F_OFF = 1536, U_OFF = 2048, VG_OFF = 2560, G_OFF = 3072;
constexpr int PXW = 3072;
constexpr int NEXP = 32, TOPK = 4;
constexpr int MAXT = 296;
constexpr int SROWS = MAXT * 256;
constexpr float EPS = 1e-6f;

constexpr size_t al256(size_t x) { return (x + 255) / 256 * 256; }
constexpr size_t WS_CTL = 0, CTL_BYTES = 1u << 20, CTL_ZERO_BYTES = 128u << 10;
constexpr size_t WS_MOD = WS_CTL + CTL_BYTES;
constexpr size_t WS_T1 = al256(WS_MOD + (size_t)DEPTH * 3 * 6144 * 4);
constexpr size_t WS_T2 = al256(WS_T1 + (size_t)64 * 256 * 128 * 4);
constexpr size_t WS_WSP = WS_T1 + (size_t)6 * 1024 * 1024;
constexpr size_t WS_ROPE = WS_T1 + (size_t)7 * 1024 * 1024;
constexpr size_t WS_TC = al256(WS_T2 + (size_t)128 * 128 * 4);
constexpr size_t WS_WIN = al256(WS_TC + (size_t)512 * 256 * 4);
constexpr size_t WS_WA = al256(WS_WIN + (size_t)DEPTH * IN_DIM * DM * 2);
constexpr size_t WS_WFP = al256(WS_WA + (size_t)DEPTH * DM * DM * 2);
constexpr size_t WS_WS = al256(WS_WFP + (size_t)DEPTH * DM * DM * 2);
constexpr size_t WS_WO = al256(WS_WS + (size_t)DEPTH * DM * DM * 2);
constexpr size_t WS_WGU = al256(WS_WO + (size_t)DEPTH * DM * DM * 2);
constexpr size_t WS_WDN = al256(WS_WGU + (size_t)DEPTH * NEXP * 2048 * DM);
constexpr size_t WS_XW = al256(WS_WDN + (size_t)DEPTH * NEXP * DM * DM);
constexpr size_t WS_HX = al256(WS_XW + (size_t)NROW * DM * 4);
constexpr size_t WS_PX = al256(WS_HX + (size_t)NROW * DM * 2);
constexpr size_t WS_GT = al256(WS_PX + (size_t)NROW * PXW * 2);
constexpr size_t WS_QN = al256(WS_GT + (size_t)NROW * 3072 * 2);
constexpr size_t WS_KN = al256(WS_QN + (size_t)NROW * DM * 2);
constexpr size_t WS_VN = al256(WS_KN + (size_t)NB * LK * 256 * 2);
constexpr size_t WS_VGN = al256(WS_VN + (size_t)NB * LK * 256 * 2);
constexpr size_t WS_Y1 = al256(WS_VGN + (size_t)NROW * 512 * 2);
constexpr size_t WS_FX = al256(WS_Y1 + (size_t)NB * 128 * 2 * 64 * 512 * 2);
constexpr size_t WS_ATT = al256(WS_FX + (size_t)NROW * DM * 2);
constexpr size_t WS_SG = al256(WS_ATT + (size_t)NROW * DM * 2);
constexpr size_t WS_PART = al256(WS_SG + (size_t)NROW * DM * 2);
constexpr size_t WS_MRG = al256(WS_PART + (size_t)NROW * DM * 4);
constexpr size_t WS_TSLOT = al256(WS_MRG + (size_t)NROW * DM * 2);
constexpr size_t WS_TW = al256(WS_TSLOT + (size_t)NROW * 4 * 4);
constexpr int CAPR = NROW;
constexpr size_t WS_WSLOT = al256(WS_TW + (size_t)NROW * 4 * 4);
constexpr size_t WS_HXS = al256(WS_WSLOT + (size_t)NEXP * CAPR * 4);
constexpr size_t WS_HID = al256(WS_HXS + (size_t)NEXP * CAPR * DM);
constexpr size_t WS_Y = al256(WS_HID + (size_t)SROWS * DM * 2);
constexpr size_t WS_HX8 = al256(WS_Y + (size_t)SROWS * DM * 2);
constexpr size_t WS_END = al256(WS_HX8 + (size_t)NROW * DM);
static_assert(WS_END < (size_t)2000 * 1024 * 1024, "workspace map beyond the guaranteed 4 x largest-input size");
constexpr int CW_BAR = 4096;
constexpr int CW_CNT = 8192;

constexpr int LDS_X_OFF = 131072;
constexpr int LDS_MISC_OFF = 143360;
constexpr int LDS_BYTES = 147456;

__device__ __forceinline__ unsigned cvt_pk_bf16(float lo, float hi) { unsigned r; asm volatile("v_cvt_pk_bf16_f32 %0, %1, %2" : "=v"(r) : "v"(lo), "v"(hi)); return r; }
__device__ __forceinline__ unsigned pk4_fp8(float a, float b, float c, float d) { int p = __builtin_amdgcn_cvt_pk_fp8_f32(a, b, 0, false); return (unsigned)__builtin_amdgcn_cvt_pk_fp8_f32(c, d, p, true); }
__device__ __forceinline__ unsigned pk4_fp8u(float a, float b, float c, float d) { int u; asm("" : "=v"(u) : "v"(a)); int p = __builtin_amdgcn_cvt_pk_fp8_f32(a, b, u, false); return (unsigned)__builtin_amdgcn_cvt_pk_fp8_f32(c, d, p, true); }
__device__ __forceinline__ float bf_lo(unsigned w) { return __uint_as_float(w << 16); }
__device__ __forceinline__ float bf_hi(unsigned w) { return __uint_as_float(w & 0xffff0000u); }
__device__ __forceinline__ float bf2f(bf16_t h) { return __uint_as_float(((unsigned)h) << 16); }
__device__ __forceinline__ int lane_id() { int l; asm volatile("v_mbcnt_lo_u32_b32 %0, -1, 0\n\tv_mbcnt_hi_u32_b32 %0, -1, %0" : "=v"(l)); return l; }
template <int M> __device__ __forceinline__ float sx(float v) {
    if constexpr (M < 32) return __int_as_float(__builtin_amdgcn_ds_swizzle(__float_as_int(v), (M << 10) | 0x1f));
    else { const auto rr = __builtin_amdgcn_permlane32_swap(__float_as_uint(v), __float_as_uint(v), false, false); return (lane_id() & 32) ? __uint_as_float(rr[0]) : __uint_as_float(rr[1]); }
}
__device__ __forceinline__ float wave_sum(float v) {
    v += sx<1>(v); v += sx<2>(v); v += sx<4>(v); v += sx<8>(v); v += sx<16>(v);
    const auto rr = __builtin_amdgcn_permlane32_swap(__float_as_uint(v), __float_as_uint(v), false, false); return __uint_as_float(rr[0]) + __uint_as_float(rr[1]);
}
__device__ __forceinline__ float sigmoidf_(float x) { return __builtin_amdgcn_rcpf(1.0f + __expf(-x)); }
__device__ __forceinline__ float gelu_tanh(float x) { const float z = 0.7978845608028654f * (x + 0.044715f * x * x * x); const float t = 1.0f - 2.0f * __builtin_amdgcn_rcpf(1.0f + __expf(2.0f * z)); return 0.5f * x * (1.0f + t); }

#define XB_TMO      128
#define XB_XCNT(j)  (256  + 64 * (j))
#define XB_XSUB(j)  (1280 + 64 * (j))
#define XB_XGEN(j)  (2304 + 64 * (j))
#define XB_TOP      3328
#define XB_TOPGEN   3392
#define XCD_BAR_WORDS 3456
#define XB_SPIN_CAP (1u << 20)
__device__ __forceinline__ unsigned xb_ld(unsigned* p)              { return __hip_atomic_load(p, __ATOMIC_RELAXED, __HIP_MEMORY_SCOPE_AGENT); }
__device__ __forceinline__ unsigned xb_add(unsigned* p, unsigned v) { return __hip_atomic_fetch_add(p, v, __ATOMIC_RELAXED, __HIP_MEMORY_SCOPE_AGENT); }
__device__ __forceinline__ unsigned xb_xcc_id() { return (unsigned)__builtin_amdgcn_s_getreg((3 << 11) | 20) & 0xFu; }
#define XB_SPIN(cond, bar) do { unsigned _sp = 0; while (cond) { __builtin_amdgcn_s_sleep(1); \
    if ((++_sp & 255u) == 0u) { if (xb_ld(&(bar)[XB_TMO])) break; if (_sp > XB_SPIN_CAP) { __hip_atomic_fetch_max(&(bar)[XB_TMO + 1], 100000u - b.seam, __ATOMIC_RELAXED, __HIP_MEMORY_SCOPE_AGENT); atomicAdd(&(bar)[XB_TMO], 1u); break; } } } } while (0)
struct XcdBarrier { unsigned* bar; unsigned x; volatile LAS unsigned* st; unsigned seam; int wave; };
__device__ __forceinline__ XcdBarrier xcd_barrier_post(unsigned* bar, volatile LAS unsigned* st) {
    XcdBarrier b; b.bar = bar; b.x = xb_xcc_id(); b.st = st; b.seam = 1u; b.wave = __builtin_amdgcn_readfirstlane((int)(threadIdx.x >> 6));
    if (threadIdx.x == 0) (void)xb_add(&bar[XB_XCNT(b.x)], 1u);
    return b;
}
__device__ __forceinline__ void xcd_barrier_complete(unsigned* bar, unsigned x, unsigned& nloc, unsigned& nx) {
    const unsigned G = gridDim.x * gridDim.y * gridDim.z;
    unsigned sum, cnt, mine, sp = 0u;
    for (;;) {
        sum = 0u; cnt = 0u;
#pragma nounroll
        for (unsigned j = 0; j < 16; ++j) { const unsigned c = xb_ld(&bar[XB_XCNT(j)]); sum += c; cnt += (c > 0u) ? 1u : 0u; }
        mine = xb_ld(&bar[XB_XCNT(x)]);
        if (sum == G) break;
        __builtin_amdgcn_s_sleep(1);
        if ((++sp & 255u) == 0u) { if (xb_ld(&bar[XB_TMO])) break; if (sp > XB_SPIN_CAP) { atomicAdd(&bar[XB_TMO], 1u); break; } }
    }
    nloc = mine > 0u ? mine : 1u; nx = cnt > 0u ? cnt : 1u;
}
__device__ __forceinline__ void xcd_barrier(const XcdBarrier& b) {
    asm volatile("s_waitcnt vmcnt(0)" ::: "memory");
    __syncthreads();
    if (b.wave == 0 && lane_id() == 0) {
        unsigned* bar = b.bar;
        __builtin_amdgcn_s_waitcnt(0);
        unsigned nloc = b.st[0], nx = b.st[1];
        if (nloc == 0u) { xcd_barrier_complete(bar, b.x, nloc, nx); b.st[0] = nloc; b.st[1] = nx; }
        const unsigned old = xb_add(&bar[XB_XSUB(b.x)], 1u);
        const unsigned gen = old / nloc;
        if (old + 1u == (gen + 1u) * nloc) {
            __builtin_amdgcn_fence(__ATOMIC_RELEASE, "agent");
            asm volatile("s_waitcnt vmcnt(0)" ::: "memory");
            const unsigned og = xb_add(&bar[XB_TOP], 1u);
            const unsigned tg = og / nx;
            if (og + 1u == (tg + 1u) * nx) xb_add(&bar[XB_TOPGEN], 1u);
            else XB_SPIN(xb_ld(&bar[XB_TOPGEN]) == tg, bar);
            __builtin_amdgcn_fence(__ATOMIC_ACQUIRE, "agent");
            xb_add(&bar[XB_XGEN(b.x)], 1u);
            asm volatile("s_waitcnt vmcnt(0)" ::: "memory");
        } else {
            XB_SPIN(xb_ld(&bar[XB_XGEN(b.x)]) == gen, bar);
            __builtin_amdgcn_fence(__ATOMIC_ACQUIRE, "agent");
            asm volatile("s_waitcnt vmcnt(0)" ::: "memory");
        }
    }
    __syncthreads();
}

namespace g8 {
constexpr int BM = 256, BK = 64, HALF = 128, HTB = HALF * BK * 2, STAGE_BYTES = 8 * HTB, NXCD = 8, WGM = 8;
__host__ __device__ __forceinline__ int lds_byte(int r, int c) { const int st = (r >> 4) * 2 + (c >> 5), rr = r & 15, cc = c & 31, ob = rr * 64 + cc * 2; return st * 1024 + (ob ^ (((ob >> 9) & 1) << 5)); }
__host__ __device__ __forceinline__ void stage_rc(int b, int& R, int& C) { const int st = b / 1024, sb = b % 1024, swz = sb ^ (((sb >> 9) & 1) << 5); R = (st >> 1) * 16 + swz / 64; C = (st & 1) * 32 + (swz % 64) / 2; }
__host__ __device__ __forceinline__ int perm32(int rho) { const int n = rho >> 4, i = rho & 15; return 8 * (i >> 2) + 4 * n + (i & 3); }

struct Unit { const char* A; const char* B; int nt; int pm, pn, aux; };
__host__ __device__ __forceinline__ int lds_byte8(int r, int cb) { const int st = (r >> 4) * 2 + (cb >> 6), ob = (r & 15) * 64 + (cb & 63); return st * 1024 + (ob ^ (((ob >> 9) & 1) << 5)); }

__device__ __forceinline__ void tile_order(int L, int nM, int nN, int& pm, int& pn) {
    const int nwg = nM * nN; int wgid = L; { const int q = nwg / NXCD, r = nwg % NXCD, xcd = wgid % NXCD, off = wgid / NXCD; wgid = (xcd < r ? xcd * (q + 1) : r * (q + 1) + (xcd - r) * q) + off; }
    const int nig = WGM * nN, gid = wgid / nig, fm = gid * WGM, gsz = (nM - fm) < WGM ? (nM - fm) : WGM;
    pm = fm + ((wgid % nig) % gsz); pn = (wgid % nig) / gsz;
}

template <class Epi, class Sched, bool FP8 = false, bool SP2 = false, bool ALIGN_EPI = false>
__device__ __forceinline__ void gemm_phase(LAS unsigned char* lds, const Sched& S, const Epi& E, int tid_in) {
    constexpr unsigned LD = FP8 ? 1024u : 2048u;
    int tid_ = tid_in; asm volatile("" : "+v"(tid_));
    const int tid = tid_, wid = __builtin_amdgcn_readfirstlane(tid >> 6), lane = tid & 63, wr = wid >> 2, wc = wid & 3, fr = lane & 15, fq = lane >> 4;
    int R0, C0; stage_rc(tid * 16, R0, C0);
    const int Rb0 = Epi::PERM ? ((R0 & ~31) + perm32(R0 & 31)) : R0;
    const unsigned c2 = (unsigned)C0 * 2u;
    const unsigned ldsw = (unsigned)wid * 1024u;
    const int aoff = FP8 ? lds_byte8(wr * 64 + fr, fq * 32) : lds_byte(wr * 64 + fr, fq * 8), boff = FP8 ? lds_byte8(wc * 32 + fr, fq * 32) : lds_byte(wc * 32 + fr, fq * 8);
#define G8_SA(b, h) (((b) * 2 + (h)) * HTB)
#define G8_SB(b, h) ((4 + (b) * 2 + (h)) * HTB)
#define G8_DMA(gp, off) __builtin_amdgcn_global_load_lds((const unsigned*)(gp), (LAS unsigned*)(lds + (off)), 16, 0, 0)
#define G8_STAGE(bufoff, base, v) do { const char* _p = (base); G8_DMA(_p + (v), (bufoff) + ldsw); G8_DMA(_p + (size_t)64 * LD + (v), (bufoff) + ldsw + 8192); } while (0)
#define G8_LDA(dst, b, h) do { if constexpr (FP8) { _Pragma("unroll") for (int m = 0; m < 4; ++m) { const v4i lo_ = *(const LAS v4i*)(lds + G8_SA(b, h) + aoff + m * 2048), hi_ = *(const LAS v4i*)(lds + G8_SA(b, h) + aoff + m * 2048 + 16); dst##8[m] = __builtin_shufflevector(lo_, hi_, 0, 1, 2, 3, 4, 5, 6, 7); } } \
        else { _Pragma("unroll") for (int m = 0; m < 4; ++m) _Pragma("unroll") for (int k = 0; k < 2; ++k) dst[m][k] = *(const LAS bf16x8*)(lds + G8_SA(b, h) + aoff + m * 2048 + k * 1024); } } while (0)
#define G8_LDB(dst, b, h) do { if constexpr (FP8) { _Pragma("unroll") for (int n = 0; n < 2; ++n) { const v4i lo_ = *(const LAS v4i*)(lds + G8_SB(b, h) + boff + n * 2048), hi_ = *(const LAS v4i*)(lds + G8_SB(b, h) + boff + n * 2048 + 16); dst##8[n] = __builtin_shufflevector(lo_, hi_, 0, 1, 2, 3, 4, 5, 6, 7); } } \
        else { _Pragma("unroll") for (int n = 0; n < 2; ++n) _Pragma("unroll") for (int k = 0; k < 2; ++k) dst[n][k] = *(const LAS bf16x8*)(lds + G8_SB(b, h) + boff + n * 2048 + k * 1024); } } while (0)
#define G8_MMA(ai, bj, At, Bt) do { __builtin_amdgcn_s_setprio(1); _Pragma("unroll") for (int m = 0; m < 4; ++m) _Pragma("unroll") for (int n = 0; n < 2; ++n) { \
        if constexpr (FP8) asm volatile("v_mfma_f32_16x16x128_f8f6f4 %0, %1, %2, %0" : "+v"(acc[ai][bj][m][n]) : "v"(Bt##8[n]), "v"(At##8[m]));   \
        else { _Pragma("unroll") for (int k = 0; k < 2; ++k) acc[ai][bj][m][n] = __builtin_amdgcn_mfma_f32_16x16x32_bf16(Bt[n][k], At[m][k], acc[ai][bj][m][n], 0, 0, 0); } } \
        __builtin_amdgcn_s_setprio(0); } while (0)
#define G8_WAIT_V(n) asm volatile("s_waitcnt vmcnt(" #n ")" ::: "memory")
#define G8_WAIT_L(n) asm volatile("s_waitcnt lgkmcnt(" #n ")" ::: "memory")
#define G8_BAR __builtin_amdgcn_s_barrier()
#define G8_SCHED __builtin_amdgcn_sched_barrier(0)
    Unit cur, nxt; int ui = 0;
    if (!S.next(0, cur)) return;
    f32x4 acc[2][2][4][2];
#pragma unroll
    for (int a = 0; a < 2; ++a)
#pragma unroll
        for (int b = 0; b < 2; ++b)
#pragma unroll
            for (int m = 0; m < 4; ++m)
#pragma unroll
                for (int n = 0; n < 2; ++n) acc[a][b][m][n] = (f32x4){0.f, 0.f, 0.f, 0.f};
    bf16x8 At[4][2], B0[2][2], B1[2][2]; v8i At8[4], B08[2], B18[2];
    const unsigned vA = (unsigned)R0 * LD + c2, vB = (unsigned)Rb0 * LD + c2;
    constexpr size_t hS = (size_t)HALF * LD;
    {
        if constexpr (SP2) {
            G8_STAGE(G8_SB(0, 0), cur.B, vB); G8_STAGE(G8_SB(0, 1), cur.B + hS, vB); G8_STAGE(G8_SA(0, 0), cur.A, vA); G8_STAGE(G8_SA(0, 1), cur.A + hS, vA);
            if (wr == 1) G8_BAR;
            G8_WAIT_V(2); G8_BAR;
        } else {
            G8_STAGE(G8_SB(0, 0), cur.B, vB); G8_STAGE(G8_SA(0, 0), cur.A, vA); G8_STAGE(G8_SB(0, 1), cur.B + hS, vB); G8_STAGE(G8_SA(0, 1), cur.A + hS, vA);
            if (wr == 1) G8_BAR;
            G8_WAIT_V(4); G8_BAR;
        }
        G8_STAGE(G8_SB(1, 0), cur.B + 128, vB); G8_STAGE(G8_SA(1, 0), cur.A + 128, vA); G8_STAGE(G8_SB(1, 1), cur.B + hS + 128, vB);
        G8_WAIT_V(6); G8_BAR;
    }
    for (;;) {
        const bool has_next = S.next(ui + 1, nxt);
        if (!has_next) nxt = cur;
        const int nt = cur.nt;
        for (int t = 0; t < nt; t += 2) {
            const bool last = (t == nt - 2);
            const char* a1 = cur.A + (size_t)(t + 1) * 128 + hS;
            const char* a2 = last ? nxt.A : cur.A + (size_t)(t + 2) * 128; const char* b2 = last ? nxt.B : cur.B + (size_t)(t + 2) * 128;
            if constexpr (Epi::NAUX > 0) { if (t == 0 && wid < Epi::NAUX) __builtin_amdgcn_global_load_lds((const unsigned*)(E.aux_src(cur, wid) + lane), (LAS unsigned*)(lds + STAGE_BYTES + (ui & 1) * 2048 + wid * 256), 4, 0, 0); }
            if constexpr (SP2) {
            G8_LDB(B0, 0, 0); G8_LDB(B1, 0, 1); G8_SCHED; G8_LDA(At, 0, 0); G8_STAGE(G8_SA(1, 1), a1, vA);
            G8_WAIT_V(8); G8_WAIT_L(0); G8_BAR; G8_MMA(0, 0, At, B0); G8_MMA(0, 1, At, B1); G8_BAR; G8_SCHED;
            G8_LDA(At, 0, 1); G8_STAGE(G8_SB(0, 0), b2, vB); G8_STAGE(G8_SB(0, 1), b2 + hS, vB); G8_STAGE(G8_SA(0, 0), a2, vA);
            G8_WAIT_V(8); G8_WAIT_L(0); G8_BAR; G8_MMA(1, 0, At, B0); G8_MMA(1, 1, At, B1); G8_BAR; G8_SCHED;
            G8_LDB(B0, 1, 0); G8_LDB(B1, 1, 1); G8_SCHED; G8_LDA(At, 1, 0); G8_STAGE(G8_SA(0, 1), a2 + hS, vA);
            G8_WAIT_V(8); G8_WAIT_L(0); G8_BAR; G8_MMA(0, 0, At, B0); G8_MMA(0, 1, At, B1); G8_BAR; G8_SCHED;
            G8_LDA(At, 1, 1); G8_STAGE(G8_SB(1, 0), b2 + 128, vB); G8_STAGE(G8_SB(1, 1), b2 + hS + 128, vB); G8_STAGE(G8_SA(1, 0), a2 + 128, vA);
            G8_WAIT_V(8); G8_WAIT_L(0); G8_BAR; G8_MMA(1, 0, At, B0); G8_MMA(1, 1, At, B1); G8_BAR; G8_SCHED;
            } else {
            G8_LDB(B0, 0, 0); G8_SCHED; G8_LDA(At, 0, 0); G8_STAGE(G8_SA(1, 1), a1, vA);
            G8_WAIT_L(8); G8_BAR; G8_WAIT_L(0); G8_MMA(0, 0, At, B0); G8_BAR; G8_SCHED;
            G8_LDB(B1, 0, 1); G8_STAGE(G8_SB(0, 0), b2, vB);
            G8_BAR; G8_WAIT_L(0); G8_MMA(0, 1, At, B1); G8_BAR;
            G8_LDA(At, 0, 1); G8_STAGE(G8_SA(0, 0), a2, vA);
            G8_BAR; G8_WAIT_L(0); G8_MMA(1, 0, At, B0); G8_BAR; G8_SCHED;
            G8_STAGE(G8_SB(0, 1), b2 + hS, vB);
            G8_WAIT_V(6); G8_BAR; G8_MMA(1, 1, At, B1); G8_BAR;
            G8_LDB(B0, 1, 0); G8_SCHED; G8_LDA(At, 1, 0); G8_STAGE(G8_SA(0, 1), a2 + hS, vA);
            G8_WAIT_L(8); G8_BAR; G8_WAIT_L(0); G8_MMA(0, 0, At, B0); G8_BAR; G8_SCHED;
            G8_LDB(B1, 1, 1); G8_STAGE(G8_SB(1, 0), b2 + 128, vB);
            G8_BAR; G8_WAIT_L(0); G8_MMA(0, 1, At, B1); G8_BAR;
            G8_LDA(At, 1, 1); G8_STAGE(G8_SA(1, 0), a2 + 128, vA);
            G8_BAR; G8_WAIT_L(0); G8_MMA(1, 0, At, B0); G8_BAR; G8_SCHED;
            G8_STAGE(G8_SB(1, 1), b2 + hS + 128, vB);
            G8_WAIT_V(6); G8_BAR; G8_MMA(1, 1, At, B1); G8_BAR;
            }
        }
        if constexpr (ALIGN_EPI) { if (wr == 0) G8_BAR; }
        if constexpr (FP8) asm volatile("s_nop 7\n\ts_nop 7\n\ts_nop 7" ::: "memory");
        const bool keep = E(acc, cur, wr, wc, fr, fq, (const LAS float*)(lds + STAGE_BYTES + (ui & 1) * 2048));
        if (!has_next) break;
        if (!keep)
#pragma unroll
        for (int a = 0; a < 2; ++a)
#pragma unroll
            for (int b = 0; b < 2; ++b)
#pragma unroll
                for (int m = 0; m < 4; ++m)
#pragma unroll
                    for (int n = 0; n < 2; ++n) acc[a][b][m][n] = (f32x4){0.f, 0.f, 0.f, 0.f};
        cur = nxt; ++ui;
        if constexpr (ALIGN_EPI) { if (wr == 1) G8_BAR; }
    }
    G8_WAIT_V(0);
    if constexpr (!ALIGN_EPI) { if (wr == 0) G8_BAR; }
    G8_BAR;
#undef G8_SA
#undef G8_SB
#undef G8_DMA
#undef G8_STAGE
#undef G8_LDA
#undef G8_LDB
#undef G8_MMA
#undef G8_WAIT_V
#undef G8_WAIT_L
#undef G8_BAR
#undef G8_SCHED
}
}

namespace att {
constexpr int D = 128, NW = 8, QBLK = 32, KVBLK = 64;
constexpr float SCALE = 0.088388347648318440f;
constexpr float THR = 5.f;
constexpr int LDQ = 1024, LDK = 256, LDO = 1024;
constexpr size_t SHM_V = KVBLK * D  , SHM_K = KVBLK * D  , NBUF = 3, SHM_ATTN = NBUF * SHM_V + NBUF * SHM_K + NW * 64 * 4 + 48;
#define KSWZ(row, colB) ((row) * 256 + ((colB) ^ (((row) & 7) << 4)))
#define SBAR() __builtin_amdgcn_sched_barrier(0)
#define PIN(a, b) asm volatile("" : "+v"(a), "+v"(b))
__device__ __forceinline__ int crow(int r, int hi) { return (r & 3) + 8 * (r >> 2) + 4 * hi; }
template <bool SC, class RowFn>
__device__ __forceinline__ void wave_rows_out(LAS unsigned char* st, const f32x16* o, const float (&sc)[16], int lane, RowFn fn) {
  const int r32 = lane & 31, hi = lane >> 5; const bool odd = (lane & 1) != 0;
  LAS unsigned char* wp = st + (odd ? (32 + r32 - 1) * 2 : r32 * 2);
#pragma unroll
  for (int r = 0; r < 16; ++r) {
#pragma unroll
    for (int dp = 0; dp < 4; dp += 2) {
      const float s = SC ? sc[r] : 1.f; const float a = o[dp][r] * s, b = o[dp + 1][r] * s; const float recv = sx<1>(odd ? a : b);
      *(LAS unsigned*)(wp + crow(r, hi) * 256 + dp * 64) = cvt_pk_bf16(odd ? recv : a, odd ? b : recv); } }
  asm volatile("s_waitcnt lgkmcnt(0)" ::: "memory");
  const LAS unsigned char* rp = st + (lane >> 4) * 256 + (lane & 15) * 16;
#pragma unroll
  for (int i = 0; i < 8; ++i) fn(4 * i + (lane >> 4), (lane & 15) * 8, *(const LAS u32x4*)(rp + i * 1024));
}
template <class RowFn>
__device__ __forceinline__ void wave_rows_out_i(LAS unsigned char* st, const f32x16* o, int lane, RowFn fn) {
  const int r32 = lane & 31, hi = lane >> 5; const bool odd = (lane & 1) != 0;
  LAS unsigned char* wp = st + (odd ? (32 + r32 - 1) * 2 : r32 * 2);
#pragma unroll
  for (int r = 0; r < 16; ++r) {
#pragma unroll
    for (int dp = 0; dp < 4; dp += 2) {
      const float a = o[dp][r], b = o[dp + 1][r]; const float recv = sx<1>(odd ? a : b);
      *(LAS unsigned*)(wp + crow(r, hi) * 256 + dp * 64) = cvt_pk_bf16(odd ? recv : a, odd ? b : recv); } }
  asm volatile("s_waitcnt lgkmcnt(0)" ::: "memory");
  const LAS unsigned char* rp = st + (lane >> 4) * 256 + (lane & 15) * 16;
#pragma unroll
  for (int i = 0; i < 8; ++i) fn(i, 4 * i + (lane >> 4), (lane & 15) * 8, *(const LAS u32x4*)(rp + i * 1024));
}
__device__ __forceinline__ void partial0(f32x16& p0, f32x16& p1, float& M) {
  float pmax = p0[0]; for (int r = 1; r < 16; ++r) pmax = fmaxf(pmax, p0[r]); for (int r = 0; r < 16; ++r) pmax = fmaxf(pmax, p1[r]);
  { auto rr = __builtin_amdgcn_permlane32_swap(__float_as_uint(pmax), __float_as_uint(pmax), false, false);
    pmax = fmaxf(__uint_as_float(rr[0]), __uint_as_float(rr[1])); }
  M = pmax;
  for (int r = 0; r < 16; ++r) { p0[r] -= M; p1[r] -= M; }
}
template <bool EXP0 = true>
__device__ __forceinline__ void partialSM(f32x16& p0, f32x16& p1, float& m_reg, float& mn, float& alpha) {
  constexpr float C = SCALE * 1.4426950408889634f;
  float pmax = p0[0]; for (int r = 1; r < 16; ++r) pmax = fmaxf(pmax, p0[r]); for (int r = 0; r < 16; ++r) pmax = fmaxf(pmax, p1[r]);
  { auto rr = __builtin_amdgcn_permlane32_swap(__float_as_uint(pmax), __float_as_uint(pmax), false, false);
    pmax = fmaxf(__uint_as_float(rr[0]), __uint_as_float(rr[1])); }
  if (__builtin_expect(__all(pmax - m_reg <= THR / SCALE), 1)) { mn = m_reg; alpha = 1.f; }
  else { mn = fmaxf(m_reg, pmax); alpha = __builtin_amdgcn_exp2f((m_reg - mn) * C); m_reg = mn; }
  float mnC = -mn * C;
  for (int r = 0; r < 16; ++r) p0[r] = fmaf(p0[r], C, mnC); for (int r = 0; r < 16; ++r) p1[r] = fmaf(p1[r], C, mnC);
  if (EXP0) { for (int r = 0; r < 16; ++r) p0[r] = __builtin_amdgcn_exp2f(p0[r]); }
}
__device__ __forceinline__ void finishSM(f32x16& p0, f32x16& p1, float alpha, float& l_reg, bf16x8& pa0, bf16x8& pa1, bf16x8& pa2, bf16x8& pa3) {
  for (int r = 0; r < 16; ++r) p1[r] = __builtin_amdgcn_exp2f(p1[r]);
  float ps = 0; for (int r = 0; r < 16; ++r) ps += p0[r]; for (int r = 0; r < 16; ++r) ps += p1[r];
  { auto rr = __builtin_amdgcn_permlane32_swap(__float_as_uint(ps), __float_as_uint(ps), false, false);
    ps = __uint_as_float(rr[0]) + __uint_as_float(rr[1]); }
  l_reg = l_reg * alpha + ps;
#define PK4(P, BASE, OUT) do { unsigned a0 = cvt_pk_bf16(P[BASE + 0], P[BASE + 1]), a1 = cvt_pk_bf16(P[BASE + 2], P[BASE + 3]);   \
    unsigned b0 = cvt_pk_bf16(P[BASE + 4], P[BASE + 5]), b1 = cvt_pk_bf16(P[BASE + 6], P[BASE + 7]);                              \
    auto r0 = __builtin_amdgcn_permlane32_swap(a0, b0, false, false); auto r1 = __builtin_amdgcn_permlane32_swap(a1, b1, false, false); \
    u32x4 w = {r0[0], r1[0], r0[1], r1[1]}; OUT = *reinterpret_cast<bf16x8*>(&w); } while (0)
  PK4(p0, 0, pa0); PK4(p0, 8, pa1); PK4(p1, 0, pa2); PK4(p1, 8, pa3);
#undef PK4
}
#define KSWZ8(row, cb) ((row) * 128 + ((cb) ^ ((((row) >> 1) & 7) << 4)))
__device__ __forceinline__ void qkt8(f32x16& p0, f32x16& p1, const char* Ks, const v8i (&qr)[2], int r32, int hi) {
  v8i kf[2][2];
#pragma unroll
  for (int kb = 0; kb < 2; ++kb)
#pragma unroll
    for (int t = 0; t < 2; ++t) { const int row = 32 * kb + r32, cb = 64 * t + 32 * hi;
      const v4i lo = *reinterpret_cast<const v4i*>(Ks + KSWZ8(row, cb)), hh = *reinterpret_cast<const v4i*>(Ks + KSWZ8(row, cb + 16));
      kf[kb][t] = __builtin_shufflevector(lo, hh, 0, 1, 2, 3, 4, 5, 6, 7); }
  asm volatile("v_mfma_f32_32x32x64_f8f6f4 %0, %1, %2, 0" : "=&v"(p0) : "v"(kf[0][0]), "v"(qr[0]));
  asm volatile("v_mfma_f32_32x32x64_f8f6f4 %0, %1, %2, 0" : "=&v"(p1) : "v"(kf[1][0]), "v"(qr[0]));
  asm volatile("v_mfma_f32_32x32x64_f8f6f4 %0, %1, %2, %0" : "+v"(p0) : "v"(kf[0][1]), "v"(qr[1]));
  asm volatile("v_mfma_f32_32x32x64_f8f6f4 %0, %1, %2, %0" : "+v"(p1) : "v"(kf[1][1]), "v"(qr[1]));
  asm volatile("s_nop 7\n\ts_nop 7\n\ts_nop 7" ::: "memory");
}
__device__ __forceinline__ int v_st(int k, int c) { const int kk = (k & ~0xC) | ((k & 4) << 1) | ((k & 8) >> 1); return ((kk >> 3) * 4 + (c >> 5)) * 512 + ((kk & 7) * 32 + (c & 31)) * 2; }
__device__ __forceinline__ int v_rd_base(int lane) { return ((lane & 3) << 3) | (((lane >> 2) & 3) << 6) | (((lane >> 4) & 1) << 5) | (((lane >> 5) & 1) << 8); }
constexpr int v_rd_off(int d0, int ks, int half) { return d0 * 512 + ks * 4096 + half * 2048; }
template <int OFF> __device__ __forceinline__ s16x4 tr_read(int vb) {
  s16x4 r; asm volatile("ds_read_b64_tr_b16 %0, %1 offset:%2" : "=&v"(r) : "v"(vb), "i"(OFF) : "memory"); return r;
}
template <int D0> __device__ __forceinline__ void pv_one(f32x16& od, int vb, bf16x8 pa0, bf16x8 pa1, bf16x8 pa2, bf16x8 pa3) {
  const s16x4 l0 = tr_read<v_rd_off(D0, 0, 0)>(vb), h0 = tr_read<v_rd_off(D0, 0, 1)>(vb), l1 = tr_read<v_rd_off(D0, 1, 0)>(vb), h1 = tr_read<v_rd_off(D0, 1, 1)>(vb);
  const s16x4 l2 = tr_read<v_rd_off(D0, 2, 0)>(vb), h2 = tr_read<v_rd_off(D0, 2, 1)>(vb), l3 = tr_read<v_rd_off(D0, 3, 0)>(vb), h3 = tr_read<v_rd_off(D0, 3, 1)>(vb);
  asm volatile("s_waitcnt lgkmcnt(0)" ::: "memory"); SBAR();
#define PK(L, H) (bf16x8){L[0], L[1], L[2], L[3], H[0], H[1], H[2], H[3]}
  od = __builtin_amdgcn_mfma_f32_32x32x16_bf16(pa0, PK(l0, h0), od, 0, 0, 0);
  od = __builtin_amdgcn_mfma_f32_32x32x16_bf16(pa1, PK(l1, h1), od, 0, 0, 0);
  od = __builtin_amdgcn_mfma_f32_32x32x16_bf16(pa2, PK(l2, h2), od, 0, 0, 0);
  od = __builtin_amdgcn_mfma_f32_32x32x16_bf16(pa3, PK(l3, h3), od, 0, 0, 0);
#undef PK
}
__device__ __forceinline__ void pv_d0(f32x16* o, int vb, bf16x8 pa0, bf16x8 pa1, bf16x8 pa2, bf16x8 pa3) {
  pv_one<0>(o[0], vb, pa0, pa1, pa2, pa3); pv_one<1>(o[1], vb, pa0, pa1, pa2, pa3); pv_one<2>(o[2], vb, pa0, pa1, pa2, pa3); pv_one<3>(o[3], vb, pa0, pa1, pa2, pa3);
}
__device__ __forceinline__ void finish8(f32x16& p0, f32x16& p1, v8i& P8) {
  for (int r = 0; r < 16; ++r) p0[r] = __builtin_amdgcn_exp2f(p0[r]); for (int r = 0; r < 16; ++r) p1[r] = __builtin_amdgcn_exp2f(p1[r]);
#pragma unroll
  for (int w = 0; w < 4; ++w) { P8[w] = (int)pk4_fp8(p0[4 * w], p0[4 * w + 1], p0[4 * w + 2], p0[4 * w + 3]); P8[4 + w] = (int)pk4_fp8(p1[4 * w], p1[4 * w + 1], p1[4 * w + 2], p1[4 * w + 3]); }
}
__device__ __forceinline__ void pv8(f32x16* o, const char* Vs, int off0, int off1, const v8i& P8, const char* ones_lds) {
  v8i vf[4];
#pragma unroll
  for (int d0 = 0; d0 < 4; ++d0) { const v4i lo = *reinterpret_cast<const v4i*>(Vs + d0 * 2048 + off0), hh = *reinterpret_cast<const v4i*>(Vs + d0 * 2048 + off1);
    vf[d0] = __builtin_shufflevector(lo, hh, 0, 1, 2, 3, 4, 5, 6, 7); }
  asm volatile("s_nop 4\n\tv_mfma_f32_32x32x64_f8f6f4 %0, %1, %2, %0" : "+v"(o[0]) : "v"(P8), "v"(vf[0]));
  asm volatile("v_mfma_f32_32x32x64_f8f6f4 %0, %1, %2, %0" : "+v"(o[1]) : "v"(P8), "v"(vf[1]));
  asm volatile("v_mfma_f32_32x32x64_f8f6f4 %0, %1, %2, %0" : "+v"(o[2]) : "v"(P8), "v"(vf[2]));
  asm volatile("v_mfma_f32_32x32x64_f8f6f4 %0, %1, %2, %0" : "+v"(o[3]) : "v"(P8), "v"(vf[3]));
  { const v8i ones = *reinterpret_cast<const v8i*>(ones_lds);
  asm volatile("v_mfma_f32_32x32x64_f8f6f4 %0, %1, %2, %0" : "+v"(o[4]) : "v"(P8), "v"(ones)); }
}
#define MFMA8(ACC, A, B) asm volatile("v_mfma_f32_32x32x64_f8f6f4 %0, %1, %2, %0" : "+v"(ACC) : "v"(A), "v"(B))
#define KEEP(x) asm volatile("" :: "v"(x))
#define MFMA8Z(ACC, A, B) asm volatile("v_mfma_f32_32x32x64_f8f6f4 %0, %1, %2, 0" : "=&v"(ACC) : "v"(A), "v"(B))
__device__ __forceinline__ float amax3(float a, float b, float c) { float d; asm("v_max3_f32 %0, %1, %2, %3" : "=v"(d) : "v"(a), "v"(b), "v"(c)); return d; }
constexpr float THR2 = THR * 1.4426950408889634f;
typedef short s16x8 __attribute__((ext_vector_type(8)));
#define MFMA16Z(ACC, A, B) asm volatile("v_mfma_f32_32x32x16_bf16 %0, %1, %2, 0" : "=&v"(ACC) : "v"(A), "v"(B))
__device__ __forceinline__ void set_mf(u32x4& mf, float M, int hi) {
  const float n = -M; const unsigned b0 = __float_as_uint(n) & 0xFFFF0000u; const float r1 = n - __uint_as_float(b0);
  const unsigned b1 = __float_as_uint(r1) & 0xFFFF0000u; const float r2 = r1 - __uint_as_float(b1); const unsigned b2 = __float_as_uint(r2) & 0xFFFF0000u;
  mf.x = hi ? 0u : ((b0 >> 16) | b1); mf.y = hi ? 0u : (b2 >> 16); mf.z = 0u; mf.w = 0u;
}
__device__ __forceinline__ void qk_fin8(f32x16& q0, f32x16& q1, const char* Ks, const v8i (&qr)[2], int r32, int hi, f32x16& p0, f32x16& p1, v8i& P8, const u32x4& mf, const char* one16_lds) {
  v8i kf[2][2];
  const u32x4 one16 = *reinterpret_cast<const u32x4*>(one16_lds);
#pragma unroll
  for (int kb = 0; kb < 2; ++kb)
#pragma unroll
    for (int t = 0; t < 2; ++t) { const int row = 32 * kb + r32, cb = 64 * t + 32 * hi;
      const v4i lo = *reinterpret_cast<const v4i*>(Ks + KSWZ8(row, cb)), hh = *reinterpret_cast<const v4i*>(Ks + KSWZ8(row, cb + 16));
      kf[kb][t] = __builtin_shufflevector(lo, hh, 0, 1, 2, 3, 4, 5, 6, 7); }
  SBAR(); MFMA16Z(q0, one16, mf); MFMA16Z(q1, one16, mf); SBAR();
#pragma unroll
  for (int r = 0; r < 8; ++r) p0[r] = __builtin_amdgcn_exp2f(p0[r]);
  SBAR(); MFMA8(q0, kf[0][0], qr[0]); KEEP(one16); SBAR();
#pragma unroll
  for (int r = 8; r < 16; ++r) p0[r] = __builtin_amdgcn_exp2f(p0[r]);
  SBAR(); MFMA8(q1, kf[1][0], qr[0]); KEEP(kf[0][0]); SBAR();
#pragma unroll
  for (int r = 0; r < 8; ++r) p1[r] = __builtin_amdgcn_exp2f(p1[r]);
  SBAR(); MFMA8(q0, kf[0][1], qr[1]); KEEP(kf[1][0]); SBAR();
#pragma unroll
  for (int r = 8; r < 16; ++r) p1[r] = __builtin_amdgcn_exp2f(p1[r]);
  SBAR(); MFMA8(q1, kf[1][1], qr[1]); KEEP(kf[0][1]); SBAR();
#pragma unroll
  for (int w = 0; w < 4; ++w) { P8[w] = (int)pk4_fp8u(p0[4 * w], p0[4 * w + 1], p0[4 * w + 2], p0[4 * w + 3]); P8[4 + w] = (int)pk4_fp8u(p1[4 * w], p1[4 * w + 1], p1[4 * w + 2], p1[4 * w + 3]); }
  KEEP(kf[1][1]);
  SBAR();
}
__device__ __forceinline__ void pv_sm8(f32x16* o, const char* Vs, int off0, int off1, const v8i& P8, const char* ones_lds, f32x16& p0, f32x16& p1, float& M, u32x4& mf, float* al_l, int r32, int hi) {
  v8i vf[4];
  const v8i ones = *reinterpret_cast<const v8i*>(ones_lds);
#pragma unroll
  for (int d0 = 0; d0 < 4; ++d0) { const v4i lo = *reinterpret_cast<const v4i*>(Vs + d0 * 2048 + off0), hh = *reinterpret_cast<const v4i*>(Vs + d0 * 2048 + off1);
    vf[d0] = __builtin_shufflevector(lo, hh, 0, 1, 2, 3, 4, 5, 6, 7); }
  SBAR(); MFMA8(o[0], P8, vf[0]); SBAR();
  const float t0 = amax3(p0[0], p0[1], p0[2]), t1 = amax3(p0[3], p0[4], p0[5]), t2 = amax3(p0[6], p0[7], p0[8]), t3 = amax3(p0[9], p0[10], p0[11]), t4 = amax3(p0[12], p0[13], p0[14]);
  SBAR(); MFMA8(o[1], P8, vf[1]); KEEP(vf[0]); SBAR();
  const float u0 = amax3(p1[0], p1[1], p1[2]), u1 = amax3(p1[3], p1[4], p1[5]), u2 = amax3(p1[6], p1[7], p1[8]), u3 = amax3(p1[9], p1[10], p1[11]), u4 = amax3(p1[12], p1[13], p1[14]);
  SBAR(); MFMA8(o[2], P8, vf[2]); KEEP(vf[1]); SBAR();
  float pm = amax3(amax3(amax3(t0, t1, t2), amax3(t3, t4, p0[15]), amax3(u0, u1, u2)), amax3(u3, u4, p1[15]), 0.f);
  { auto rr = __builtin_amdgcn_permlane32_swap(__float_as_uint(pm), __float_as_uint(pm), false, false);
    pm = amax3(__uint_as_float(rr[0]), __uint_as_float(rr[1]), 0.f); }
  SBAR(); MFMA8(o[3], P8, vf[3]); KEEP(vf[2]); SBAR();
  MFMA8(o[4], P8, ones); KEEP(vf[3]); SBAR();
  const bool moved = !__all(pm <= THR2);
  KEEP(ones);
  if (__builtin_expect(moved, 0)) {
    const float d = pm, alpha = __builtin_amdgcn_exp2f(-d);
    M += d; set_mf(mf, M, hi);
#pragma unroll
    for (int r = 0; r < 16; ++r) { p0[r] -= d; p1[r] -= d; }
    asm volatile("s_nop 7\n\ts_nop 7\n\ts_nop 7" ::: "memory");
    if (hi == 0) al_l[r32] = alpha; asm volatile("s_waitcnt lgkmcnt(0)" ::: "memory");
    for (int dd = 0; dd < 5; ++dd) for (int r = 0; r < 16; ++r) o[dd][r] *= al_l[crow(r, hi)];
  }
}
__device__ __forceinline__ void attn_dense_body(const unsigned char* __restrict__ Qb, const unsigned char* __restrict__ Kh, const unsigned char* __restrict__ Vt,
                                                bf16_t* __restrict__ Ob, int seq, char* lds, int tid_in) {
  int tid_ = tid_in; asm volatile("" : "+v"(tid_));
  const int tid = tid_, wid = tid >> 6, lane = tid & 63, r32 = lane & 31, hi = lane >> 5;
  char* V_lds = lds; char* K_lds = lds + NBUF * SHM_V;
  float* ws = (float*)(lds + NBUF * SHM_V + NBUF * SHM_K) + wid * 64; float* al_l = ws + 32;
  float M; u32x4 mf; f32x16 o[5] = {}; v8i qr[2];
  const char* ones = lds + NBUF * SHM_V + NBUF * SHM_K + NW * 64 * 4;
  const char* one16 = ones + 32;
  if (tid < 12) ((int*)ones)[tid] = tid < 8 ? 0x38383838 : 0x3F803F80;
  const unsigned char* Qw = Qb + (long)(wid * QBLK + r32) * LDQ + hi * 32;
#pragma unroll
  for (int t = 0; t < 2; ++t) qr[t] = *reinterpret_cast<const v8i*>(Qw + t * 64);
  const int kkey = tid >> 3, kpc = (tid & 7) * 16, kst = KSWZ8(kkey, kpc);
  const int vd = tid >> 2, vst = vd * 64 + (((tid & 3) ^ ((vd >> 2) & 3)) << 4);
  const int vsw = (r32 >> 2) & 3, voff0 = r32 * 64 + (((2 * hi) ^ vsw) << 4), voff1 = r32 * 64 + (((2 * hi + 1) ^ vsw) << 4);
  struct { u32x4 vs0, ks0; } sr_;
  const __amdgpu_buffer_rsrc_t rV = __builtin_amdgcn_make_buffer_rsrc((void*)Vt, (short)0, 0x7fffffff, 0x00020000), rK = __builtin_amdgcn_make_buffer_rsrc((void*)Kh, (short)0, 0x7fffffff, 0x00020000);
  const unsigned vlo = (unsigned)tid * 16u, klo = (unsigned)(kkey * LDK + kpc);
#define SLOAD(k0) do { sr_.vs0 = __builtin_bit_cast(u32x4, __builtin_amdgcn_raw_buffer_load_b128(rV, vlo, (unsigned)(((k0) / KVBLK) * 8192), 0)); \
    sr_.ks0 = __builtin_bit_cast(u32x4, __builtin_amdgcn_raw_buffer_load_b128(rK, klo, (unsigned)((k0) * LDK), 0)); } while (0)
#define SWRITE(b) do { *(u32x4*)(V_lds + (b) * SHM_V + vst) = sr_.vs0; *(u32x4*)(K_lds + (b) * SHM_K + kst) = sr_.ks0; } while (0)
#define SWAIT() asm volatile("s_waitcnt vmcnt(0)" ::: "memory")
  f32x16 pA0, pA1, pB0, pB1; v8i P8; const int NT = seq / KVBLK;
  SLOAD(0); SWAIT(); SWRITE(0); SLOAD(KVBLK); __syncthreads();
  qkt8(pA0, pA1, (const char*)K_lds, qr, r32, hi); partial0(pA0, pA1, M); set_mf(mf, M, hi);
  SWAIT(); SWRITE(1); if (2 < NT) SLOAD(2 * KVBLK); __syncthreads();
  int bt = 1;
#define NXB(b) ((b) == 2 ? 0 : (b) + 1)
  int j = 1;
#define ABLK(Q0, Q1, P0, P1, KB, WB, VB, LT) do { SBAR(); qk_fin8(Q0, Q1, (const char*)K_lds + (KB) * SHM_K, qr, r32, hi, P0, P1, P8, mf, one16); \
    SWAIT(); SWRITE(WB); SLOAD((LT) * KVBLK); SBAR(); pv_sm8(o, V_lds + (VB) * SHM_V, voff0, voff1, P8, ones, Q0, Q1, M, mf, al_l, r32, hi); __syncthreads(); } while (0)
  for (; j + 7 < NT; j += 6) {
    ABLK(pB0, pB1, pA0, pA1, 1, 2, 0, j + 2); ABLK(pA0, pA1, pB0, pB1, 2, 0, 1, j + 3);
    ABLK(pB0, pB1, pA0, pA1, 0, 1, 2, j + 4); ABLK(pA0, pA1, pB0, pB1, 1, 2, 0, j + 5);
    ABLK(pB0, pB1, pA0, pA1, 2, 0, 1, j + 6); ABLK(pA0, pA1, pB0, pB1, 0, 1, 2, j + 7);
  }
#undef ABLK
  for (; j + 1 < NT; j += 2) {
    const int bp = NXB(NXB(bt)), bn = NXB(bt);
    SBAR(); qk_fin8(pB0, pB1, (const char*)K_lds + bt * SHM_K, qr, r32, hi, pA0, pA1, P8, mf, one16);
    SWAIT(); SWRITE(bn); SLOAD((j + 2) * KVBLK); SBAR();
    pv_sm8(o, V_lds + bp * SHM_V, voff0, voff1, P8, ones, pB0, pB1, M, mf, al_l, r32, hi);
    __syncthreads();
    SBAR(); qk_fin8(pA0, pA1, (const char*)K_lds + bn * SHM_K, qr, r32, hi, pB0, pB1, P8, mf, one16);
    SWAIT(); SWRITE(bp); if (j + 3 < NT) SLOAD((j + 3) * KVBLK); SBAR();
    pv_sm8(o, V_lds + bt * SHM_V, voff0, voff1, P8, ones, pA0, pA1, M, mf, al_l, r32, hi);
    __syncthreads();
    bt = bp;
  }
  { const int bp = NXB(NXB(bt));
  SBAR(); qk_fin8(pB0, pB1, (const char*)K_lds + bt * SHM_K, qr, r32, hi, pA0, pA1, P8, mf, one16);
  pv_sm8(o, V_lds + bp * SHM_V, voff0, voff1, P8, ones, pB0, pB1, M, mf, al_l, r32, hi);
  finish8(pB0, pB1, P8); SBAR();
  pv8(o, V_lds + bt * SHM_V, voff0, voff1, P8, ones);
  asm volatile("s_nop 7\n\ts_nop 7\n\ts_nop 7" : "+v"(o[0]), "+v"(o[1]), "+v"(o[2]), "+v"(o[3]), "+v"(o[4]) :: "memory"); }
#undef NXB
  float rli[16];
#pragma unroll
  for (int r = 0; r < 16; ++r) rli[r] = __builtin_amdgcn_rcpf(o[4][r]);
  bf16_t* Ow = Ob + (long)(wid * QBLK) * LDO;
  wave_rows_out<true>((LAS unsigned char*)lds + 65536 + wid * 8192, o, rli, lane, [&](int row, int col8, u32x4 v) { *(u32x4*)(Ow + (long)row * LDO + col8) = v; });
  __syncthreads();
#undef SLOAD
#undef SWRITE
#undef SWAIT
}
#undef KSWZ
#undef KSWZ8
#undef SBAR
}

struct KArgs { const float* in[23]; float* out; unsigned char* ws; };
enum { I_X = 0, I_C, I_CTX, I_CCTX, I_WMOD, I_BMOD, I_WIN, I_BGATE, I_QGAIN, I_KGAIN, I_WAO, I_WFOUR, I_SGUGAIN, I_WSPAT, I_BSPAT, I_WSGUO, I_WOUT, I_WROUTER, I_BROUTER, I_WGU, I_BGU, I_WDN, I_BDN };

typedef __attribute__((address_space(4))) const char* kaptr_t;
__device__ __forceinline__ const float* INP(int i) {
    kaptr_t ka = (kaptr_t)__builtin_amdgcn_kernarg_segment_ptr();
    return (const float*)(const GAS float*)*(const unsigned long long volatile __attribute__((address_space(4)))*)(ka + i * 8);
}
__device__ __forceinline__ float* OUTP() {
    kaptr_t ka = (kaptr_t)__builtin_amdgcn_kernarg_segment_ptr();
    return (float*)(GAS float*)*(const unsigned long long volatile __attribute__((address_space(4)))*)(ka + 23 * 8);
}
struct Frame {
    LAS unsigned char* lds; unsigned char* ws;
    int tid, lane, wave, vcu, G;
};
__device__ __forceinline__ void refresh(Frame& F) {
    int w0 = F.wave; asm volatile("" : "+s"(w0)); int t = (w0 << 6) | lane_id(); asm volatile("" : "+v"(t)); F.tid = t; F.lane = t & 63; F.wave = w0;
    GAS unsigned char* w = (GAS unsigned char*)F.ws; asm volatile("" : "+s"(w)); F.ws = (unsigned char*)w;
    int v = F.vcu; asm volatile("" : "+s"(v)); F.vcu = v;
}
__device__ __forceinline__ int launder_v(int x) { asm volatile("" : "+v"(x)); return x; }
__device__ __forceinline__ int launder_s(int x) { asm volatile("" : "+s"(x)); return x; }
__device__ __forceinline__ int modrow_of(int row) { return row < SEQ ? 0 : (row < NXR ? 1 : 2); }

__device__ __forceinline__ void cvt_item(const float* src, int ldS, bf16_t* dst, int K, int k0, int srccol0, int dstrow0, LAS float* scr, int lane) {
    f32x4 v[16];
#pragma unroll
    for (int it = 0; it < 16; ++it) { const int kk = it * 4 + (lane >> 4), nn = (lane & 15) * 4; v[it] = *(const f32x4*)(src + (size_t)(k0 + kk) * ldS + srccol0 + nn); }
#pragma unroll
    for (int it = 0; it < 16; ++it) { const int kk = it * 4 + (lane >> 4), nn = (lane & 15) * 4; LAS float* s = scr + kk * 65 + nn; s[0] = v[it].x; s[1] = v[it].y; s[2] = v[it].z; s[3] = v[it].w; }
    asm volatile("s_waitcnt lgkmcnt(0)" ::: "memory");
    const int kb = lane & 7;
#pragma unroll
    for (int j = 0; j < 8; ++j) {
        const int n = (lane >> 3) + 8 * j; const LAS float* s = scr + (8 * kb) * 65 + n;
        u32x4 o; o.x = cvt_pk_bf16(s[0], s[65]); o.y = cvt_pk_bf16(s[2 * 65], s[3 * 65]); o.z = cvt_pk_bf16(s[4 * 65], s[5 * 65]); o.w = cvt_pk_bf16(s[6 * 65], s[7 * 65]);
        *(u32x4*)(dst + (size_t)(dstrow0 + n) * K + k0 + 8 * kb) = o;
    }
    asm volatile("s_waitcnt lgkmcnt(0)" ::: "memory");
}

struct CvtDesc { const float* src; unsigned char* dst; int ldS, k0, srccol0, dstrow0; };
__device__ __forceinline__ void cvt_load(const CvtDesc& d, f32x4 (&v)[16], int lane) {
#pragma unroll
    for (int it = 0; it < 16; ++it) { const int kk = it * 4 + (lane >> 4), nn = (lane & 15) * 4; v[it] = *(const f32x4*)(d.src + (size_t)(d.k0 + kk) * d.ldS + d.srccol0 + nn); }
}
__device__ __forceinline__ void cvt_finish(const CvtDesc& d, const f32x4 (&v)[16], LAS float* scr, int lane) {
#pragma unroll
    for (int it = 0; it < 16; ++it) { const int kk = it * 4 + (lane >> 4), nn = (lane & 15) * 4; LAS float* s = scr + kk * 65 + nn; s[0] = v[it].x; s[1] = v[it].y; s[2] = v[it].z; s[3] = v[it].w; }
    asm volatile("s_waitcnt lgkmcnt(0)" ::: "memory");
    const int kb = lane & 7;
#pragma unroll
    for (int j = 0; j < 8; ++j) {
        const int n = (lane >> 3) + 8 * j; const LAS float* s = scr + (8 * kb) * 65 + n;
        u32x2 o; o.x = pk4_fp8(s[0] * 64.f, s[65] * 64.f, s[2 * 65] * 64.f, s[3 * 65] * 64.f); o.y = pk4_fp8(s[4 * 65] * 64.f, s[5 * 65] * 64.f, s[6 * 65] * 64.f, s[7 * 65] * 64.f);
        *(u32x2*)(d.dst + (size_t)(d.dstrow0 + n) * DM + d.k0 + 8 * kb) = o;
    }
    asm volatile("s_waitcnt lgkmcnt(0)" ::: "memory");
}
__device__ __forceinline__ void p0_prologue(Frame& F) {
    const int gw = F.vcu * 8 + F.wave, NGW = F.G * 8;
    LAS float* scr = (LAS float*)(F.lds + F.wave * 16640);
    {
        constexpr int I_IN = 16 * 96, I_SQ = 256, I_S = 128;
        constexpr int PER_L = I_IN + 2 * I_SQ + I_S;
        for (int it = gw; it < DEPTH * PER_L; it += NGW) {
            const int l = it / PER_L; int r = it % PER_L;
            if (r < I_IN) { const int kb = r / 96, nb = r % 96; CvtDesc d; d.src = INP(I_WIN) + (size_t)l * DM * IN_DIM; d.dst = (unsigned char*)(F.ws + WS_WIN) + (size_t)l * IN_DIM * DM; d.ldS = IN_DIM; d.k0 = kb * 64; d.srccol0 = nb * 64; d.dstrow0 = nb * 64;
                f32x4 vv[16]; cvt_load(d, vv, F.lane); cvt_finish(d, vv, scr, F.lane); continue; } r -= I_IN;
            if (r < I_SQ) { const int kb = r / 16, nb = r % 16; cvt_item(INP(I_WAO) + (size_t)l * DM * DM, DM, (bf16_t*)(F.ws + WS_WA) + (size_t)l * DM * DM, DM, kb * 64, nb * 64, nb * 64, scr, F.lane); continue; } r -= I_SQ;
            if (r < I_SQ) { const int kb = r / 16, nb = r % 16; cvt_item(INP(I_WOUT) + (size_t)l * DM * DM, DM, (bf16_t*)(F.ws + WS_WO) + (size_t)l * DM * DM, DM, kb * 64, nb * 64, nb * 64, scr, F.lane); continue; } r -= I_SQ;
            { const int kb = r / 16, nb = r % 16; cvt_item(INP(I_WSGUO) + (size_t)l * 512 * DM, DM, (bf16_t*)(F.ws + WS_WS) + (size_t)l * DM * DM, DM, kb * 64, nb * 64, nb * 64, scr, F.lane); }
        }
    }
    __syncthreads();
    {
        LAS float* red = (LAS float*)F.lds;
        LAS float* sil = (LAS float*)(F.lds + 8192);
        float* MOD = (float*)(F.ws + WS_MOD);
        for (int i = F.tid; i < 3 * DM; i += 512) { const int r = i >> 10, k = i & 1023; const float c = r < 2 ? INP(I_C)[r * DM + k] : INP(I_CCTX)[k]; sil[i] = c * sigmoidf_(c); }
        __syncthreads();
        for (int u = (F.G >= 256 ? (F.vcu < 128 ? F.vcu : DEPTH * 96) : F.vcu); u < DEPTH * 96; u += (F.G >= 256 ? 128 : F.G)) {
            const int l = u / 96, j0 = (u % 96) * 64;
            const float* wm = INP(I_WMOD) + (size_t)l * DM * 6144 + (size_t)(F.wave * 128) * 6144 + j0 + F.lane;
            float a0 = 0.f, a1 = 0.f, a2 = 0.f;
#pragma unroll 32
            for (int kk = 0; kk < 128; ++kk) {
                const float w = wm[(size_t)kk * 6144]; const int k = F.wave * 128 + kk;
                a0 += sil[k] * w; a1 += sil[1024 + k] * w; a2 += sil[2048 + k] * w;
            }
            red[(F.wave * 3 + 0) * 64 + F.lane] = a0; red[(F.wave * 3 + 1) * 64 + F.lane] = a1; red[(F.wave * 3 + 2) * 64 + F.lane] = a2;
            __syncthreads();
            if (F.tid < 192) { const int r = F.tid >> 6, j = F.tid & 63; float sacc = 0.f;
#pragma unroll
                for (int w = 0; w < 8; ++w) sacc += red[(w * 3 + r) * 64 + j];
                MOD[((size_t)l * 3 + r) * 6144 + j0 + j] = sacc + INP(I_BMOD)[(size_t)l * 6144 + j0 + j]; }
            __syncthreads();
        }
    }
    {
        bf16_t* T1 = (bf16_t*)(F.ws + WS_T1); bf16_t* T2 = (bf16_t*)(F.ws + WS_T2); bf16_t* TC = (bf16_t*)(F.ws + WS_TC); bf16_t* WSP = (bf16_t*)(F.ws + WS_WSP);
        const int gt = F.vcu * 512 + F.tid, NGT = F.G * 512;
        for (int i = gt; i < 64 * 256 * 128 / 2; i += NGT) {
            const int n2 = (2 * i) & 127, m = ((2 * i) >> 7) & 255, n1 = (2 * i) >> 15, k2 = m & 127, reim = m >> 7; float v[2];
#pragma unroll
            for (int q = 0; q < 2; ++q) { const int r = (k2 * (n1 + 64 * (n2 + q))) & 8191; float sn, cs; sincospif((float)r * (1.0f / 4096.0f), &sn, &cs); v[q] = (reim ? -sn : cs) * 0.08838834764831845f; }
            ((unsigned*)T1)[i] = cvt_pk_bf16(v[0], v[1]);
        }
        for (int i = gt; i < 128 * 128 / 2; i += NGT) {
            const int j0 = (2 * i) & 127, m = (2 * i) >> 7, ri = j0 >> 6, k1 = m & 63, ro = m >> 6; float v[2];
#pragma unroll
            for (int q = 0; q < 2; ++q) { const int n1 = (j0 + q) & 63; const int r = (k1 * n1) & 63; float sn, cs; sincospif((float)r * (1.0f / 32.0f), &sn, &cs); v[q] = ((ro == ri) ? cs : (ro == 0 ? sn : -sn)) * 0.125f; }
            ((unsigned*)T2)[i] = cvt_pk_bf16(v[0], v[1]);
        }
        for (int i = gt; i < 512 * 256 / 2; i += NGT) {
            const int n = (2 * i) & 255, m = (2 * i) >> 8, k = m & 255, reim = m >> 8; float v[2];
#pragma unroll
            for (int q = 0; q < 2; ++q) { const int r = (k * (n + q)) & 255; float sn, cs; sincospif((float)r * (1.0f / 128.0f), &sn, &cs); v[q] = (reim ? -sn : cs) * 0.0625f; }
            ((unsigned*)TC)[i] = cvt_pk_bf16(v[0], v[1]);
        }
        for (int i = gt; i < 128 * 32; i += NGT) { const int pos = i >> 5, f = i & 31; float sn, cs; sincosf((float)pos * exp2f(-(float)f * (13.287712379549449f / 32.0f)), &sn, &cs);
            ((float*)(F.ws + WS_ROPE))[i] = cs; ((float*)(F.ws + WS_ROPE))[4096 + i] = sn; }
        const float* wsp = INP(I_WSPAT);
        for (int i = gt; i < DEPTH * 4 * 128 * 128 / 2; i += NGT) { const f32x2 v = ((const f32x2*)wsp)[i]; ((unsigned*)WSP)[i] = cvt_pk_bf16(v.x, v.y); }
    }
    {
        LAS float* wt = (LAS float*)F.lds;
        LAS float* tb = (LAS float*)(F.lds + 32768);
        if (F.tid < 128) { float s, c; sincospif((float)F.tid * (1.0f / 64.0f), &s, &c); tb[F.tid] = c; tb[128 + F.tid] = s; }
        for (int u = (F.G >= 256 ? F.vcu - 128 : F.vcu); u < DEPTH * 4 * 16; u += F.G) {
            if (u < 0) continue;
            const int l = u / 64, g = (u / 16) & 3, d0 = (u & 15) * 64;
            __syncthreads();
            for (int i = F.tid; i < 128 * 64; i += 512) { const int m = i >> 6, d = i & 63; wt[i] = INP(I_WFOUR)[((size_t)l * 512 + g * 128 + m) * DM + d0 + d]; }
            __syncthreads();
            const int c = F.tid & 127, dq = F.tid >> 7;
            float ar[16], ai[16];
#pragma unroll
            for (int i = 0; i < 16; ++i) { ar[i] = 0.f; ai[i] = 0.f; }
            for (int m = 0; m < 128; ++m) {
                const int r = (m * c) & 127; const float cs = tb[r], sn = tb[128 + r];
#pragma unroll
                for (int i = 0; i < 16; ++i) { const float w = wt[m * 64 + dq * 16 + i]; ar[i] += cs * w; ai[i] += sn * w; }
            }
            bf16_t* W = (bf16_t*)(F.ws + WS_WFP) + (size_t)l * DM * DM;
            const bool oddc = (c & 1) != 0;
#pragma unroll
            for (int i = 0; i < 16; ++i) { const size_t rowo = (size_t)(d0 + dq * 16 + i) * DM;
                const float a = ar[i] * 0.08838834764831845f, b = ai[i] * 0.08838834764831845f; const float recv = sx<1>(oddc ? a : b);
                *(unsigned*)(W + rowo + (oddc ? 512 : 0) + g * 128 + (c & ~1)) = cvt_pk_bf16(oddc ? recv : a, oddc ? b : recv); }
        }
    }
}

constexpr int MOE_ITEMS = NEXP * (512 + 256);
__device__ __forceinline__ CvtDesc moe_cvt_desc(Frame& F, int l, int it) {
    CvtDesc d; const int e = it / 768; int r = it % 768;
    if (r < 512) { const int kb = r / 32, nb = r % 32;
        const int T = nb >> 2, half = (nb >> 1) & 1, i0 = (nb & 1) * 64;
        d.src = INP(I_WGU) + ((size_t)l * NEXP + e) * DM * 2048; d.ldS = 2048; d.dst = (unsigned char*)(F.ws + WS_WGU) + ((size_t)l * NEXP + e) * 2048 * DM; d.k0 = kb * 64; d.srccol0 = half * 1024 + T * 128 + i0; d.dstrow0 = nb * 64; }
    else { r -= 512; const int kb = r / 16, nb = r % 16;
        d.src = INP(I_WDN) + ((size_t)l * NEXP + e) * DM * DM; d.ldS = DM; d.dst = (unsigned char*)(F.ws + WS_WDN) + ((size_t)l * NEXP + e) * DM * DM; d.k0 = kb * 64; d.srccol0 = nb * 64; d.dstrow0 = nb * 64; }
    return d;
}
struct FillCur { int c0, c1;
    __device__ __forceinline__ int get(int l) const { return l == 0 ? c0 : c1; }
    __device__ __forceinline__ void add(int l, int n) { if (l == 0) c0 += n; else c1 += n; } };
__device__ __forceinline__ void fill_range(Frame& F, int lay, int lo, int hi, int widx, int nw) {
    LAS float* scr = (LAS float*)(F.lds + F.wave * 16640);
    int it = lo + widx; if (it >= hi) return;
    f32x4 va[16], vb[16]; CvtDesc da = moe_cvt_desc(F, lay, it), db = da;
    cvt_load(da, va, F.lane);
    for (;;) {
        const bool hb = it + nw < hi; if (hb) { db = moe_cvt_desc(F, lay, it + nw); cvt_load(db, vb, F.lane); }
        cvt_finish(da, va, scr, F.lane); if (!hb) break;
        const bool ha = it + 2 * nw < hi; if (ha) { da = moe_cvt_desc(F, lay, it + 2 * nw); cvt_load(da, va, F.lane); }
        cvt_finish(db, vb, scr, F.lane); if (!ha) break;
        it += 2 * nw;
    }
}
__device__ __forceinline__ void fill_after(Frame& F, FillCur& C, int lmin, int total, int c, int per_wave) {
    const int rem = total % F.G; if (rem == 0) return;
    const int n_idle = F.G - rem, nw = n_idle * 8; int budget = nw * per_wave;
    const bool idle = c >= rem; const int widx = (c - rem) * 8 + F.wave;
#pragma unroll
    for (int lay = 0; lay < DEPTH; ++lay) { if (lay < lmin) continue;
        const int cu = C.get(lay), take = (MOE_ITEMS - cu < budget) ? MOE_ITEMS - cu : budget;
        if (take > 0) { if (idle) fill_range(F, lay, cu, cu + take, widx, nw); C.add(lay, take); budget -= take; } }
}
__device__ __forceinline__ void fill_cleanup(Frame& F, FillCur& C, int lay) {
    const int cu = C.get(lay); if (cu < MOE_ITEMS) { fill_range(F, lay, cu, MOE_ITEMS, F.vcu * 8 + F.wave, F.G * 8); C.add(lay, MOE_ITEMS - cu); }
}

__device__ __forceinline__ void p_norm1(Frame& F, int l, int nrows) {
    const int gw = F.vcu * 8 + F.wave, NGW = F.G * 8;
    const float* MOD = (const float*)(F.ws + WS_MOD) + (size_t)l * 3 * 6144;
#define N1_SRC(r_) ((const f32x4*)((l == 0) ? ((r_) < NXR ? INP(I_X) + (size_t)(r_) * DM : INP(I_CTX) + (size_t)((r_) - NXR) * DM) : (const float*)(F.ws + WS_XW) + (size_t)(r_) * DM) + F.lane)
    f32x4 nv[4] = {};
    if (gw < nrows) { const f32x4* xr = N1_SRC(gw);
#pragma unroll
        for (int j = 0; j < 4; ++j) nv[j] = xr[64 * j]; }
    for (int row = gw; row < nrows; row += NGW) {
        f32x4 v[4]; float ss = 0.f;
#pragma unroll
        for (int j = 0; j < 4; ++j) v[j] = nv[j];
        if (row + NGW < nrows) { const f32x4* xr = N1_SRC(row + NGW);
#pragma unroll
            for (int j = 0; j < 4; ++j) nv[j] = xr[64 * j]; }
#pragma unroll
        for (int j = 0; j < 4; ++j) ss += (v[j].x * v[j].x + v[j].y * v[j].y) + (v[j].z * v[j].z + v[j].w * v[j].w);
        const float* md = MOD + (size_t)modrow_of(row) * 6144;
        f32x4 sh[4], sc[4];
#pragma unroll
        for (int j = 0; j < 4; ++j) { const int c = 4 * F.lane + 256 * j; sh[j] = *(const f32x4*)(md + c); sc[j] = *(const f32x4*)(md + 1024 + c); }
        const float rstd = rsqrtf(wave_sum(ss) * (1.f / DM) + EPS);
        unsigned* o = (unsigned*)((unsigned char*)(F.ws + WS_HX8) + (size_t)row * DM) + F.lane;
#pragma unroll
        for (int j = 0; j < 4; ++j) { const f32x4 h = v[j] * rstd * (sc[j] + 1.0f) + sh[j]; o[64 * j] = pk4_fp8(h.x, h.y, h.z, h.w); }
    }
#undef N1_SRC
}

struct SchedIn {
    const char* A; const char* B; int G, c, nxt_total, last;
    __device__ __forceinline__ bool next(int i, g8::Unit& u) const {
        const int L = i * G + c; if (L >= nxt_total) return false;
        int pm, pn;
        if (L < 64 * 24) g8::tile_order(L, 64, 24, pm, pn);
        else { const int r = L - 64 * 24; if (last) { pm = 64 + (r >> 1); pn = 4 + (r & 1); } else { pm = 64 + r / 24; pn = r % 24; } }
        u.A = A + (size_t)pm * 256 * 1024; u.B = B + (size_t)pn * 256 * 1024; u.nt = 8; u.pm = pm; u.pn = pn; u.aux = 0; return true;
    }
};
struct EpiIn {
    static constexpr bool PERM = true; static constexpr int NAUX = 0;
    bf16_t* PX; bf16_t* GT; const float* bgate;
    __device__ __forceinline__ bool operator()(f32x4 (&acc)[2][2][4][2], const g8::Unit& u, int wr, int wc, int fr, int fq, const LAS float* aux) const {
        const int row0 = u.pm * 256 + wr * 64 + fr; const bool gates = u.pn >= 12;
        bf16_t* base = gates ? GT : PX; const int colt = (gates ? u.pn - 12 : u.pn) * 256, col0 = colt + wc * 32 + 8 * fq;
        f32x4 bv[2][2];
#pragma unroll
        for (int bj = 0; bj < 2; ++bj)
#pragma unroll
            for (int n = 0; n < 2; ++n) bv[bj][n] = gates ? *(const f32x4*)(bgate + col0 + bj * 128 + 4 * n) * -1.4426950408889634f : (f32x4){0.f, 0.f, 0.f, 0.f};
#pragma unroll
        for (int ai = 0; ai < 2; ++ai)
#pragma unroll
            for (int m = 0; m < 4; ++m) { bf16_t* rowp = base + (size_t)(row0 + ai * 128 + m * 16) * 3072 + col0;
#pragma unroll
                for (int bj = 0; bj < 2; ++bj) { f32x4 v0, v1;
                    if (gates) {
#pragma unroll
                        for (int j = 0; j < 4; ++j) { v0[j] = __builtin_amdgcn_rcpf(1.0f + __builtin_amdgcn_exp2f(__builtin_fmaf(acc[ai][bj][m][0][j], -0.022542110013890054f, bv[bj][0][j])));
                                                      v1[j] = __builtin_amdgcn_rcpf(1.0f + __builtin_amdgcn_exp2f(__builtin_fmaf(acc[ai][bj][m][1][j], -0.022542110013890054f, bv[bj][1][j]))); } }
                    else { v0 = acc[ai][bj][m][0] * 0.015625f; v1 = acc[ai][bj][m][1] * 0.015625f; }
                    u32x4 w; w.x = cvt_pk_bf16(v0[0], v0[1]); w.y = cvt_pk_bf16(v0[2], v0[3]); w.z = cvt_pk_bf16(v1[0], v1[1]); w.w = cvt_pk_bf16(v1[2], v1[3]);
                    *(u32x4*)(rowp + bj * 128) = w; } }
        return false;
    }
};

__device__ __forceinline__ void p_postproj(Frame& F, int l, int nrows) {
    const int gw = F.vcu * 8 + F.wave, NGW = F.G * 8, L = F.lane, hs = L >> 4, j = L & 15;
    const bf16_t* PX = (const bf16_t*)(F.ws + WS_PX);
    const float* qg = INP(I_QGAIN) + l * 128 + 8 * j; const float* kg = INP(I_KGAIN) + l * 128 + 8 * j; const float* sg = INP(I_SGUGAIN) + l * 512 + hs * 128 + 8 * j;
    float qgv[8], kgv[8], sgv[8];
#pragma unroll
    for (int i = 0; i < 8; ++i) { qgv[i] = qg[i]; kgv[i] = kg[i]; sgv[i] = sg[i]; }
    const int ax = j >> 3, half = (j >> 2) & 1, f0 = 8 * (j & 3);
    const float* RC = (const float*)(F.ws + WS_ROPE);
#define PP_LOAD(r_, a0, a1, a2, a3) do { const bf16_t* p_ = PX + (size_t)(r_) * PXW; a0 = *(const u32x4*)(p_ + hs * 128 + 8 * j); a1 = *(const u32x4*)(p_ + (4 + hs) * 128 + 8 * j); \
        if (hs < 2) a2 = *(const u32x4*)(p_ + K_OFF + hs * 128 + 8 * j);   a3 = *(const u32x4*)(p_ + VG_OFF + hs * 128 + 8 * j); } while (0)
#define PP_RC(r_) do { const bool isx_ = (r_) < NXR; const int s_ = isx_ ? ((r_) & 8191) : (((r_) - NXR) & 255); const int pos_ = isx_ ? (ax ? (s_ & 63) : (s_ >> 6)) : 0; \
        nc0 = *(const f32x4*)(RC + pos_ * 32 + f0); nc1 = *(const f32x4*)(RC + pos_ * 32 + f0 + 4); ns0 = *(const f32x4*)(RC + 4096 + pos_ * 32 + f0); ns1 = *(const f32x4*)(RC + 4096 + pos_ * 32 + f0 + 4); } while (0)
    u32x4 nq0 = {}, nq1 = {}, nkv = {}, nvg = {}; f32x4 nc0 = {}, nc1 = {}, ns0 = {}, ns1 = {};
    if (gw < nrows) { PP_LOAD(gw, nq0, nq1, nkv, nvg); PP_RC(gw); }
    for (int row = gw; row < nrows; row += NGW) {
        const bool isx = row < NXR; const int b = isx ? (row >> 13) : ((row - NXR) >> 8), s = isx ? (row & 8191) : ((row - NXR) & 255);
        const int pos = isx ? (ax ? (s & 63) : (s >> 6)) : 0;
        float cs[8], sn[8];
        { const f32x4 c0 = nc0, c1 = nc1, s0 = ns0, s1 = ns1; (void)pos;
#pragma unroll
          for (int i = 0; i < 4; ++i) { cs[i] = c0[i]; cs[4 + i] = c1[i]; sn[i] = half ? s0[i] : -s0[i]; sn[4 + i] = half ? s1[i] : -s1[i]; } }
        const bf16_t* pr = PX + (size_t)row * PXW;
        const size_t krow = (size_t)b * LK + (isx ? s : SEQ + s);
        const u32x4 wq0 = nq0, wq1 = nq1, wkv = nkv, wvg = nvg; (void)pr;
        if (row + NGW < nrows) { PP_LOAD(row + NGW, nq0, nq1, nkv, nvg); PP_RC(row + NGW); }
#pragma unroll
        for (int p = 0; p < 4; ++p) {
            const u32x4 w = p == 0 ? wq0 : p == 1 ? wq1 : p == 2 ? wkv : wvg;
            float v[8] = {bf_lo(w.x), bf_hi(w.x), bf_lo(w.y), bf_hi(w.y), bf_lo(w.z), bf_hi(w.z), bf_lo(w.w), bf_hi(w.w)};
            if (p == 3) {
#pragma unroll
                for (int i = 0; i < 8; ++i) v[i] = gelu_tanh(v[i]); }
            float ss = 0.f;
#pragma unroll
            for (int i = 0; i < 8; ++i) ss += v[i] * v[i];
            ss += sx<1>(ss); ss += sx<2>(ss); ss += sx<4>(ss); ss += sx<8>(ss);
            const float rstd = rsqrtf(ss * (1.f / 128.f) + EPS);
            const bool plain = (p == 2 && hs >= 2);
            const bool rope = isx && (p < 2 || (p == 2 && hs < 2));
            float o[8];
#pragma unroll
            for (int i = 0; i < 8; ++i) { const float gn = p < 2 ? qgv[i] : p == 2 ? kgv[i] : sgv[i]; o[i] = v[i] * rstd * gn; }
            if (p < 3) {
#pragma unroll
                for (int i = 0; i < 8; ++i) { const float pa = sx<4>(o[i]); if (rope) o[i] = o[i] * cs[i] + pa * sn[i]; } }
            const bool f8 = p < 2 || (p == 2 && hs < 2);
            const float qs = p < 2 ? att::SCALE * 1.4426950408889634f : 1.f;
            u32x2 q8; q8.x = pk4_fp8(o[0] * qs, o[1] * qs, o[2] * qs, o[3] * qs); q8.y = pk4_fp8(o[4] * qs, o[5] * qs, o[6] * qs, o[7] * qs);
            u32x4 q; q.x = plain ? w.x : cvt_pk_bf16(o[0], o[1]); q.y = plain ? w.y : cvt_pk_bf16(o[2], o[3]); q.z = plain ? w.z : cvt_pk_bf16(o[4], o[5]); q.w = plain ? w.w : cvt_pk_bf16(o[6], o[7]);
            if (f8) { unsigned char* d8 = p == 0 ? (unsigned char*)(F.ws + WS_QN) + (size_t)row * DM + hs * 128 : p == 1 ? (unsigned char*)(F.ws + WS_QN) + (size_t)row * DM + (4 + hs) * 128
                                         : (unsigned char*)(F.ws + WS_KN) + krow * 256 + hs * 128;
                *(u32x2*)(d8 + 8 * j) = q8; }
            else if (p == 3) *(u32x4*)((bf16_t*)(F.ws + WS_VGN) + (size_t)row * 512 + hs * 128 + 8 * j) = q;
        }
    }
#undef PP_LOAD
#undef PP_RC
}

__device__ __forceinline__ void p_vblocks(Frame& F) {
    LAS unsigned char* T = F.lds;
    const bf16_t* PX = (const bf16_t*)(F.ws + WS_PX);
    const int key = F.tid >> 3, pc = F.tid & 7, w = key & 31, pos = 32 * ((w >> 2) & 1) + 16 * (key >> 5) + (w & 3) + 4 * (w >> 3);
#define VB_LOAD(u_, A, C) do { const int t_ = (u_) % 132, kvh_ = ((u_) / 132) & 1, b_ = (u_) / 264; \
        const size_t row_ = t_ < 128 ? (size_t)b_ * SEQ + 64 * t_ + key : (size_t)NXR + b_ * CTX + 64 * (t_ - 128) + key; \
        const u32x4* src_ = (const u32x4*)(PX + row_ * PXW + V_OFF + kvh_ * 128 + 16 * pc); A = src_[0]; C = src_[1]; } while (0)
    u32x4 na = {}, nc = {};
    if (F.vcu < NB * 2 * 132) VB_LOAD(F.vcu, na, nc);
    for (int u = F.vcu; u < NB * 2 * 132; u += F.G) {
        const u32x4 a = na, c = nc;
        const unsigned q0 = pk4_fp8(bf_lo(a.x), bf_hi(a.x), bf_lo(a.y), bf_hi(a.y)), q1 = pk4_fp8(bf_lo(a.z), bf_hi(a.z), bf_lo(a.w), bf_hi(a.w));
        const unsigned q2 = pk4_fp8(bf_lo(c.x), bf_hi(c.x), bf_lo(c.y), bf_hi(c.y)), q3 = pk4_fp8(bf_lo(c.z), bf_hi(c.z), bf_lo(c.w), bf_hi(c.w));
        __syncthreads();
#pragma unroll
        for (int i = 0; i < 4; ++i) { T[(16 * pc + i) * 64 + pos] = (unsigned char)(q0 >> (8 * i)); T[(16 * pc + 4 + i) * 64 + pos] = (unsigned char)(q1 >> (8 * i));
            T[(16 * pc + 8 + i) * 64 + pos] = (unsigned char)(q2 >> (8 * i)); T[(16 * pc + 12 + i) * 64 + pos] = (unsigned char)(q3 >> (8 * i)); }
        __syncthreads();
        if (u + F.G < NB * 2 * 132) VB_LOAD(u + F.G, na, nc);
        *(u32x4*)((unsigned char*)(F.ws + WS_VN) + (size_t)u * 8192 + F.tid * 16) = *(const LAS u32x4*)(T + F.tid * 16);
    }
#undef VB_LOAD
    __syncthreads();
}

template <int M, int K, class Epi>
__device__ __forceinline__ void lm_unit(Frame& F, const bf16_t* __restrict__ Wm, const bf16_t* __restrict__ in, size_t in_stride, const Epi& E) {
    constexpr int NTL = K / 64;
    constexpr bool HOIST = (M / 32 == 8) && NTL <= 2;
    const int r32 = F.lane & 31, hi = F.lane >> 5;
    bf16x8 pw[NTL][4];
    __syncthreads();
    {
        const int sr = F.tid >> 4, sc = (F.tid & 15) * 8, vst0 = att::v_st(sr, sc), vst1 = att::v_st(32 + sr, sc);
        bf16x8 t0[NTL], t1[NTL];
#pragma unroll
        for (int t = 0; t < NTL; ++t) { t0[t] = *(const bf16x8*)(in + (size_t)(t * 64 + sr) * in_stride + sc); t1[t] = *(const bf16x8*)(in + (size_t)(t * 64 + 32 + sr) * in_stride + sc); }
        if constexpr (HOIST) { const bf16_t* wrow = Wm + (size_t)(F.wave * 32 + r32) * K + hi * 8;
#pragma unroll
            for (int t = 0; t < NTL; ++t)
#pragma unroll
                for (int i = 0; i < 4; ++i) pw[t][i] = *(const bf16x8*)(wrow + t * 64 + 16 * i); }
#pragma unroll
        for (int t = 0; t < NTL; ++t) { *(LAS bf16x8*)(F.lds + t * 16384 + vst0) = t0[t]; *(LAS bf16x8*)(F.lds + t * 16384 + vst1) = t1[t]; }
    }
    __syncthreads();
    const int vb0 = (int)(unsigned)(uintptr_t)F.lds + att::v_rd_base(F.lane);
    for (int rb = F.wave; rb < M / 32; rb += 8) {
        f32x16 o[4] = {};
        const bf16_t* wrow = Wm + (size_t)(rb * 32 + r32) * K + hi * 8;
#pragma unroll
        for (int t = 0; t < NTL; ++t) {
            if constexpr (HOIST) att::pv_d0(o, vb0 + t * 16384, pw[t][0], pw[t][1], pw[t][2], pw[t][3]);
            else { const bf16x8 pa0 = *(const bf16x8*)(wrow + t * 64), pa1 = *(const bf16x8*)(wrow + t * 64 + 16), pa2 = *(const bf16x8*)(wrow + t * 64 + 32), pa3 = *(const bf16x8*)(wrow + t * 64 + 48);
                att::pv_d0(o, vb0 + t * 16384, pa0, pa1, pa2, pa3); }
        }
        if constexpr (HOIST) { const float one[16] = {};
            att::wave_rows_out<false>(F.lds + 65536 + F.wave * 8192, o, one, F.lane, [&](int row, int col8, u32x4 v) { E.rows(rb * 32 + row, col8, v); }); }
        else {
        const bool odd = (F.lane & 1) != 0;
#pragma unroll
        for (int r = 0; r < 16; ++r) { const int row = rb * 32 + att::crow(r, hi);
#pragma unroll
            for (int dp = 0; dp < 4; dp += 2) {
                const float recv = sx<1>(odd ? o[dp][r] : o[dp + 1][r]);
                E(row, odd ? (dp + 1) * 32 + r32 - 1 : dp * 32 + r32, odd ? recv : o[dp][r], odd ? o[dp + 1][r] : recv); } }
        }
    }
}
template <class EpiA, class EpiB>
__device__ __forceinline__ void lm_unit_pair(Frame& F, const bf16_t* __restrict__ WmA, const bf16_t* __restrict__ inA, const EpiA& EA, const bf16_t* __restrict__ WmB, const bf16_t* __restrict__ inB, const EpiB& EB, size_t in_stride, bool hasB) {
    const int r32 = F.lane & 31, hi = F.lane >> 5;
    bf16x8 pw[2][4];
    __syncthreads();
    {
        const int sr = F.tid >> 4, sc = (F.tid & 15) * 8, vst0 = att::v_st(sr, sc), vst1 = att::v_st(32 + sr, sc);
        bf16x8 t0[4], t1[4];
#pragma unroll
        for (int t = 0; t < 4; ++t) { const bf16_t* in = (t < 2 || !hasB) ? inA : inB; const int tt = t & 1;
            t0[t] = *(const bf16x8*)(in + (size_t)(tt * 64 + sr) * in_stride + sc); t1[t] = *(const bf16x8*)(in + (size_t)(tt * 64 + 32 + sr) * in_stride + sc); }
        { const bf16_t* wrow = ((F.wave >> 2) ? WmB : WmA) + (size_t)((F.wave & 3) * 32 + r32) * 128 + hi * 8;
#pragma unroll
            for (int t = 0; t < 2; ++t)
#pragma unroll
                for (int i = 0; i < 4; ++i) pw[t][i] = *(const bf16x8*)(wrow + t * 64 + 16 * i); }
#pragma unroll
        for (int t = 0; t < 4; ++t) { *(LAS bf16x8*)(F.lds + t * 16384 + vst0) = t0[t]; *(LAS bf16x8*)(F.lds + t * 16384 + vst1) = t1[t]; }
    }
    __syncthreads();
    const int pb = F.wave >> 2, rb = F.wave & 3;
    if (pb == 0 || hasB) {
        const int vb0 = (int)(unsigned)(uintptr_t)F.lds + att::v_rd_base(F.lane) + pb * 32768;
        f32x16 o[4] = {};
#pragma unroll
        for (int t = 0; t < 2; ++t) att::pv_d0(o, vb0 + t * 16384, pw[t][0], pw[t][1], pw[t][2], pw[t][3]);
        const bool odd = (F.lane & 1) != 0;
#pragma unroll
        for (int r = 0; r < 16; ++r) { const int row = rb * 32 + att::crow(r, hi);
#pragma unroll
            for (int dp = 0; dp < 4; dp += 2) {
                const float recv = sx<1>(odd ? o[dp][r] : o[dp + 1][r]);
                const int col = odd ? (dp + 1) * 32 + r32 - 1 : dp * 32 + r32; const float v0 = odd ? recv : o[dp][r], v1 = odd ? o[dp + 1][r] : recv;
                if (pb == 0) EA(row, col, v0, v1); else EB(row, col, v0, v1); } }
    }
}
__device__ __forceinline__ unsigned lm_dma_lane_off(int wave, int lane, int i, unsigned in_stride) {
    const int g = wave * 128 + i * 64 + lane, blk = g >> 5, within = g & 31, kk = (blk >> 2) * 8 + (within >> 2), c = (blk & 3) * 32 + (within & 3) * 8;
    const int k = (kk & ~0xC) | ((kk & 4) << 1) | ((kk & 8) >> 1);
    return ((unsigned)k * in_stride + (unsigned)c) * 2u;
}
__device__ __forceinline__ void lm_dma_pair(Frame& F, const bf16_t* inA, const bf16_t* inB, unsigned in_stride, int bufoff, unsigned lo0, unsigned lo1) {
#pragma unroll
    for (int t = 0; t < 4; ++t) { const char* base = (const char*)((t < 2 ? inA : inB) + (size_t)((t & 1) * 64) * in_stride);
        unsigned a0 = lo0, a1 = lo1; asm volatile("" : "+v"(a0), "+v"(a1));
        __builtin_amdgcn_global_load_lds((const unsigned*)(base + a0), (LAS unsigned*)(F.lds + bufoff + t * 16384 + F.wave * 2048), 16, 0, 0);
        __builtin_amdgcn_global_load_lds((const unsigned*)(base + a1), (LAS unsigned*)(F.lds + bufoff + t * 16384 + F.wave * 2048 + 1024), 16, 0, 0); }
}
template <class Epi>
__device__ __forceinline__ void lm_pair_compute(Frame& F, const bf16x8 (&pw)[2][4], int bufoff, const Epi& E) {
    const int r32 = F.lane & 31, hi = F.lane >> 5, pb = F.wave >> 2, rb = F.wave & 3;
    const int vb0 = (int)(unsigned)(uintptr_t)F.lds + bufoff + att::v_rd_base(F.lane) + pb * 32768;
    f32x16 o[4] = {};
#pragma unroll
    for (int t = 0; t < 2; ++t) att::pv_d0(o, vb0 + t * 16384, pw[t][0], pw[t][1], pw[t][2], pw[t][3]);
    __syncthreads();
    const float one[16] = {};
    att::wave_rows_out<false>(F.lds + bufoff + F.wave * 8192, o, one, F.lane, [&](int row, int col8, u32x4 v) { E.rows(rb * 32 + row, col8, v); });
    (void)r32; (void)hi;
}
__device__ __forceinline__ void lm_load_w(Frame& F, bf16x8 (&pw)[2][4], const bf16_t* Wm) {
    const bf16_t* wrow = Wm + (size_t)((F.wave & 3) * 32 + (F.lane & 31)) * 128 + (F.lane >> 5) * 8;
#pragma unroll
    for (int t = 0; t < 2; ++t)
#pragma unroll
        for (int i = 0; i < 4; ++i) pw[t][i] = *(const bf16x8*)(wrow + t * 64 + 16 * i);
}
struct EpiStore2 {
    bf16_t* base; int Mh; size_t s1, s2;
    __device__ __forceinline__ void operator()(int m, int col, float v0, float v1) const {
        const int hi = m >= Mh ? 1 : 0, lo = m - hi * Mh;
        *(unsigned*)(base + (size_t)lo * s1 + (size_t)hi * s2 + col) = cvt_pk_bf16(v0, v1);
    }
    __device__ __forceinline__ void rows(int m, int col8, u32x4 v) const {
        const int hi = m >= Mh ? 1 : 0, lo = m - hi * Mh; *(u32x4*)(base + (size_t)lo * s1 + (size_t)hi * s2 + col8) = v;
    }
};
struct EpiSgu {
    bf16_t* sg; const bf16_t* u; const float* bs;
    __device__ __forceinline__ void operator()(int m, int col, float v0, float v1) const {
        const unsigned w = *(const unsigned*)(u + (size_t)m * PXW + col); const float b = bs[m];
        *(unsigned*)(sg + (size_t)m * DM + col) = cvt_pk_bf16((v0 + b) * gelu_tanh(bf_lo(w)), (v1 + b) * gelu_tanh(bf_hi(w)));
    }
    __device__ __forceinline__ void pre(int rbase, int lane, u32x4 (&uw)[8], float (&ub)[8]) const {
#pragma unroll
        for (int i = 0; i < 8; ++i) { const int m = rbase + 4 * i + (lane >> 4); uw[i] = *(const u32x4*)(u + (size_t)m * PXW + (lane & 15) * 8); ub[i] = bs[m]; }
    }
    __device__ __forceinline__ void rows2(int m, int col8, u32x4 v, u32x4 w, float b) const {
        u32x4 r;
        r.x = cvt_pk_bf16((bf_lo(v.x) + b) * gelu_tanh(bf_lo(w.x)), (bf_hi(v.x) + b) * gelu_tanh(bf_hi(w.x))); r.y = cvt_pk_bf16((bf_lo(v.y) + b) * gelu_tanh(bf_lo(w.y)), (bf_hi(v.y) + b) * gelu_tanh(bf_hi(w.y)));
        r.z = cvt_pk_bf16((bf_lo(v.z) + b) * gelu_tanh(bf_lo(w.z)), (bf_hi(v.z) + b) * gelu_tanh(bf_hi(w.z))); r.w = cvt_pk_bf16((bf_lo(v.w) + b) * gelu_tanh(bf_lo(w.w)), (bf_hi(v.w) + b) * gelu_tanh(bf_hi(w.w)));
        *(u32x4*)(sg + (size_t)m * DM + col8) = r;
    }
    __device__ __forceinline__ void rows(int m, int col8, u32x4 v) const {
        const u32x4 w = *(const u32x4*)(u + (size_t)m * PXW + col8); const float b = bs[m]; u32x4 r;
        r.x = cvt_pk_bf16((bf_lo(v.x) + b) * gelu_tanh(bf_lo(w.x)), (bf_hi(v.x) + b) * gelu_tanh(bf_hi(w.x))); r.y = cvt_pk_bf16((bf_lo(v.y) + b) * gelu_tanh(bf_lo(w.y)), (bf_hi(v.y) + b) * gelu_tanh(bf_hi(w.y)));
        r.z = cvt_pk_bf16((bf_lo(v.z) + b) * gelu_tanh(bf_lo(w.z)), (bf_hi(v.z) + b) * gelu_tanh(bf_hi(w.z))); r.w = cvt_pk_bf16((bf_lo(v.w) + b) * gelu_tanh(bf_lo(w.w)), (bf_hi(v.w) + b) * gelu_tanh(bf_hi(w.w)));
        *(u32x4*)(sg + (size_t)m * DM + col8) = r;
    }
};

constexpr int RT_R = 22, RT_P = 23;
__device__ __forceinline__ void p_route(Frame& F, int l, int nrows, int cbank = 0) {
    LAS float* hsT = (LAS float*)F.lds;
    LAS float* part = (LAS float*)(F.lds + 98304);
    LAS float* lgs = (LAS float*)(F.lds + 122880);
    LAS float* tval = (LAS float*)(F.lds + 122880 + 3072);
    LAS int* tk_e = (LAS int*)(F.lds + LDS_X_OFF);
    LAS float* tk_w = (LAS float*)(F.lds + LDS_X_OFF + 2048);
    LAS int* wcnt = (LAS int*)(F.lds + LDS_X_OFF + 4096);
    LAS int* ebase = (LAS int*)(F.lds + LDS_X_OFF + 4096 + 1024);
    const int chunk = (nrows + F.G - 1) / F.G;
    const int rA = F.vcu * chunk, rB = (rA + chunk < nrows) ? rA + chunk : nrows;
    const int e = F.lane & 31, kh = F.lane >> 5;
    float wreg[64];
    { const float* wr = INP(I_WROUTER) + (size_t)l * DM * NEXP + e;
#pragma unroll
      for (int m = 0; m < 64; ++m) { const int sidx = 128 * F.wave + 2 * m + kh; wreg[m] = wr[(size_t)(4 * (sidx & 255) + (sidx >> 8)) * NEXP]; } }
    const float* MOD = (const float*)(F.ws + WS_MOD) + (size_t)l * 3 * 6144;
    const float* XW = (const float*)(F.ws + WS_XW);
    __syncthreads();
    f32x4 v[3][4] = {};
#define RT_ROWS(r0_) do { const int nr_ = ((r0_) + RT_R < rB) ? RT_R : rB - (r0_); _Pragma("unroll") for (int t = 0; t < 3; ++t) { const int rr = F.wave + 8 * t; if (rr < nr_) { \
        const f32x4* xr = (const f32x4*)(XW + (size_t)((r0_) + rr) * DM) + F.lane; _Pragma("unroll") for (int j = 0; j < 4; ++j) v[t][j] = xr[64 * j]; } } } while (0)
    if (rA < rB) RT_ROWS(rA);
    for (int r0 = rA; r0 < rB; r0 += RT_R) {
        const int nr = (r0 + RT_R < rB) ? RT_R : rB - r0;
        {
#pragma unroll
            for (int t = 0; t < 3; ++t) { const int rr = F.wave + 8 * t;
              if (rr < nr) { const int row = r0 + rr; float ss = 0.f;
                const float* md = MOD + (size_t)modrow_of(row) * 6144;
                f32x4 sh[4], sc[4];
#pragma unroll
                for (int j = 0; j < 4; ++j) { const int c = 4 * F.lane + 256 * j; sh[j] = *(const f32x4*)(md + 3072 + c); sc[j] = *(const f32x4*)(md + 4096 + c); }
#pragma unroll
                for (int j = 0; j < 4; ++j) ss += (v[t][j].x * v[t][j].x + v[t][j].y * v[t][j].y) + (v[t][j].z * v[t][j].z + v[t][j].w * v[t][j].w);
                const float rstd = rsqrtf(wave_sum(ss) * (1.f / DM) + EPS);
                unsigned* o = (unsigned*)((unsigned char*)(F.ws + WS_HX) + (size_t)row * DM) + F.lane;
#pragma unroll
                for (int j = 0; j < 4; ++j) {
                    const f32x4 h = v[t][j] * rstd * (sc[j] + 1.0f) + sh[j]; o[64 * j] = pk4_fp8(h.x, h.y, h.z, h.w);
                    LAS float* d = hsT + (F.lane + 64 * j) * RT_P + rr;
                    d[0] = h.x; d[256 * RT_P] = h.y; d[512 * RT_P] = h.z; d[768 * RT_P] = h.w; } } }
            if (r0 + RT_R < rB) RT_ROWS(r0 + RT_R);
        }
        __syncthreads();
        {
            f32x16 D = {};
            const LAS float* hp = hsT + (128 * F.wave + kh) * RT_P + e;
#pragma unroll
            for (int m0 = 0; m0 < 64; m0 += 8) { float av[8];
#pragma unroll
                for (int q = 0; q < 8; ++q) av[q] = hp[(2 * (m0 + q)) * RT_P];
#pragma unroll
                for (int q = 0; q < 8; ++q) D = __builtin_amdgcn_mfma_f32_32x32x2f32(av[q], wreg[m0 + q], D, 0, 0, 0); }
#pragma unroll
            for (int r = 0; r < 16; ++r) { const int row = (r & 3) + 8 * (r >> 2) + 4 * kh; if (row < nr) part[(row * 8 + F.wave) * 32 + e] = D[r]; }
        }
        __syncthreads();
        for (int i = F.tid; i < nr * 32; i += 512) { const int r = i >> 5, ee = i & 31; float sacc = INP(I_BROUTER)[l * NEXP + ee];
#pragma unroll
            for (int w = 0; w < 8; ++w) sacc += part[(r * 8 + w) * 32 + ee];
            lgs[i] = sacc; }
        __syncthreads();
        for (int i = F.tid; i < nr * 32; i += 512) { const int r = i >> 5, ee = i & 31; const float mine = lgs[i]; int rank = 0;
#pragma unroll
            for (int q = 0; q < 8; ++q) { const f32x4 o4 = *(const LAS f32x4*)(lgs + r * 32 + 4 * q);
                rank += (o4.x > mine || (o4.x == mine && 4 * q + 0 < ee)) ? 1 : 0; rank += (o4.y > mine || (o4.y == mine && 4 * q + 1 < ee)) ? 1 : 0;
                rank += (o4.z > mine || (o4.z == mine && 4 * q + 2 < ee)) ? 1 : 0; rank += (o4.w > mine || (o4.w == mine && 4 * q + 3 < ee)) ? 1 : 0; }
            if (rank < 4) { tk_e[(r0 - rA + r) * 4 + rank] = ee; tval[r * 4 + rank] = mine; } }
        __syncthreads();
        for (int i = F.tid; i < nr * 4; i += 512) { const int r = i >> 2; const f32x4 t4 = *(const LAS f32x4*)(tval + r * 4);
            const float e1 = __expf(t4.y - t4.x), e2 = __expf(t4.z - t4.x), e3 = __expf(t4.w - t4.x), inv = __builtin_amdgcn_rcpf(1.0f + e1 + e2 + e3); const int k = i & 3;
            tk_w[(r0 - rA) * 4 + i] = (k == 0 ? 1.0f : k == 1 ? e1 : k == 2 ? e2 : e3) * inv; }
        __syncthreads();
    }
#undef RT_ROWS
    const int nent = (rB > rA ? rB - rA : 0) * 4;
    const int myent = F.tid < nent ? tk_e[F.tid] : -1; int rank_w = 0;
#pragma unroll 4
    for (int ee = 0; ee < 32; ++ee) { const unsigned long long m = __ballot(myent == ee); if (myent == ee) rank_w = __popcll(m & ((1ull << F.lane) - 1ull)); if (F.lane == 0) wcnt[F.wave * 32 + ee] = __popcll(m); }
    __syncthreads();
    if (F.tid < 32) { int c = 0;
#pragma unroll
        for (int w = 0; w < 8; ++w) { const int t = wcnt[w * 32 + F.tid]; wcnt[w * 32 + F.tid] = c; c += t; }
        unsigned* cnt = (unsigned*)(F.ws + WS_CTL) + CW_CNT + cbank * 4096 + l * 64 + F.tid;
        ebase[F.tid] = c ? (int)__hip_atomic_fetch_add(cnt, (unsigned)c, __ATOMIC_RELAXED, __HIP_MEMORY_SCOPE_AGENT) : 0; }
    __syncthreads();
    LAS int* tk_pos = (LAS int*)(F.lds + LDS_X_OFF + 5632);
    if (F.tid < nent) { const int pos = ebase[myent] + wcnt[F.wave * 32 + myent] + rank_w; const size_t gi = (size_t)rA * 4 + F.tid;
        ((unsigned*)(F.ws + WS_TSLOT))[gi] = ((unsigned)myent << 16) | (unsigned)pos; ((float*)(F.ws + WS_TW))[gi] = tk_w[F.tid]; tk_pos[F.tid] = pos; }
    asm volatile("s_waitcnt vmcnt(0)" ::: "memory");
    __syncthreads();
    {
        u32x4 v[4] = {}; size_t dst[4] = {};
#define RC_LOAD(i0_) _Pragma("unroll") for (int q = 0; q < 4; ++q) { const int i = (i0_) + 8 * q; const bool ok = i < nent; const int ii = ok ? i : (i0_); \
            dst[q] = (size_t)tk_e[ii] * CAPR + tk_pos[ii]; v[q] = ((const u32x4*)((const unsigned char*)(F.ws + WS_HX) + (size_t)(rA + (ii >> 2)) * DM))[F.lane]; }
        if (F.wave < nent) { RC_LOAD(F.wave) }
        for (int i0 = F.wave; i0 < nent; i0 += 32) {
            u32x4 cv[4]; size_t cd[4];
#pragma unroll
            for (int q = 0; q < 4; ++q) { cv[q] = v[q]; cd[q] = dst[q]; }
            if (i0 + 32 < nent) { RC_LOAD(i0 + 32) }
#pragma unroll
            for (int q = 0; q < 4; ++q) { const int i = i0 + 8 * q; if (i < nent) {
                ((u32x4*)((unsigned char*)(F.ws + WS_HXS) + cd[q] * DM))[F.lane] = cv[q];
                if (F.lane == 0) ((float*)(F.ws + WS_WSLOT))[cd[q]] = tk_w[i]; } }
        }
#undef RC_LOAD
    }
    __syncthreads();
}

__device__ __forceinline__ void moe_tables(Frame& F, int l) {
    LAS int* cum = (LAS int*)(F.lds + LDS_X_OFF + 8192); LAS int* texp = (LAS int*)(F.lds + LDS_X_OFF + 8192 + 256); LAS int* ntl = (LAS int*)(F.lds + LDS_X_OFF + 8192 + 256 + 1280);
    __syncthreads();
    if (F.tid < NEXP) { const unsigned* cnt = (const unsigned*)(F.ws + WS_CTL) + CW_CNT + l * 64;
        ntl[F.tid] = ((int)__hip_atomic_load(cnt + F.tid, __ATOMIC_RELAXED, __HIP_MEMORY_SCOPE_AGENT) + 255) >> 8; }
    __syncthreads();
    if (F.tid < NEXP) { int t = 0; for (int e = 0; e < F.tid; ++e) t += ntl[e]; const int n = ntl[F.tid];
        cum[F.tid] = t; if (F.tid == NEXP - 1) cum[NEXP] = t + n;
        for (int i = 0; i < n; ++i) texp[t + i] = F.tid; }
    __syncthreads();
}
__device__ __forceinline__ void p_scatter(Frame& F, int nrows) {
    const LAS int* cum = (const LAS int*)(F.lds + LDS_X_OFF + 8192);
    const int gw = F.vcu * 8 + F.wave, NGW = F.G * 8, nent = nrows * 4;
    for (int i0 = gw * 4; i0 < nent; i0 += NGW * 4) {
        const int row = i0 >> 2;
        const u32x4 ts = *(const u32x4*)((const unsigned*)(F.ws + WS_TSLOT) + i0);
        const f32x4 tw = *(const f32x4*)((const float*)(F.ws + WS_TW) + i0);
        const u32x4 o = ((const u32x4*)((const unsigned char*)(F.ws + WS_HX) + (size_t)row * DM))[F.lane];
#pragma unroll
        for (int k = 0; k < 4; ++k) { const unsigned t = ts[k]; const int slot = cum[t >> 16] * 256 + (int)(t & 0xffff);
            ((u32x4*)((unsigned char*)(F.ws + WS_HXS) + (size_t)slot * DM))[F.lane] = o;
            if (F.lane == 0) ((float*)(F.ws + WS_WSLOT))[slot] = tw[k]; }
    }
}
struct SchedMoe {
    const char* A; const char* B; size_t bstride; int G, c, ncol, total; const LAS int* texp; const LAS int* cum; size_t acap;
    __device__ __forceinline__ bool next(int i, g8::Unit& u) const {
        const int L = i * G + c; if (L >= total) return false;
        const int gt = L / ncol, pn = L % ncol; const int e = __builtin_amdgcn_readfirstlane(texp[gt]);
        const size_t arow = acap ? (size_t)e * acap + (size_t)(gt - __builtin_amdgcn_readfirstlane(cum[e])) * 256 : (size_t)gt * 256;
        u.A = A + arow * 1024; u.B = B + (size_t)e * bstride + (size_t)pn * 256 * 1024; u.nt = 8; u.pm = gt; u.pn = pn; u.aux = e; return true;
    }
};
struct EpiUp {
    static constexpr bool PERM = true; static constexpr int NAUX = 4;
    unsigned char* HID; const float* bgu;
    __device__ __forceinline__ const float* aux_src(const g8::Unit& u, int piece) const { return bgu + (size_t)u.aux * 2048 + (piece >> 1) * 1024 + u.pn * 128 + (piece & 1) * 64; }
    __device__ __forceinline__ bool operator()(f32x4 (&acc)[2][2][4][2], const g8::Unit& u, int wr, int wc, int fr, int fq, const LAS float* aux) const {
        const int row0 = u.pm * 256 + wr * 64 + fr, hl = wc * 32 + 8 * fq, hc0 = u.pn * 128 + hl;
        f32x4 bgt[2], bup[2];
#pragma unroll
        for (int n = 0; n < 2; ++n) { bgt[n] = *(const LAS f32x4*)(aux + hl + 4 * n); bup[n] = *(const LAS f32x4*)(aux + 128 + hl + 4 * n); }
#pragma unroll
        for (int ai = 0; ai < 2; ++ai)
#pragma unroll
            for (int m = 0; m < 4; ++m) { float h[8];
#pragma unroll
                for (int n = 0; n < 2; ++n) { const f32x4 g4 = acc[ai][0][m][n] * 0.015625f + bgt[n], u4 = acc[ai][1][m][n] * 0.015625f + bup[n];
#pragma unroll
                    for (int j = 0; j < 4; ++j) { const float g = fminf(g4[j], 7.0f), up = fminf(fmaxf(u4[j], -7.0f), 7.0f); h[4 * n + j] = __builtin_fmaf(up, g, g) * __builtin_amdgcn_rcpf(1.0f + __builtin_amdgcn_exp2f(g * -2.4554669595930157f)); } }
                u32x2 w; w.x = pk4_fp8(h[0], h[1], h[2], h[3]); w.y = pk4_fp8(h[4], h[5], h[6], h[7]);
                *(u32x2*)(HID + (size_t)(row0 + ai * 128 + m * 16) * DM + hc0) = w; }
        return false;
    }
};
struct EpiDown {
    static constexpr bool PERM = true; static constexpr int NAUX = 4;
    bf16_t* Y; const float* bdn; const float* wslot; const LAS int* cum;
    __device__ __forceinline__ const float* aux_src(const g8::Unit& u, int piece) const { return bdn + (size_t)u.aux * DM + u.pn * 256 + piece * 64; }
    __device__ __forceinline__ bool operator()(f32x4 (&acc)[2][2][4][2], const g8::Unit& u, int wr, int wc, int fr, int fq, const LAS float* aux) const {
        const int cl = wc * 32 + 8 * fq, col0 = u.pn * 256 + cl;
        f32x4 bv[2][2];
#pragma unroll
        for (int bj = 0; bj < 2; ++bj)
#pragma unroll
            for (int n = 0; n < 2; ++n) bv[bj][n] = *(const LAS f32x4*)(aux + bj * 128 + cl + 4 * n);
#pragma unroll
        for (int ai = 0; ai < 2; ++ai)
#pragma unroll
            for (int m = 0; m < 4; ++m) { const int rl = ai * 128 + wr * 64 + m * 16 + fr; bf16_t* rowp = Y + (size_t)(u.pm * 256 + rl) * DM + col0;
#pragma unroll
                for (int bj = 0; bj < 2; ++bj) { const f32x4 v0 = acc[ai][bj][m][0] * 0.015625f + bv[bj][0], v1 = acc[ai][bj][m][1] * 0.015625f + bv[bj][1];
                    u32x4 w; w.x = cvt_pk_bf16(v0[0], v0[1]); w.y = cvt_pk_bf16(v0[2], v0[3]); w.z = cvt_pk_bf16(v1[0], v1[1]); w.w = cvt_pk_bf16(v1[2], v1[3]);
                    *(u32x4*)(rowp + bj * 128) = w; } }
        return false;
    }
};

struct SchedMerge {
    const char* ws; size_t woff; int G, c, nM, total;
    __device__ __forceinline__ bool next(int i, g8::Unit& u) const {
        const int br = i % 3, T = (i / 3) * G + c; if (T >= total) return false;
        int pm, pn; g8::tile_order(T, nM, 4, pm, pn);
        const size_t aoff = WS_ATT + (br > 0 ? (WS_FX - WS_ATT) : 0) + (br > 1 ? (WS_SG - WS_FX) : 0);
        const size_t boff = WS_WA + (br > 0 ? (WS_WFP - WS_WA) : 0) + (br > 1 ? (WS_WS - WS_WFP) : 0);
        u.A = ws + aoff + (size_t)pm * 256 * 2048; u.B = ws + boff + woff + (size_t)pn * 256 * 2048; u.nt = br == 2 ? 8 : 16; u.pm = pm; u.pn = pn; u.aux = br; return true;
    }
};
struct EpiMerge {
    static constexpr bool PERM = true; static constexpr int NAUX = 0;
    const bf16_t* GT; bf16_t* MRG;
    __device__ __forceinline__ bool operator()(f32x4 (&acc)[2][2][4][2], const g8::Unit& u, int wr, int wc, int fr, int fq, const LAS float* aux) const {
        const int row0 = u.pm * 256 + wr * 64 + fr, col0 = u.pn * 256 + wc * 32 + 8 * fq, br = u.aux;
        const bf16_t* gp = GT + (size_t)row0 * 3072 + br * 1024 + col0;
        if (br < 2) {
#pragma unroll
            for (int ai = 0; ai < 2; ++ai) { u32x4 gw[4][2], hw[4][2];
#pragma unroll
                for (int m = 0; m < 4; ++m)
#pragma unroll
                    for (int bj = 0; bj < 2; ++bj) { const bf16_t* p = gp + (size_t)(ai * 128 + m * 16) * 3072 + bj * 128; gw[m][bj] = *(const u32x4*)p; hw[m][bj] = *(const u32x4*)(p + 1024); }
#pragma unroll
                for (int m = 0; m < 4; ++m)
#pragma unroll
                    for (int bj = 0; bj < 2; ++bj) { const u32x4 g4 = gw[m][bj], h4 = hw[m][bj];
                        const float g[8] = {bf_lo(g4.x), bf_hi(g4.x), bf_lo(g4.y), bf_hi(g4.y), bf_lo(g4.z), bf_hi(g4.z), bf_lo(g4.w), bf_hi(g4.w)};
                        const float h[8] = {bf_lo(h4.x), bf_hi(h4.x), bf_lo(h4.y), bf_hi(h4.y), bf_lo(h4.z), bf_hi(h4.z), bf_lo(h4.w), bf_hi(h4.w)};
#pragma unroll
                        for (int j = 0; j < 8; ++j) { const float gg = br > 0 ? fmaxf(g[j], 1e-20f) : g[j]; acc[ai][bj][m][j >> 2][j & 3] *= gg * __builtin_amdgcn_rcpf(fmaxf(h[j], 1e-20f)); } } }
        } else {
            u32x4 gw[2][4][2];
#pragma unroll
            for (int ai = 0; ai < 2; ++ai)
#pragma unroll
                for (int m = 0; m < 4; ++m)
#pragma unroll
                    for (int bj = 0; bj < 2; ++bj) gw[ai][m][bj] = *(const u32x4*)(gp + (size_t)(ai * 128 + m * 16) * 3072 + bj * 128);
#pragma unroll
            for (int ai = 0; ai < 2; ++ai)
#pragma unroll
                for (int m = 0; m < 4; ++m)
#pragma unroll
                    for (int bj = 0; bj < 2; ++bj) { const u32x4 g4 = gw[ai][m][bj];
                        const float g[8] = {bf_lo(g4.x), bf_hi(g4.x), bf_lo(g4.y), bf_hi(g4.y), bf_lo(g4.z), bf_hi(g4.z), bf_lo(g4.w), bf_hi(g4.w)};
                        float v[8];
#pragma unroll
                        for (int j = 0; j < 8; ++j) v[j] = fmaxf(g[j], 1e-20f) * acc[ai][bj][m][j >> 2][j & 3];
                        u32x4 w; w.x = cvt_pk_bf16(v[0], v[1]); w.y = cvt_pk_bf16(v[2], v[3]); w.z = cvt_pk_bf16(v[4], v[5]); w.w = cvt_pk_bf16(v[6], v[7]);
                        *(u32x4*)(MRG + (size_t)(row0 + ai * 128 + m * 16) * DM + col0 + bj * 128) = w; }
        }
        return br < 2;
    }
};
struct SchedPlain {
    const char* A; const char* B; int G, c, nM, nN, nt;
    __device__ __forceinline__ bool next(int i, g8::Unit& u) const {
        const int L = i * G + c; if (L >= nM * nN) return false;
        int pm, pn; g8::tile_order(L, nM, nN, pm, pn);
        u.A = A + (size_t)pm * 256 * 2048; u.B = B + (size_t)pn * 256 * 2048; u.nt = nt; u.pm = pm; u.pn = pn; u.aux = 0; return true;
    }
};
struct EpiOut {
    static constexpr bool PERM = false; static constexpr int NAUX = 0;
    const float* rx; const float* rc; float* XW; const float* mod;
    __device__ __forceinline__ bool operator()(f32x4 (&acc)[2][2][4][2], const g8::Unit& u, int wr, int wc, int fr, int fq, const LAS float* aux) const {
        const int row0 = u.pm * 256 + wr * 64 + fr, col0 = u.pn * 256 + wc * 32 + 4 * fq;
        const float* res = u.pm < 64 ? rx : rc; const float* g1 = mod + (size_t)(u.pm < 32 ? 0 : (u.pm < 64 ? 1 : 2)) * 6144 + 2048;
        f32x4 gv[2][2];
#pragma unroll
        for (int bj = 0; bj < 2; ++bj)
#pragma unroll
            for (int n = 0; n < 2; ++n) gv[bj][n] = *(const f32x4*)(g1 + col0 + bj * 128 + n * 16);
        f32x4 r0[8], r1[8];
#define EO_OFF(gi, mm) ((size_t)(row0 + ((gi) >> 1) * 128 + ((((gi) & 1) << 1) + (mm)) * 16) * DM + col0)
#define EO_LD(r, gi) _Pragma("unroll") for (int mm = 0; mm < 2; ++mm) _Pragma("unroll") for (int bj = 0; bj < 2; ++bj) _Pragma("unroll") for (int n = 0; n < 2; ++n) \
            r[mm * 4 + bj * 2 + n] = *(const f32x4*)(res + EO_OFF(gi, mm) + bj * 128 + n * 16);
#define EO_ST(r, gi) _Pragma("unroll") for (int mm = 0; mm < 2; ++mm) _Pragma("unroll") for (int bj = 0; bj < 2; ++bj) _Pragma("unroll") for (int n = 0; n < 2; ++n) \
            *(f32x4*)(XW + EO_OFF(gi, mm) + bj * 128 + n * 16) = r[mm * 4 + bj * 2 + n] + gv[bj][n] * acc[(gi) >> 1][bj][(((gi) & 1) << 1) + mm][n];
        EO_LD(r0, 0) EO_LD(r1, 1)
        EO_ST(r0, 0) EO_LD(r0, 2)
        EO_ST(r1, 1) EO_LD(r1, 3)
        EO_ST(r0, 2) EO_ST(r1, 3)
#undef EO_OFF
#undef EO_LD
#undef EO_ST
        return false;
    }
};

__device__ __forceinline__ void p_combine(Frame& F, int l, int nrows, bool last) {
    const LAS int* cum = (const LAS int*)(F.lds + LDS_X_OFF + 8192);
    const int gw = F.vcu * 8 + F.wave, NGW = F.G * 8;
    const float* MOD = (const float*)(F.ws + WS_MOD) + (size_t)l * 3 * 6144;
    const bool poison = last && __hip_atomic_load((const unsigned*)(F.ws + WS_CTL) + CW_BAR + XB_TMO, __ATOMIC_RELAXED, __HIP_MEMORY_SCOPE_AGENT) != 0u;
    const float qn = __builtin_nanf("");
    float* outp = last ? OUTP() : (float*)(F.ws + WS_XW);
    const bf16_t* Y = (const bf16_t*)(F.ws + WS_Y);
    const float* MODN = MOD + 3 * 6144;
    u32x4 w[4][2] = {}; f32x4 xv[2][2] = {}, gv[2][2] = {}, shv[2][2] = {}, scv[2][2] = {}, twv = {};
#define CB_ISSUE(r_, ts_, W, XV, GV, SHV, SCV) do { twv = *(const f32x4*)((const float*)(F.ws + WS_TW) + (size_t)(r_) * 4); \
        const u32x4* y0 = (const u32x4*)(Y + (size_t)(cum[(ts_).x >> 16] * 256 + (int)((ts_).x & 0xffff)) * DM) + F.lane; \
        const u32x4* y1 = (const u32x4*)(Y + (size_t)(cum[(ts_).y >> 16] * 256 + (int)((ts_).y & 0xffff)) * DM) + F.lane; \
        const u32x4* y2 = (const u32x4*)(Y + (size_t)(cum[(ts_).z >> 16] * 256 + (int)((ts_).z & 0xffff)) * DM) + F.lane; \
        const u32x4* y3 = (const u32x4*)(Y + (size_t)(cum[(ts_).w >> 16] * 256 + (int)((ts_).w & 0xffff)) * DM) + F.lane; \
        _Pragma("unroll") for (int j = 0; j < 2; ++j) { W[0][j] = y0[64 * j]; W[1][j] = y1[64 * j]; W[2][j] = y2[64 * j]; W[3][j] = y3[64 * j]; } \
        const float* xr_ = (const float*)(F.ws + WS_XW) + (size_t)(r_) * DM; const int mr_ = modrow_of(r_); const float* g2_ = MOD + (size_t)mr_ * 6144 + 5120; const float* md_ = MODN + (size_t)mr_ * 6144; \
        _Pragma("unroll") for (int j = 0; j < 2; ++j) { const int c = 8 * F.lane + 512 * j; XV[j][0] = *(const f32x4*)(xr_ + c); XV[j][1] = *(const f32x4*)(xr_ + c + 4); GV[j][0] = *(const f32x4*)(g2_ + c); GV[j][1] = *(const f32x4*)(g2_ + c + 4); \
            if (!last) { SHV[j][0] = *(const f32x4*)(md_ + c); SHV[j][1] = *(const f32x4*)(md_ + c + 4); SCV[j][0] = *(const f32x4*)(md_ + 1024 + c); SCV[j][1] = *(const f32x4*)(md_ + 1024 + c + 4); } } } while (0)
    if (gw < nrows) { const u32x4 ts0 = *(const u32x4*)((const unsigned*)(F.ws + WS_TSLOT) + (size_t)gw * 4); CB_ISSUE(gw, ts0, w, xv, gv, shv, scv); }
    for (int row = gw; row < nrows; row += NGW) {
        const int nrow = row + NGW; const bool hn = nrow < nrows;
        u32x4 tsn = {}; if (hn) tsn = *(const u32x4*)((const unsigned*)(F.ws + WS_TSLOT) + (size_t)nrow * 4);
        f32x4 xn[2][2]; const f32x4 tw = twv;
#pragma unroll
        for (int j = 0; j < 2; ++j) {
            f32x4 a0 = (f32x4){0.f, 0.f, 0.f, 0.f}, a1 = a0;
#pragma unroll
            for (int k = 0; k < 4; ++k) { const u32x4 q = w[k][j]; a0 += (f32x4){bf_lo(q.x), bf_hi(q.x), bf_lo(q.y), bf_hi(q.y)} * tw[k]; a1 += (f32x4){bf_lo(q.z), bf_hi(q.z), bf_lo(q.w), bf_hi(q.w)} * tw[k]; }
            f32x4 r0 = xv[j][0] + gv[j][0] * a0, r1 = xv[j][1] + gv[j][1] * a1;
            if (poison) { r0 = (f32x4){qn, qn, qn, qn}; r1 = r0; }
            xn[j][0] = r0; xn[j][1] = r1;
        }
        f32x4 sh[2][2], sc[2][2];
#pragma unroll
        for (int j = 0; j < 2; ++j)
#pragma unroll
            for (int q = 0; q < 2; ++q) { sh[j][q] = shv[j][q]; sc[j][q] = scv[j][q]; }
        if (hn) CB_ISSUE(nrow, tsn, w, xv, gv, shv, scv);
#pragma unroll
        for (int j = 0; j < 2; ++j) { const int c = 8 * F.lane + 512 * j; *(f32x4*)(outp + (size_t)row * DM + c) = xn[j][0]; *(f32x4*)(outp + (size_t)row * DM + c + 4) = xn[j][1]; }
        if (!last) {
            float ss = 0.f;
#pragma unroll
            for (int j = 0; j < 2; ++j)
#pragma unroll
                for (int q = 0; q < 2; ++q) ss += (xn[j][q].x * xn[j][q].x + xn[j][q].y * xn[j][q].y) + (xn[j][q].z * xn[j][q].z + xn[j][q].w * xn[j][q].w);
            const float rstd = rsqrtf(wave_sum(ss) * (1.f / DM) + EPS);
#pragma unroll
            for (int j = 0; j < 2; ++j) { const int c = 8 * F.lane + 512 * j;
                const f32x4 h0 = xn[j][0] * rstd * (sc[j][0] + 1.0f) + sh[j][0], h1 = xn[j][1] * rstd * (sc[j][1] + 1.0f) + sh[j][1];
                u32x2 w2; w2.x = pk4_fp8(h0.x, h0.y, h0.z, h0.w); w2.y = pk4_fp8(h1.x, h1.y, h1.z, h1.w);
                *(u32x2*)((unsigned char*)(F.ws + WS_HX8) + (size_t)row * DM + c) = w2; }
        }
    }
#undef CB_ISSUE
}

#ifndef EPI_ALIGN
#define EPI_ALIGN true
#endif
#ifndef BF_SP2
#define BF_SP2 true
#endif
#ifndef MOE_SP2
#define MOE_SP2 true
#endif
#ifndef DUP
#define DUP 0
#endif
#define REPB(bit, stmt) do { stmt; if (DUP & (bit)) { GRID_BAR(); refresh(F); stmt; } } while (0)
#define REP(bit) for (int rep_ = 0; rep_ < ((DUP & (bit)) ? 2 : 1); ++rep_)
#ifndef PHM
#define PHM 0xffff
#endif
__global__ void __launch_bounds__(512, 2) mk_fwd(KArgs args) {
    extern __shared__ __attribute__((aligned(16))) unsigned char lds_raw[];
    Frame F;
    F.lds = (LAS unsigned char*)lds_raw; F.ws = args.ws;
    F.tid = threadIdx.x; F.lane = F.tid & 63; F.wave = __builtin_amdgcn_readfirstlane(F.tid >> 6);
    F.G = gridDim.x; { const int bx = blockIdx.x; F.vcu = (F.G % 8 == 0) ? (bx % 8) * (F.G / 8) + bx / 8 : bx; }
    volatile LAS unsigned* MISC = (volatile LAS unsigned*)(F.lds + LDS_MISC_OFF);
    for (int u = F.tid; u < (LDS_BYTES - LDS_MISC_OFF) / 4; u += 512) MISC[u] = 0u;
    __syncthreads();
    XcdBarrier bar = xcd_barrier_post((unsigned*)(F.ws + WS_CTL) + CW_BAR, MISC + 8);
    const int bid = (int)blockIdx.x;
#define GRID_BAR() do { XcdBarrier b_ = bar; b_.seam = (unsigned)(__LINE__); asm volatile("" : "+s"(b_.x)); asm volatile("" : "+s"(b_.bar)); asm volatile("" : "+s"(b_.wave)); xcd_barrier(b_); if (DUP & 16384) xcd_barrier(b_); } while (0)

    refresh(F);
    REP(1) if (PHM & 1) p0_prologue(F);
    GRID_BAR();

    FillCur FC; FC.c0 = 0; FC.c1 = 0;
    for (int l_ = 0; l_ < DEPTH; ++l_) {
        const int l = launder_s(l_);
        const bool last = (l == DEPTH - 1);
        const int nrows = last ? NXR : NROW;
        const bf16_t* HX = (const bf16_t*)(F.ws + WS_HX);
        refresh(F);
        if (l == 0) { p_norm1(F, l, NROW); GRID_BAR(); }
        refresh(F);
        REP(4) if (PHM & 4) {
            SchedIn S{(const char*)(F.ws + WS_HX8), (const char*)(F.ws + WS_WIN) + (size_t)l * IN_DIM * DM, F.G, bid, 64 * 24 + (last ? 4 : 48), last ? 1 : 0};
            EpiIn E{(bf16_t*)(F.ws + WS_PX), (bf16_t*)(F.ws + WS_GT), INP(I_BGATE) + (size_t)l * 3072};
            g8::gemm_phase<EpiIn, SchedIn, true, BF_SP2, EPI_ALIGN>(F.lds, S, E, F.tid);
            fill_after(F, FC, l, 64 * 24 + (last ? 4 : 48), bid, 4);
        }
        GRID_BAR();
        refresh(F);
        if (PHM & 8) p_postproj(F, l, NROW);
        refresh(F);
        p_vblocks(F);
        refresh(F);
        if (PHM & 16) {
            const bf16_t* PX = (const bf16_t*)(F.ws + WS_PX);
            for (int u = F.vcu; u < 512; u += F.G) {
                const int n1 = u >> 3, b = (u >> 2) & 1, cb = u & 3;
                EpiStore2 E{(bf16_t*)(F.ws + WS_Y1) + ((size_t)b * 128 * 2 * 64 + n1) * 512 + cb * 128, 128, (size_t)2 * 64 * 512, (size_t)64 * 512};
                lm_unit<256, 128>(F, (const bf16_t*)(F.ws + WS_T1) + (size_t)n1 * 256 * 128, PX + ((size_t)b * SEQ + n1) * PXW + F_OFF + cb * 128, (size_t)64 * PXW, E);
            }
            if (!last) for (int u = (F.G >= 16 ? F.vcu - (F.G - 8) : F.vcu); u < 8; u += F.G) {
                if (u < 0) continue;
                const int b = u >> 2, cb = u & 3;
                EpiStore2 E{(bf16_t*)(F.ws + WS_FX) + (size_t)(NXR + b * CTX) * DM + cb * 128, 256, (size_t)DM, (size_t)512};
                lm_unit<512, 256>(F, (const bf16_t*)(F.ws + WS_TC), PX + (size_t)(NXR + b * CTX) * PXW + F_OFF + cb * 128, (size_t)PXW, E);
            }
        }
        GRID_BAR();
        refresh(F);
        REP(32) if (PHM & 32) {
            const unsigned char* QN = (const unsigned char*)(F.ws + WS_QN); const unsigned char* KN = (const unsigned char*)(F.ws + WS_KN); const unsigned char* VT = (const unsigned char*)(F.ws + WS_VN); bf16_t* ATT = (bf16_t*)(F.ws + WS_ATT);
            REP(8192) for (int u = bid; u < 512; u += F.G) {
                const int b = u >> 8, kvh = (u >> 7) & 1, hq = (u >> 5) & 3, qb = u & 31, h = kvh * 4 + hq;
                const size_t q0 = ((size_t)b * SEQ + qb * 256) * DM + h * 128, k0 = (size_t)b * LK * 256 + kvh * 128;
                att::attn_dense_body(QN + q0, KN + k0, VT + (size_t)((b * 2 + kvh) * 132) * 8192, ATT + q0, LK, (char*)lds_raw, F.tid);
            }
            if (!last) for (int u = bid; u < 16; u += F.G) {
                const int b = u >> 3, h = u & 7, kvh = h >> 2;
                const size_t q0 = (size_t)(NXR + b * CTX) * DM + h * 128, k0 = ((size_t)b * LK + SEQ) * 256 + kvh * 128;
                att::attn_dense_body(QN + q0, KN + k0, VT + (size_t)((b * 2 + kvh) * 132 + 128) * 8192, ATT + q0, CTX, (char*)lds_raw, F.tid);
            }
            refresh(F);
            const unsigned lo0 = lm_dma_lane_off(F.wave, F.lane, 0, 512u), lo1 = lm_dma_lane_off(F.wave, F.lane, 1, 512u);
            {
                const bf16_t* T2 = (const bf16_t*)(F.ws + WS_T2);
#define P2_IN(uu) ((const bf16_t*)(F.ws + WS_Y1) + ((size_t)((uu) >> 9) * 128 + (((uu) >> 2) & 127)) * 2 * 64 * 512 + ((uu) & 3) * 128)
                int p = F.vcu, buf = 0;
                __syncthreads();
                if (p < 512) lm_dma_pair(F, P2_IN(2 * p), P2_IN(2 * p + 1), 512u, 0, lo0, lo1);
                for (; p < 512; p += F.G) {
                    asm volatile("s_waitcnt vmcnt(0)" ::: "memory"); __syncthreads();
                    bf16x8 pw[2][4]; lm_load_w(F, pw, T2);
                    if (p + F.G < 512) lm_dma_pair(F, P2_IN(2 * (p + F.G)), P2_IN(2 * (p + F.G) + 1), 512u, (buf ^ 1) * 65536, lo0, lo1);
                    const int u = 2 * p + (F.wave >> 2), b = u >> 9, k2 = (u >> 2) & 127, cb = u & 3;
                    EpiStore2 E{(bf16_t*)(F.ws + WS_FX) + ((size_t)b * SEQ + k2) * DM + cb * 128, 64, (size_t)128 * DM, (size_t)512};
                    lm_pair_compute(F, pw, buf * 65536, E);
                    buf ^= 1;
                }
#undef P2_IN
            }
            {
                const int np = (nrows / 128) * 2;
                const bf16_t* WSPl = (const bf16_t*)(F.ws + WS_WSP) + (size_t)l * 4 * 128 * 128;
#define SG_IN(uu) ((const bf16_t*)(F.ws + WS_VGN) + (size_t)((uu) >> 2) * 128 * 512 + ((uu) & 3) * 128)
                int p = F.vcu, buf = 0;
                __syncthreads();
                if (p < np) lm_dma_pair(F, SG_IN(2 * p), SG_IN(2 * p + 1), 512u, 0, lo0, lo1);
                for (; p < np; p += F.G) {
                    asm volatile("s_waitcnt vmcnt(0)" ::: "memory"); __syncthreads();
                    const int u = 2 * p + (F.wave >> 2), ch = u >> 2, g = u & 3; const size_t row0 = (size_t)ch * 128;
                    bf16x8 pw[2][4]; lm_load_w(F, pw, WSPl + (size_t)g * 128 * 128);
                    EpiSgu E{(bf16_t*)(F.ws + WS_SG) + row0 * DM + g * 128, (const bf16_t*)(F.ws + WS_PX) + row0 * PXW + U_OFF + g * 128, INP(I_BSPAT) + (size_t)l * 512 + g * 128};
                    u32x4 uw[8]; float ub[8]; E.pre((F.wave & 3) * 32, F.lane, uw, ub);
                    if (p + F.G < np) lm_dma_pair(F, SG_IN(2 * (p + F.G)), SG_IN(2 * (p + F.G) + 1), 512u, (buf ^ 1) * 65536, lo0, lo1);
                    {
                        const int pb = F.wave >> 2, rb = F.wave & 3;
                        const int vb0 = (int)(unsigned)(uintptr_t)F.lds + buf * 65536 + att::v_rd_base(F.lane) + pb * 32768;
                        f32x16 o[4] = {};
#pragma unroll
                        for (int t = 0; t < 2; ++t) att::pv_d0(o, vb0 + t * 16384, pw[t][0], pw[t][1], pw[t][2], pw[t][3]);
                        __syncthreads();
                        att::wave_rows_out_i(F.lds + buf * 65536 + F.wave * 8192, o, F.lane, [&](int i, int row, int col8, u32x4 v) { E.rows2(rb * 32 + row, col8, v, uw[i], ub[i]); });
                    }
                    buf ^= 1;
                }
#undef SG_IN
            }
            __syncthreads();
        }
        GRID_BAR();
        refresh(F);
        REP(64) if (PHM & 64) {
            const int nM = nrows / 256;
            SchedMerge S{(const char*)F.ws, (size_t)l * DM * DM * 2, F.G, bid, nM, nM * 4};
            EpiMerge E{(const bf16_t*)(F.ws + WS_GT), (bf16_t*)(F.ws + WS_MRG)};
            g8::gemm_phase<EpiMerge, SchedMerge, false, BF_SP2, true>(F.lds, S, E, F.tid);
            fill_after(F, FC, l, nM * 4, bid, 12);
        }
        GRID_BAR();
        refresh(F);
        for (int rep_ = 0; rep_ < (((DUP & 128) && l == 0) ? 2 : 1); ++rep_) {
            SchedPlain S{(const char*)(F.ws + WS_MRG), (const char*)((const bf16_t*)(F.ws + WS_WO) + (size_t)l * DM * DM), F.G, bid, nrows / 256, 4, 16};
            const float* XWc = (const float*)(F.ws + WS_XW);
            EpiOut E{l == 0 ? INP(I_X) : XWc, l == 0 ? INP(I_CTX) - (size_t)NXR * DM : XWc, (float*)(F.ws + WS_XW), (const float*)(F.ws + WS_MOD) + (size_t)l * 3 * 6144};
            g8::gemm_phase<EpiOut, SchedPlain, false, BF_SP2, true>(F.lds, S, E, F.tid);
            fill_after(F, FC, l, (nrows / 256) * 4, bid, 5);
        }
        GRID_BAR();
        refresh(F);
        if (DUP & 256) { p_route(F, l, nrows, 1); GRID_BAR(); refresh(F); }
        if (PHM & 256) p_route(F, l, nrows);
        refresh(F);
        fill_cleanup(F, FC, l);
        GRID_BAR();
        moe_tables(F, l);
        refresh(F);
        const LAS int* cum = (const LAS int*)(F.lds + LDS_X_OFF + 8192); const LAS int* texp = (const LAS int*)(F.lds + LDS_X_OFF + 8192 + 256);
        const int ntile = __builtin_amdgcn_readfirstlane(cum[NEXP]);
        int vup = bid, vdn = bid;
        if (F.G == 256) { const int x = bid & 7, r = bid >> 3; vup = (8 * (x >> 1) + (r >> 2)) * 8 + 4 * (x & 1) + (r & 3); vdn = (8 * x + (r >> 2)) * 4 + (r & 3); }
        refresh(F);
        REP(1024) if (PHM & 1024) {
            SchedMoe S{(const char*)(F.ws + WS_HXS), (const char*)(F.ws + WS_WGU) + (size_t)l * NEXP * 2048 * DM, (size_t)2048 * DM, F.G, vup, 8, ntile * 8, texp, cum, (size_t)CAPR};
            EpiUp E{(unsigned char*)(F.ws + WS_HID), INP(I_BGU) + (size_t)l * NEXP * 2048};
            g8::gemm_phase<EpiUp, SchedMoe, true, MOE_SP2, EPI_ALIGN>(F.lds, S, E, F.tid);
            if (!last) fill_after(F, FC, l + 1, ntile * 8, vup, 4);
        }
        GRID_BAR();
        refresh(F);
        REP(2048) if (PHM & 2048) {
            SchedMoe S{(const char*)(F.ws + WS_HID), (const char*)(F.ws + WS_WDN) + (size_t)l * NEXP * DM * DM, (size_t)DM * DM, F.G, vdn, 4, ntile * 4, texp, cum, (size_t)0};
            EpiDown E{(bf16_t*)(F.ws + WS_Y), INP(I_BDN) + (size_t)l * NEXP * DM, (const float*)(F.ws + WS_WSLOT), cum};
            g8::gemm_phase<EpiDown, SchedMoe, true, MOE_SP2, EPI_ALIGN>(F.lds, S, E, F.tid);
            if (!last) fill_after(F, FC, l + 1, ntile * 4, vdn, 2);
        }
        GRID_BAR();
        refresh(F);
        if (last) { REPB(4096, p_combine(F, l, nrows, last)); } else p_combine(F, l, nrows, last);
        GRID_BAR();
    }
}

extern "C" void kernel_launch(void* const* d_in, const int* in_sizes, int n_in, void* d_out, int out_size, void* d_ws, size_t ws_size, hipStream_t stream) {
    static int grid = 0;
    if (grid == 0) {
        if (n_in != 23 || out_size != NXR * DM || ws_size < WS_END) { fprintf(stderr, "kernel_launch: unexpected shapes: n_in %d out %d ws %zu (need %zu)\n", n_in, out_size, ws_size, (size_t)WS_END); grid = -1; return; }
        int dev = 0, cus = 0, per_cu = 0;
        if (hipGetDevice(&dev) != hipSuccess || hipDeviceGetAttribute(&cus, hipDeviceAttributeMultiprocessorCount, dev) != hipSuccess) { grid = -1; return; }
        if (hipFuncSetAttribute((const void*)mk_fwd, hipFuncAttributeMaxDynamicSharedMemorySize, LDS_BYTES) != hipSuccess) { fprintf(stderr, "kernel_launch: hipFuncSetAttribute failed\n"); grid = -1; return; }
        if (hipOccupancyMaxActiveBlocksPerMultiprocessor(&per_cu, (const void*)mk_fwd, 512, LDS_BYTES) != hipSuccess || per_cu < 1) { fprintf(stderr, "kernel_launch: occupancy query says %d\n", per_cu); (void)hipGetLastError(); }
        grid = cus;
    }
    if (grid < 0) return;
    if (hipMemsetAsync((char*)d_ws + WS_CTL, 0, CTL_ZERO_BYTES, stream) != hipSuccess) return;
    KArgs a{};
    for (int i = 0; i < 23; ++i) a.in[i] = (const float*)d_in[i];
    a.out = (float*)d_out; a.ws = (unsigned char*)d_ws;
    hipLaunchKernelGGL(mk_fwd, dim3(grid), dim3(512), LDS_BYTES, stream, a);
}
```

```cpp
#include <hip/hip_runtime.h>
#include <cstdio>
#include <cstdint>

#define LAS __attribute__((address_space(3)))
#define GAS __attribute__((address_space(1)))
typedef unsigned short bf16_t;
typedef short bf16x8 __attribute__((ext_vector_type(8)));
typedef int v8i __attribute__((ext_vector_type(8)));
typedef int v4i __attribute__((ext_vector_type(4)));
typedef short s16x4 __attribute__((ext_vector_type(4)));
typedef float f32x2 __attribute__((ext_vector_type(2)));
typedef float f32x4 __attribute__((ext_vector_type(4)));
typedef float f32x16 __attribute__((ext_vector_type(16)));
typedef unsigned u32x2 __attribute__((ext_vector_type(2)));
typedef unsigned u32x4 __attribute__((ext_vector_type(4)));

constexpr int DM = 1024, NB = 2, SEQ = 8192, CTX = 256, DEPTH = 2;
constexpr int NXR = NB * SEQ;
constexpr int NCR = NB * CTX;
constexpr int NROW = NXR + NCR;
constexpr int LK = SEQ + CTX;
constexpr int IN_DIM = 6144, Q_OFF = 0, K_OFF = 1024, V_OFF = 1280, F_OFF = 1536, U_OFF = 2048, VG_OFF = 2560, G_OFF = 3072;
constexpr int PXW = 3072;
constexpr int NEXP = 32, TOPK = 4;
constexpr int MAXT = 296;
constexpr int SROWS = MAXT * 256;
constexpr float EPS = 1e-6f;

constexpr size_t al256(size_t x) { return (x + 255) / 256 * 256; }
constexpr size_t WS_CTL = 0, CTL_BYTES = 1u << 20, CTL_ZERO_BYTES = 128u << 10;
constexpr size_t WS_MOD = WS_CTL + CTL_BYTES;
constexpr size_t WS_T1 = al256(WS_MOD + (size_t)DEPTH * 3 * 6144 * 4);
constexpr size_t WS_T2 = al256(WS_T1 + (size_t)64 * 256 * 128 * 4);
constexpr size_t WS_WSP = WS_T1 + (size_t)6 * 1024 * 1024;
constexpr size_t WS_ROPE = WS_T1 + (size_t)7 * 1024 * 1024;
constexpr size_t WS_TC = al256(WS_T2 + (size_t)128 * 128 * 4);
constexpr size_t WS_WIN = al256(WS_TC + (size_t)512 * 256 * 4);
constexpr size_t WS_WA = al256(WS_WIN + (size_t)DEPTH * IN_DIM * DM * 2);
constexpr size_t WS_WFP = al256(WS_WA + (size_t)DEPTH * DM * DM * 2);
constexpr size_t WS_WS = al256(WS_WFP + (size_t)DEPTH * DM * DM * 2);
constexpr size_t WS_WO = al256(WS_WS + (size_t)DEPTH * DM * DM * 2);
constexpr size_t WS_WGU = al256(WS_WO + (size_t)DEPTH * DM * DM * 2);
constexpr size_t WS_WDN = al256(WS_WGU + (size_t)DEPTH * NEXP * 2048 * DM);
constexpr size_t WS_XW = al256(WS_WDN + (size_t)DEPTH * NEXP * DM * DM);
constexpr size_t WS_HX = al256(WS_XW + (size_t)NROW * DM * 4);
constexpr size_t WS_PX = al256(WS_HX + (size_t)NROW * DM * 2);
constexpr size_t WS_GT = al256(WS_PX + (size_t)NROW * PXW * 2);
constexpr size_t WS_QN = al256(WS_GT + (size_t)NROW * 3072 * 2);
constexpr size_t WS_KN = al256(WS_QN + (size_t)NROW * DM * 2);
constexpr size_t WS_VN = al256(WS_KN + (size_t)NB * LK * 256 * 2);
constexpr size_t WS_VGN = al256(WS_VN + (size_t)NB * LK * 256 * 2);
constexpr size_t WS_Y1 = al256(WS_VGN + (size_t)NROW * 512 * 2);
constexpr size_t WS_FX = al256(WS_Y1 + (size_t)NB * 128 * 2 * 64 * 512 * 2);
constexpr size_t WS_ATT = al256(WS_FX + (size_t)NROW * DM * 2);
constexpr size_t WS_SG = al256(WS_ATT + (size_t)NROW * DM * 2);
constexpr size_t WS_PART = al256(WS_SG + (size_t)NROW * DM * 2);
constexpr size_t WS_MRG = al256(WS_PART + (size_t)NROW * DM * 4);
constexpr size_t WS_TSLOT = al256(WS_MRG + (size_t)NROW * DM * 2);
constexpr size_t WS_TW = al256(WS_TSLOT + (size_t)NROW * 4 * 4);
constexpr int CAPR = NROW;
constexpr size_t WS_WSLOT = al256(WS_TW + (size_t)NROW * 4 * 4);
constexpr size_t WS_HXS = al256(WS_WSLOT + (size_t)NEXP * CAPR * 4);
constexpr size_t WS_HID = al256(WS_HXS + (size_t)NEXP * CAPR * DM);
constexpr size_t WS_Y = al256(WS_HID + (size_t)SROWS * DM * 2);
constexpr size_t WS_HX8 = al256(WS_Y + (size_t)SROWS * DM * 2);
constexpr size_t WS_END = al256(WS_HX8 + (size_t)NROW * DM);
static_assert(WS_END < (size_t)2000 * 1024 * 1024, "workspace map beyond the guaranteed 4 x largest-input size");
constexpr int CW_BAR = 4096;
constexpr int CW_CNT = 8192;

constexpr int LDS_X_OFF = 131072;
constexpr int LDS_MISC_OFF = 143360;
constexpr int LDS_BYTES = 147456;

__device__ __forceinline__ unsigned cvt_pk_bf16(float lo, float hi) { unsigned r; asm volatile("v_cvt_pk_bf16_f32 %0, %1, %2" : "=v"(r) : "v"(lo), "v"(hi)); return r; }
__device__ __forceinline__ unsigned pk4_fp8(float a, float b, float c, float d) { int p = __builtin_amdgcn_cvt_pk_fp8_f32(a, b, 0, false); return (unsigned)__builtin_amdgcn_cvt_pk_fp8_f32(c, d, p, true); }
__device__ __forceinline__ unsigned pk4_fp8u(float a, float b, float c, float d) { int u; asm("" : "=v"(u) : "v"(a)); int p = __builtin_amdgcn_cvt_pk_fp8_f32(a, b, u, false); return (unsigned)__builtin_amdgcn_cvt_pk_fp8_f32(c, d, p, true); }
__device__ __forceinline__ float bf_lo(unsigned w) { return __uint_as_float(w << 16); }
__device__ __forceinline__ float bf_hi(unsigned w) { return __uint_as_float(w & 0xffff0000u); }
__device__ __forceinline__ float bf2f(bf16_t h) { return __uint_as_float(((unsigned)h) << 16); }
__device__ __forceinline__ int lane_id() { int l; asm volatile("v_mbcnt_lo_u32_b32 %0, -1, 0\n\tv_mbcnt_hi_u32_b32 %0, -1, %0" : "=v"(l)); return l; }
template <int M> __device__ __forceinline__ float sx(float v) {
    if constexpr (M < 32) return __int_as_float(__builtin_amdgcn_ds_swizzle(__float_as_int(v), (M << 10) | 0x1f));
    else { const auto rr = __builtin_amdgcn_permlane32_swap(__float_as_uint(v), __float_as_uint(v), false, false); return (lane_id() & 32) ? __uint_as_float(rr[0]) : __uint_as_float(rr[1]); }
}
__device__ __forceinline__ float wave_sum(float v) {
    v += sx<1>(v); v += sx<2>(v); v += sx<4>(v); v += sx<8>(v); v += sx<16>(v);
    const auto rr = __builtin_amdgcn_permlane32_swap(__float_as_uint(v), __float_as_uint(v), false, false); return __uint_as_float(rr[0]) + __uint_as_float(rr[1]);
}
__device__ __forceinline__ float sigmoidf_(float x) { return __builtin_amdgcn_rcpf(1.0f + __expf(-x)); }
__device__ __forceinline__ float gelu_tanh(float x) { const float z = 0.7978845608028654f * (x + 0.044715f * x * x * x); const float t = 1.0f - 2.0f * __builtin_amdgcn_rcpf(1.0f + __expf(2.0f * z)); return 0.5f * x * (1.0f + t); }

#define XB_TMO      128
#define XB_XCNT(j)  (256  + 64 * (j))
#define XB_XSUB(j)  (1280 + 64 * (j))
#define XB_XGEN(j)  (2304 + 64 * (j))
#define XB_TOP      3328
#define XB_TOPGEN   3392
#define XCD_BAR_WORDS 3456
#define XB_SPIN_CAP (1u << 20)
__device__ __forceinline__ unsigned xb_ld(unsigned* p)              { return __hip_atomic_load(p, __ATOMIC_RELAXED, __HIP_MEMORY_SCOPE_AGENT); }
__device__ __forceinline__ unsigned xb_add(unsigned* p, unsigned v) { return __hip_atomic_fetch_add(p, v, __ATOMIC_RELAXED, __HIP_MEMORY_SCOPE_AGENT); }
__device__ __forceinline__ unsigned xb_xcc_id() { return (unsigned)__builtin_amdgcn_s_getreg((3 << 11) | 20) & 0xFu; }
#define XB_SPIN(cond, bar) do { unsigned _sp = 0; while (cond) { __builtin_amdgcn_s_sleep(1); \
    if ((++_sp & 255u) == 0u) { if (xb_ld(&(bar)[XB_TMO])) break; if (_sp > XB_SPIN_CAP) { __hip_atomic_fetch_max(&(bar)[XB_TMO + 1], 100000u - b.seam, __ATOMIC_RELAXED, __HIP_MEMORY_SCOPE_AGENT); atomicAdd(&(bar)[XB_TMO], 1u); break; } } } } while (0)
struct XcdBarrier { unsigned* bar; unsigned x; volatile LAS unsigned* st; unsigned seam; int wave; };
__device__ __forceinline__ XcdBarrier xcd_barrier_post(unsigned* bar, volatile LAS unsigned* st) {
    XcdBarrier b; b.bar = bar; b.x = xb_xcc_id(); b.st = st; b.seam = 1u; b.wave = __builtin_amdgcn_readfirstlane((int)(threadIdx.x >> 6));
    if (threadIdx.x == 0) (void)xb_add(&bar[XB_XCNT(b.x)], 1u);
    return b;
}
__device__ __forceinline__ void xcd_barrier_complete(unsigned* bar, unsigned x, unsigned& nloc, unsigned& nx) {
    const unsigned G = gridDim.x * gridDim.y * gridDim.z;
    unsigned sum, cnt, mine, sp = 0u;
    for (;;) {
        sum = 0u; cnt = 0u;
#pragma nounroll
        for (unsigned j = 0; j < 16; ++j) { const unsigned c = xb_ld(&bar[XB_XCNT(j)]); sum += c; cnt += (c > 0u) ? 1u : 0u; }
        mine = xb_ld(&bar[XB_XCNT(x)]);
        if (sum == G) break;
        __builtin_amdgcn_s_sleep(1);
        if ((++sp & 255u) == 0u) { if (xb_ld(&bar[XB_TMO])) break; if (sp > XB_SPIN_CAP) { atomicAdd(&bar[XB_TMO], 1u); break; } }
    }
    nloc = mine > 0u ? mine : 1u; nx = cnt > 0u ? cnt : 1u;
}
__device__ __forceinline__ void xcd_barrier(const XcdBarrier& b) {
    asm volatile("s_waitcnt vmcnt(0)" ::: "memory");
    __syncthreads();
    if (b.wave == 0 && lane_id() == 0) {
        unsigned* bar = b.bar;
        __builtin_amdgcn_s_waitcnt(0);
        unsigned nloc = b.st[0], nx = b.st[1];
        if (nloc == 0u) { xcd_barrier_complete(bar, b.x, nloc, nx); b.st[0] = nloc; b.st[1] = nx; }
        const unsigned old = xb_add(&bar[XB_XSUB(b.x)], 1u);
        const unsigned gen = old / nloc;
        if (old + 1u == (gen + 1u) * nloc) {
            __builtin_amdgcn_fence(__ATOMIC_RELEASE, "agent");
            asm volatile("s_waitcnt vmcnt(0)" ::: "memory");
            const unsigned og = xb_add(&bar[XB_TOP], 1u);
            const unsigned tg = og / nx;
            if (og + 1u == (tg + 1u) * nx) xb_add(&bar[XB_TOPGEN], 1u);
            else XB_SPIN(xb_ld(&bar[XB_TOPGEN]) == tg, bar);
            __builtin_amdgcn_fence(__ATOMIC_ACQUIRE, "agent");
            xb_add(&bar[XB_XGEN(b.x)], 1u);
            asm volatile("s_waitcnt vmcnt(0)" ::: "memory");
        } else {
            XB_SPIN(xb_ld(&bar[XB_XGEN(b.x)]) == gen, bar);
            __builtin_amdgcn_fence(__ATOMIC_ACQUIRE, "agent");
            asm volatile("s_waitcnt vmcnt(0)" ::: "memory");
        }
    }
    __syncthreads();
}

namespace g8 {
constexpr int BM = 256, BK = 64, HALF = 128, HTB = HALF * BK * 2, STAGE_BYTES = 8 * HTB, NXCD = 8, WGM = 8;
__host__ __device__ __forceinline__ int lds_byte(int r, int c) { const int st = (r >> 4) * 2 + (c >> 5), rr = r & 15, cc = c & 31, ob = rr * 64 + cc * 2; return st * 1024 + (ob ^ (((ob >> 9) & 1) << 5)); }
__host__ __device__ __forceinline__ void stage_rc(int b, int& R, int& C) { const int st = b / 1024, sb = b % 1024, swz = sb ^ (((sb >> 9) & 1) << 5); R = (st >> 1) * 16 + swz / 64; C = (st & 1) * 32 + (swz % 64) / 2; }
__host__ __device__ __forceinline__ int perm32(int rho) { const int n = rho >> 4, i = rho & 15; return 8 * (i >> 2) + 4 * n + (i & 3); }

struct Unit { const char* A; const char* B; int nt; int pm, pn, aux; };
__host__ __device__ __forceinline__ int lds_byte8(int r, int cb) { const int st = (r >> 4) * 2 + (cb >> 6), ob = (r & 15) * 64 + (cb & 63); return st * 1024 + (ob ^ (((ob >> 9) & 1) << 5)); }

__device__ __forceinline__ void tile_order(int L, int nM, int nN, int& pm, int& pn) {
    const int nwg = nM * nN; int wgid = L; { const int q = nwg / NXCD, r = nwg % NXCD, xcd = wgid % NXCD, off = wgid / NXCD; wgid = (xcd < r ? xcd * (q + 1) : r * (q + 1) + (xcd - r) * q) + off; }
    const int nig = WGM * nN, gid = wgid / nig, fm = gid * WGM, gsz = (nM - fm) < WGM ? (nM - fm) : WGM;
    pm = fm + ((wgid % nig) % gsz); pn = (wgid % nig) / gsz;
}

template <class Epi, class Sched, bool FP8 = false, bool SP2 = false, bool ALIGN_EPI = false>
__device__ __forceinline__ void gemm_phase(LAS unsigned char* lds, const Sched& S, const Epi& E, int tid_in) {
    constexpr unsigned LD = FP8 ? 1024u : 2048u;
    int tid_ = tid_in; asm volatile("" : "+v"(tid_));
    const int tid = tid_, wid = __builtin_amdgcn_readfirstlane(tid >> 6), lane = tid & 63, wr = wid >> 2, wc = wid & 3, fr = lane & 15, fq = lane >> 4;
    int R0, C0; stage_rc(tid * 16, R0, C0);
    const int Rb0 = Epi::PERM ? ((R0 & ~31) + perm32(R0 & 31)) : R0;
    const unsigned c2 = (unsigned)C0 * 2u;
    const unsigned ldsw = (unsigned)wid * 1024u;
    const int aoff = FP8 ? lds_byte8(wr * 64 + fr, fq * 32) : lds_byte(wr * 64 + fr, fq * 8), boff = FP8 ? lds_byte8(wc * 32 + fr, fq * 32) : lds_byte(wc * 32 + fr, fq * 8);
#define G8_SA(b, h) (((b) * 2 + (h)) * HTB)
#define G8_SB(b, h) ((4 + (b) * 2 + (h)) * HTB)
#define G8_DMA(gp, off) __builtin_amdgcn_global_load_lds((const unsigned*)(gp), (LAS unsigned*)(lds + (off)), 16, 0, 0)
#define G8_STAGE(bufoff, base, v) do { const char* _p = (base); G8_DMA(_p + (v), (bufoff) + ldsw); G8_DMA(_p + (size_t)64 * LD + (v), (bufoff) + ldsw + 8192); } while (0)
#define G8_LDA(dst, b, h) do { if constexpr (FP8) { _Pragma("unroll") for (int m = 0; m < 4; ++m) { const v4i lo_ = *(const LAS v4i*)(lds + G8_SA(b, h) + aoff + m * 2048), hi_ = *(const LAS v4i*)(lds + G8_SA(b, h) + aoff + m * 2048 + 16); dst##8[m] = __builtin_shufflevector(lo_, hi_, 0, 1, 2, 3, 4, 5, 6, 7); } } \
        else { _Pragma("unroll") for (int m = 0; m < 4; ++m) _Pragma("unroll") for (int k = 0; k < 2; ++k) dst[m][k] = *(const LAS bf16x8*)(lds + G8_SA(b, h) + aoff + m * 2048 + k * 1024); } } while (0)
#define G8_LDB(dst, b, h) do { if constexpr (FP8) { _Pragma("unroll") for (int n = 0; n < 2; ++n) { const v4i lo_ = *(const LAS v4i*)(lds + G8_SB(b, h) + boff + n * 2048), hi_ = *(const LAS v4i*)(lds + G8_SB(b, h) + boff + n * 2048 + 16); dst##8[n] = __builtin_shufflevector(lo_, hi_, 0, 1, 2, 3, 4, 5, 6, 7); } } \
        else { _Pragma("unroll") for (int n = 0; n < 2; ++n) _Pragma("unroll") for (int k = 0; k < 2; ++k) dst[n][k] = *(const LAS bf16x8*)(lds + G8_SB(b, h) + boff + n * 2048 + k * 1024); } } while (0)
#define G8_MMA(ai, bj, At, Bt) do { __builtin_amdgcn_s_setprio(1); _Pragma("unroll") for (int m = 0; m < 4; ++m) _Pragma("unroll") for (int n = 0; n < 2; ++n) { \
        if constexpr (FP8) asm volatile("v_mfma_f32_16x16x128_f8f6f4 %0, %1, %2, %0" : "+v"(acc[ai][bj][m][n]) : "v"(Bt##8[n]), "v"(At##8[m]));   \
        else { _Pragma("unroll") for (int k = 0; k < 2; ++k) acc[ai][bj][m][n] = __builtin_amdgcn_mfma_f32_16x16x32_bf16(Bt[n][k], At[m][k], acc[ai][bj][m][n], 0, 0, 0); } } \
        __builtin_amdgcn_s_setprio(0); } while (0)
#define G8_WAIT_V(n) asm volatile("s_waitcnt vmcnt(" #n ")" ::: "memory")
#define G8_WAIT_L(n) asm volatile("s_waitcnt lgkmcnt(" #n ")" ::: "memory")
#define G8_BAR __builtin_amdgcn_s_barrier()
#define G8_SCHED __builtin_amdgcn_sched_barrier(0)
    Unit cur, nxt; int ui = 0;
    if (!S.next(0, cur)) return;
    f32x4 acc[2][2][4][2];
#pragma unroll
    for (int a = 0; a < 2; ++a)
#pragma unroll
        for (int b = 0; b < 2; ++b)
#pragma unroll
            for (int m = 0; m < 4; ++m)
#pragma unroll
                for (int n = 0; n < 2; ++n) acc[a][b][m][n] = (f32x4){0.f, 0.f, 0.f, 0.f};
    bf16x8 At[4][2], B0[2][2], B1[2][2]; v8i At8[4], B08[2], B18[2];
    const unsigned vA = (unsigned)R0 * LD + c2, vB = (unsigned)Rb0 * LD + c2;
    constexpr size_t hS = (size_t)HALF * LD;
    {
        if constexpr (SP2) {
            G8_STAGE(G8_SB(0, 0), cur.B, vB); G8_STAGE(G8_SB(0, 1), cur.B + hS, vB); G8_STAGE(G8_SA(0, 0), cur.A, vA); G8_STAGE(G8_SA(0, 1), cur.A + hS, vA);
            if (wr == 1) G8_BAR;
            G8_WAIT_V(2); G8_BAR;
        } else {
            G8_STAGE(G8_SB(0, 0), cur.B, vB); G8_STAGE(G8_SA(0, 0), cur.A, vA); G8_STAGE(G8_SB(0, 1), cur.B + hS, vB); G8_STAGE(G8_SA(0, 1), cur.A + hS, vA);
            if (wr == 1) G8_BAR;
            G8_WAIT_V(4); G8_BAR;
        }
        G8_STAGE(G8_SB(1, 0), cur.B + 128, vB); G8_STAGE(G8_SA(1, 0), cur.A + 128, vA); G8_STAGE(G8_SB(1, 1), cur.B + hS + 128, vB);
        G8_WAIT_V(6); G8_BAR;
    }
    for (;;) {
        const bool has_next = S.next(ui + 1, nxt);
        if (!has_next) nxt = cur;
        const int nt = cur.nt;
        for (int t = 0; t < nt; t += 2) {
            const bool last = (t == nt - 2);
            const char* a1 = cur.A + (size_t)(t + 1) * 128 + hS;
            const char* a2 = last ? nxt.A : cur.A + (size_t)(t + 2) * 128; const char* b2 = last ? nxt.B : cur.B + (size_t)(t + 2) * 128;
            if constexpr (Epi::NAUX > 0) { if (t == 0 && wid < Epi::NAUX) __builtin_amdgcn_global_load_lds((const unsigned*)(E.aux_src(cur, wid) + lane), (LAS unsigned*)(lds + STAGE_BYTES + (ui & 1) * 2048 + wid * 256), 4, 0, 0); }
            if constexpr (SP2) {
            G8_LDB(B0, 0, 0); G8_LDB(B1, 0, 1); G8_SCHED; G8_LDA(At, 0, 0); G8_STAGE(G8_SA(1, 1), a1, vA);
            G8_WAIT_V(8); G8_WAIT_L(0); G8_BAR; G8_MMA(0, 0, At, B0); G8_MMA(0, 1, At, B1); G8_BAR; G8_SCHED;
            G8_LDA(At, 0, 1); G8_STAGE(G8_SB(0, 0), b2, vB); G8_STAGE(G8_SB(0, 1), b2 + hS, vB); G8_STAGE(G8_SA(0, 0), a2, vA);
            G8_WAIT_V(8); G8_WAIT_L(0); G8_BAR; G8_MMA(1, 0, At, B0); G8_MMA(1, 1, At, B1); G8_BAR; G8_SCHED;
            G8_LDB(B0, 1, 0); G8_LDB(B1, 1, 1); G8_SCHED; G8_LDA(At, 1, 0); G8_STAGE(G8_SA(0, 1), a2 + hS, vA);
            G8_WAIT_V(8); G8_WAIT_L(0); G8_BAR; G8_MMA(0, 0, At, B0); G8_MMA(0, 1, At, B1); G8_BAR; G8_SCHED;
            G8_LDA(At, 1, 1); G8_STAGE(G8_SB(1, 0), b2 + 128, vB); G8_STAGE(G8_SB(1, 1), b2 + hS + 128, vB); G8_STAGE(G8_SA(1, 0), a2 + 128, vA);
            G8_WAIT_V(8); G8_WAIT_L(0); G8_BAR; G8_MMA(1, 0, At, B0); G8_MMA(1, 1, At, B1); G8_BAR; G8_SCHED;
            } else {
            G8_LDB(B0, 0, 0); G8_SCHED; G8_LDA(At, 0, 0); G8_STAGE(G8_SA(1, 1), a1, vA);
            G8_WAIT_L(8); G8_BAR; G8_WAIT_L(0); G8_MMA(0, 0, At, B0); G8_BAR; G8_SCHED;
            G8_LDB(B1, 0, 1); G8_STAGE(G8_SB(0, 0), b2, vB);
            G8_BAR; G8_WAIT_L(0); G8_MMA(0, 1, At, B1); G8_BAR;
            G8_LDA(At, 0, 1); G8_STAGE(G8_SA(0, 0), a2, vA);
            G8_BAR; G8_WAIT_L(0); G8_MMA(1, 0, At, B0); G8_BAR; G8_SCHED;
            G8_STAGE(G8_SB(0, 1), b2 + hS, vB);
            G8_WAIT_V(6); G8_BAR; G8_MMA(1, 1, At, B1); G8_BAR;
            G8_LDB(B0, 1, 0); G8_SCHED; G8_LDA(At, 1, 0); G8_STAGE(G8_SA(0, 1), a2 + hS, vA);
            G8_WAIT_L(8); G8_BAR; G8_WAIT_L(0); G8_MMA(0, 0, At, B0); G8_BAR; G8_SCHED;
            G8_LDB(B1, 1, 1); G8_STAGE(G8_SB(1, 0), b2 + 128, vB);
            G8_BAR; G8_WAIT_L(0); G8_MMA(0, 1, At, B1); G8_BAR;
            G8_LDA(At, 1, 1); G8_STAGE(G8_SA(1, 0), a2 + 128, vA);
            G8_BAR; G8_WAIT_L(0); G8_MMA(1, 0, At, B0); G8_BAR; G8_SCHED;
            G8_STAGE(G8_SB(1, 1), b2 + hS + 128, vB);
            G8_WAIT_V(6); G8_BAR; G8_MMA(1, 1, At, B1); G8_BAR;
            }
        }
        if constexpr (ALIGN_EPI) { if (wr == 0) G8_BAR; }
        if constexpr (FP8) asm volatile("s_nop 7\n\ts_nop 7\n\ts_nop 7" ::: "memory");
        const bool keep = E(acc, cur, wr, wc, fr, fq, (const LAS float*)(lds + STAGE_BYTES + (ui & 1) * 2048));
        if (!has_next) break;
        if (!keep)
#pragma unroll
        for (int a = 0; a < 2; ++a)
#pragma unroll
            for (int b = 0; b < 2; ++b)
#pragma unroll
                for (int m = 0; m < 4; ++m)
#pragma unroll
                    for (int n = 0; n < 2; ++n) acc[a][b][m][n] = (f32x4){0.f, 0.f, 0.f, 0.f};
        cur = nxt; ++ui;
        if constexpr (ALIGN_EPI) { if (wr == 1) G8_BAR; }
    }
    G8_WAIT_V(0);
    if constexpr (!ALIGN_EPI) { if (wr == 0) G8_BAR; }
    G8_BAR;
#undef G8_SA
#undef G8_SB
#undef G8_DMA
#undef G8_STAGE
#undef G8_LDA
#undef G8_LDB
#undef G8_MMA
#undef G8_WAIT_V
#undef G8_WAIT_L
#undef G8_BAR
#undef G8_SCHED
}
}

namespace att {
constexpr int D = 128, NW = 8, QBLK = 32, KVBLK = 64;
constexpr float SCALE = 0.088388347648318440f;
constexpr float THR = 5.f;
constexpr int LDQ = 1024, LDK = 256, LDO = 1024;
constexpr size_t SHM_V = KVBLK * D  , SHM_K = KVBLK * D  , NBUF = 3, SHM_ATTN = NBUF * SHM_V + NBUF * SHM_K + NW * 64 * 4 + 48;
#define KSWZ(row, colB) ((row) * 256 + ((colB) ^ (((row) & 7) << 4)))
#define SBAR() __builtin_amdgcn_sched_barrier(0)
#define PIN(a, b) asm volatile("" : "+v"(a), "+v"(b))
__device__ __forceinline__ int crow(int r, int hi) { return (r & 3) + 8 * (r >> 2) + 4 * hi; }
template <bool SC, class RowFn>
__device__ __forceinline__ void wave_rows_out(LAS unsigned char* st, const f32x16* o, const float (&sc)[16], int lane, RowFn fn) {
  const int r32 = lane & 31, hi = lane >> 5; const bool odd = (lane & 1) != 0;
  LAS unsigned char* wp = st + (odd ? (32 + r32 - 1) * 2 : r32 * 2);
#pragma unroll
  for (int r = 0; r < 16; ++r) {
#pragma unroll
    for (int dp = 0; dp < 4; dp += 2) {
      const float s = SC ? sc[r] : 1.f; const float a = o[dp][r] * s, b = o[dp + 1][r] * s; const float recv = sx<1>(odd ? a : b);
      *(LAS unsigned*)(wp + crow(r, hi) * 256 + dp * 64) = cvt_pk_bf16(odd ? recv : a, odd ? b : recv); } }
  asm volatile("s_waitcnt lgkmcnt(0)" ::: "memory");
  const LAS unsigned char* rp = st + (lane >> 4) * 256 + (lane & 15) * 16;
#pragma unroll
  for (int i = 0; i < 8; ++i) fn(4 * i + (lane >> 4), (lane & 15) * 8, *(const LAS u32x4*)(rp + i * 1024));
}
template <class RowFn>
__device__ __forceinline__ void wave_rows_out_i(LAS unsigned char* st, const f32x16* o, int lane, RowFn fn) {
  const int r32 = lane & 31, hi = lane >> 5; const bool odd = (lane & 1) != 0;
  LAS unsigned char* wp = st + (odd ? (32 + r32 - 1) * 2 : r32 * 2);
#pragma unroll
  for (int r = 0; r < 16; ++r) {
#pragma unroll
    for (int dp = 0; dp < 4; dp += 2) {
      const float a = o[dp][r], b = o[dp + 1][r]; const float recv = sx<1>(odd ? a : b);
      *(LAS unsigned*)(wp + crow(r, hi) * 256 + dp * 64) = cvt_pk_bf16(odd ? recv : a, odd ? b : recv); } }
  asm volatile("s_waitcnt lgkmcnt(0)" ::: "memory");
  const LAS unsigned char* rp = st + (lane >> 4) * 256 + (lane & 15) * 16;
#pragma unroll
  for (int i = 0; i < 8; ++i) fn(i, 4 * i + (lane >> 4), (lane & 15) * 8, *(const LAS u32x4*)(rp + i * 1024));
}
__device__ __forceinline__ void partial0(f32x16& p0, f32x16& p1, float& M) {
  float pmax = p0[0]; for (int r = 1; r < 16; ++r) pmax = fmaxf(pmax, p0[r]); for (int r = 0; r < 16; ++r) pmax = fmaxf(pmax, p1[r]);
  { auto rr = __builtin_amdgcn_permlane32_swap(__float_as_uint(pmax), __float_as_uint(pmax), false, false);
    pmax = fmaxf(__uint_as_float(rr[0]), __uint_as_float(rr[1])); }
  M = pmax;
  for (int r = 0; r < 16; ++r) { p0[r] -= M; p1[r] -= M; }
}
template <bool EXP0 = true>
__device__ __forceinline__ void partialSM(f32x16& p0, f32x16& p1, float& m_reg, float& mn, float& alpha) {
  constexpr float C = SCALE * 1.4426950408889634f;
  float pmax = p0[0]; for (int r = 1; r < 16; ++r) pmax = fmaxf(pmax, p0[r]); for (int r = 0; r < 16; ++r) pmax = fmaxf(pmax, p1[r]);
  { auto rr = __builtin_amdgcn_permlane32_swap(__float_as_uint(pmax), __float_as_uint(pmax), false, false);
    pmax = fmaxf(__uint_as_float(rr[0]), __uint_as_float(rr[1])); }
  if (__builtin_expect(__all(pmax - m_reg <= THR / SCALE), 1)) { mn = m_reg; alpha = 1.f; }
  else { mn = fmaxf(m_reg, pmax); alpha = __builtin_amdgcn_exp2f((m_reg - mn) * C); m_reg = mn; }
  float mnC = -mn * C;
  for (int r = 0; r < 16; ++r) p0[r] = fmaf(p0[r], C, mnC); for (int r = 0; r < 16; ++r) p1[r] = fmaf(p1[r], C, mnC);
  if (EXP0) { for (int r = 0; r < 16; ++r) p0[r] = __builtin_amdgcn_exp2f(p0[r]); }
}
__device__ __forceinline__ void finishSM(f32x16& p0, f32x16& p1, float alpha, float& l_reg, bf16x8& pa0, bf16x8& pa1, bf16x8& pa2, bf16x8& pa3) {
  for (int r = 0; r < 16; ++r) p1[r] = __builtin_amdgcn_exp2f(p1[r]);
  float ps = 0; for (int r = 0; r < 16; ++r) ps += p0[r]; for (int r = 0; r < 16; ++r) ps += p1[r];
  { auto rr = __builtin_amdgcn_permlane32_swap(__float_as_uint(ps), __float_as_uint(ps), false, false);
    ps = __uint_as_float(rr[0]) + __uint_as_float(rr[1]); }
  l_reg = l_reg * alpha + ps;
#define PK4(P, BASE, OUT) do { unsigned a0 = cvt_pk_bf16(P[BASE + 0], P[BASE + 1]), a1 = cvt_pk_bf16(P[BASE + 2], P[BASE + 3]);   \
    unsigned b0 = cvt_pk_bf16(P[BASE + 4], P[BASE + 5]), b1 = cvt_pk_bf16(P[BASE + 6], P[BASE + 7]);                              \
    auto r0 = __builtin_amdgcn_permlane32_swap(a0, b0, false, false); auto r1 = __builtin_amdgcn_permlane32_swap(a1, b1, false, false); \
    u32x4 w = {r0[0], r1[0], r0[1], r1[1]}; OUT = *reinterpret_cast<bf16x8*>(&w); } while (0)
  PK4(p0, 0, pa0); PK4(p0, 8, pa1); PK4(p1, 0, pa2); PK4(p1, 8, pa3);
#undef PK4
}
#define KSWZ8(row, cb) ((row) * 128 + ((cb) ^ ((((row) >> 1) & 7) << 4)))
__device__ __forceinline__ void qkt8(f32x16& p0, f32x16& p1, const char* Ks, const v8i (&qr)[2], int r32, int hi) {
  v8i kf[2][2];
#pragma unroll
  for (int kb = 0; kb < 2; ++kb)
#pragma unroll
    for (int t = 0; t < 2; ++t) { const int row = 32 * kb + r32, cb = 64 * t + 32 * hi;
      const v4i lo = *reinterpret_cast<const v4i*>(Ks + KSWZ8(row, cb)), hh = *reinterpret_cast<const v4i*>(Ks + KSWZ8(row, cb + 16));
      kf[kb][t] = __builtin_shufflevector(lo, hh, 0, 1, 2, 3, 4, 5, 6, 7); }
  asm volatile("v_mfma_f32_32x32x64_f8f6f4 %0, %1, %2, 0" : "=&v"(p0) : "v"(kf[0][0]), "v"(qr[0]));
  asm volatile("v_mfma_f32_32x32x64_f8f6f4 %0, %1, %2, 0" : "=&v"(p1) : "v"(kf[1][0]), "v"(qr[0]));
  asm volatile("v_mfma_f32_32x32x64_f8f6f4 %0, %1, %2, %0" : "+v"(p0) : "v"(kf[0][1]), "v"(qr[1]));
  asm volatile("v_mfma_f32_32x32x64_f8f6f4 %0, %1, %2, %0" : "+v"(p1) : "v"(kf[1][1]), "v"(qr[1]));
  asm volatile("s_nop 7\n\ts_nop 7\n\ts_nop 7" ::: "memory");
}
__device__ __forceinline__ int v_st(int k, int c) { const int kk = (k & ~0xC) | ((k & 4) << 1) | ((k & 8) >> 1); return ((kk >> 3) * 4 + (c >> 5)) * 512 + ((kk & 7) * 32 + (c & 31)) * 2; }
__device__ __forceinline__ int v_rd_base(int lane) { return ((lane & 3) << 3) | (((lane >> 2) & 3) << 6) | (((lane >> 4) & 1) << 5) | (((lane >> 5) & 1) << 8); }
constexpr int v_rd_off(int d0, int ks, int half) { return d0 * 512 + ks * 4096 + half * 2048; }
template <int OFF> __device__ __forceinline__ s16x4 tr_read(int vb) {
  s16x4 r; asm volatile("ds_read_b64_tr_b16 %0, %1 offset:%2" : "=&v"(r) : "v"(vb), "i"(OFF) : "memory"); return r;
}
template <int D0> __device__ __forceinline__ void pv_one(f32x16& od, int vb, bf16x8 pa0, bf16x8 pa1, bf16x8 pa2, bf16x8 pa3) {
  const s16x4 l0 = tr_read<v_rd_off(D0, 0, 0)>(vb), h0 = tr_read<v_rd_off(D0, 0, 1)>(vb), l1 = tr_read<v_rd_off(D0, 1, 0)>(vb), h1 = tr_read<v_rd_off(D0, 1, 1)>(vb);
  const s16x4 l2 = tr_read<v_rd_off(D0, 2, 0)>(vb), h2 = tr_read<v_rd_off(D0, 2, 1)>(vb), l3 = tr_read<v_rd_off(D0, 3, 0)>(vb), h3 = tr_read<v_rd_off(D0, 3, 1)>(vb);
  asm volatile("s_waitcnt lgkmcnt(0)" ::: "memory"); SBAR();
#define PK(L, H) (bf16x8){L[0], L[1], L[2], L[3], H[0], H[1], H[2], H[3]}
  od = __builtin_amdgcn_mfma_f32_32x32x16_bf16(pa0, PK(l0, h0), od, 0, 0, 0);
  od = __builtin_amdgcn_mfma_f32_32x32x16_bf16(pa1, PK(l1, h1), od, 0, 0, 0);
  od = __builtin_amdgcn_mfma_f32_32x32x16_bf16(pa2, PK(l2, h2), od, 0, 0, 0);
  od = __builtin_amdgcn_mfma_f32_32x32x16_bf16(pa3, PK(l3, h3), od, 0, 0, 0);
#undef PK
}
__device__ __forceinline__ void pv_d0(f32x16* o, int vb, bf16x8 pa0, bf16x8 pa1, bf16x8 pa2, bf16x8 pa3) {
  pv_one<0>(o[0], vb, pa0, pa1, pa2, pa3); pv_one<1>(o[1], vb, pa0, pa1, pa2, pa3); pv_one<2>(o[2], vb, pa0, pa1, pa2, pa3); pv_one<3>(o[3], vb, pa0, pa1, pa2, pa3);
}
__device__ __forceinline__ void finish8(f32x16& p0, f32x16& p1, v8i& P8) {
  for (int r = 0; r < 16; ++r) p0[r] = __builtin_amdgcn_exp2f(p0[r]); for (int r = 0; r < 16; ++r) p1[r] = __builtin_amdgcn_exp2f(p1[r]);
#pragma unroll
  for (int w = 0; w < 4; ++w) { P8[w] = (int)pk4_fp8(p0[4 * w], p0[4 * w + 1], p0[4 * w + 2], p0[4 * w + 3]); P8[4 + w] = (int)pk4_fp8(p1[4 * w], p1[4 * w + 1], p1[4 * w + 2], p1[4 * w + 3]); }
}
__device__ __forceinline__ void pv8(f32x16* o, const char* Vs, int off0, int off1, const v8i& P8, const char* ones_lds) {
  v8i vf[4];
#pragma unroll
  for (int d0 = 0; d0 < 4; ++d0) { const v4i lo = *reinterpret_cast<const v4i*>(Vs + d0 * 2048 + off0), hh = *reinterpret_cast<const v4i*>(Vs + d0 * 2048 + off1);
    vf[d0] = __builtin_shufflevector(lo, hh, 0, 1, 2, 3, 4, 5, 6, 7); }
  asm volatile("s_nop 4\n\tv_mfma_f32_32x32x64_f8f6f4 %0, %1, %2, %0" : "+v"(o[0]) : "v"(P8), "v"(vf[0]));
  asm volatile("v_mfma_f32_32x32x64_f8f6f4 %0, %1, %2, %0" : "+v"(o[1]) : "v"(P8), "v"(vf[1]));
  asm volatile("v_mfma_f32_32x32x64_f8f6f4 %0, %1, %2, %0" : "+v"(o[2]) : "v"(P8), "v"(vf[2]));
  asm volatile("v_mfma_f32_32x32x64_f8f6f4 %0, %1, %2, %0" : "+v"(o[3]) : "v"(P8), "v"(vf[3]));
  { const v8i ones = *reinterpret_cast<const v8i*>(ones_lds);
  asm volatile("v_mfma_f32_32x32x64_f8f6f4 %0, %1, %2, %0" : "+v"(o[4]) : "v"(P8), "v"(ones)); }
}
#define MFMA8(ACC, A, B) asm volatile("v_mfma_f32_32x32x64_f8f6f4 %0, %1, %2, %0" : "+v"(ACC) : "v"(A), "v"(B))
#define KEEP(x) asm volatile("" :: "v"(x))
#define MFMA8Z(ACC, A, B) asm volatile("v_mfma_f32_32x32x64_f8f6f4 %0, %1, %2, 0" : "=&v"(ACC) : "v"(A), "v"(B))
__device__ __forceinline__ float amax3(float a, float b, float c) { float d; asm("v_max3_f32 %0, %1, %2, %3" : "=v"(d) : "v"(a), "v"(b), "v"(c)); return d; }
constexpr float THR2 = THR * 1.4426950408889634f;
typedef short s16x8 __attribute__((ext_vector_type(8)));
#define MFMA16Z(ACC, A, B) asm volatile("v_mfma_f32_32x32x16_bf16 %0, %1, %2, 0" : "=&v"(ACC) : "v"(A), "v"(B))
__device__ __forceinline__ void set_mf(u32x4& mf, float M, int hi) {
  const float n = -M; const unsigned b0 = __float_as_uint(n) & 0xFFFF0000u; const float r1 = n - __uint_as_float(b0);
  const unsigned b1 = __float_as_uint(r1) & 0xFFFF0000u; const float r2 = r1 - __uint_as_float(b1); const unsigned b2 = __float_as_uint(r2) & 0xFFFF0000u;
  mf.x = hi ? 0u : ((b0 >> 16) | b1); mf.y = hi ? 0u : (b2 >> 16); mf.z = 0u; mf.w = 0u;
}
__device__ __forceinline__ void qk_fin8(f32x16& q0, f32x16& q1, const char* Ks, const v8i (&qr)[2], int r32, int hi, f32x16& p0, f32x16& p1, v8i& P8, const u32x4& mf, const char* one16_lds) {
  v8i kf[2][2];
  const u32x4 one16 = *reinterpret_cast<const u32x4*>(one16_lds);
#pragma unroll
  for (int kb = 0; kb < 2; ++kb)
#pragma unroll
    for (int t = 0; t < 2; ++t) { const int row = 32 * kb + r32, cb = 64 * t + 32 * hi;
      const v4i lo = *reinterpret_cast<const v4i*>(Ks + KSWZ8(row, cb)), hh = *reinterpret_cast<const v4i*>(Ks + KSWZ8(row, cb + 16));
      kf[kb][t] = __builtin_shufflevector(lo, hh, 0, 1, 2, 3, 4, 5, 6, 7); }
  SBAR(); MFMA16Z(q0, one16, mf); MFMA16Z(q1, one16, mf); SBAR();
#pragma unroll
  for (int r = 0; r < 8; ++r) p0[r] = __builtin_amdgcn_exp2f(p0[r]);
  SBAR(); MFMA8(q0, kf[0][0], qr[0]); KEEP(one16); SBAR();
#pragma unroll
  for (int r = 8; r < 16; ++r) p0[r] = __builtin_amdgcn_exp2f(p0[r]);
  SBAR(); MFMA8(q1, kf[1][0], qr[0]); KEEP(kf[0][0]); SBAR();
#pragma unroll
  for (int r = 0; r < 8; ++r) p1[r] = __builtin_amdgcn_exp2f(p1[r]);
  SBAR(); MFMA8(q0, kf[0][1], qr[1]); KEEP(kf[1][0]); SBAR();
#pragma unroll
  for (int r = 8; r < 16; ++r) p1[r] = __builtin_amdgcn_exp2f(p1[r]);
  SBAR(); MFMA8(q1, kf[1][1], qr[1]); KEEP(kf[0][1]); SBAR();
#pragma unroll
  for (int w = 0; w < 4; ++w) { P8[w] = (int)pk4_fp8u(p0[4 * w], p0[4 * w + 1], p0[4 * w + 2], p0[4 * w + 3]); P8[4 + w] = (int)pk4_fp8u(p1[4 * w], p1[4 * w + 1], p1[4 * w + 2], p1[4 * w + 3]); }
  KEEP(kf[1][1]);
  SBAR();
}
__device__ __forceinline__ void pv_sm8(f32x16* o, const char* Vs, int off0, int off1, const v8i& P8, const char* ones_lds, f32x16& p0, f32x16& p1, float& M, u32x4& mf, float* al_l, int r32, int hi) {
  v8i vf[4];
  const v8i ones = *reinterpret_cast<const v8i*>(ones_lds);
#pragma unroll
  for (int d0 = 0; d0 < 4; ++d0) { const v4i lo = *reinterpret_cast<const v4i*>(Vs + d0 * 2048 + off0), hh = *reinterpret_cast<const v4i*>(Vs + d0 * 2048 + off1);
    vf[d0] = __builtin_shufflevector(lo, hh, 0, 1, 2, 3, 4, 5, 6, 7); }
  SBAR(); MFMA8(o[0], P8, vf[0]); SBAR();
  const float t0 = amax3(p0[0], p0[1], p0[2]), t1 = amax3(p0[3], p0[4], p0[5]), t2 = amax3(p0[6], p0[7], p0[8]), t3 = amax3(p0[9], p0[10], p0[11]), t4 = amax3(p0[12], p0[13], p0[14]);
  SBAR(); MFMA8(o[1], P8, vf[1]); KEEP(vf[0]); SBAR();
  const float u0 = amax3(p1[0], p1[1], p1[2]), u1 = amax3(p1[3], p1[4], p1[5]), u2 = amax3(p1[6], p1[7], p1[8]), u3 = amax3(p1[9], p1[10], p1[11]), u4 = amax3(p1[12], p1[13], p1[14]);
  SBAR(); MFMA8(o[2], P8, vf[2]); KEEP(vf[1]); SBAR();
  float pm = amax3(amax3(amax3(t0, t1, t2), amax3(t3, t4, p0[15]), amax3(u0, u1, u2)), amax3(u3, u4, p1[15]), 0.f);
  { auto rr = __builtin_amdgcn_permlane32_swap(__float_as_uint(pm), __float_as_uint(pm), false, false);
    pm = amax3(__uint_as_float(rr[0]), __uint_as_float(rr[1]), 0.f); }
  SBAR(); MFMA8(o[3], P8, vf[3]); KEEP(vf[2]); SBAR();
  MFMA8(o[4], P8, ones); KEEP(vf[3]); SBAR();
  const bool moved = !__all(pm <= THR2);
  KEEP(ones);
  if (__builtin_expect(moved, 0)) {
    const float d = pm, alpha = __builtin_amdgcn_exp2f(-d);
    M += d; set_mf(mf, M, hi);
#pragma unroll
    for (int r = 0; r < 16; ++r) { p0[r] -= d; p1[r] -= d; }
    asm volatile("s_nop 7\n\ts_nop 7\n\ts_nop 7" ::: "memory");
    if (hi == 0) al_l[r32] = alpha; asm volatile("s_waitcnt lgkmcnt(0)" ::: "memory");
    for (int dd = 0; dd < 5; ++dd) for (int r = 0; r < 16; ++r) o[dd][r] *= al_l[crow(r, hi)];
  }
}
__device__ __forceinline__ void attn_dense_body(const unsigned char* __restrict__ Qb, const unsigned char* __restrict__ Kh, const unsigned char* __restrict__ Vt,
                                                bf16_t* __restrict__ Ob, int seq, char* lds, int tid_in) {
  int tid_ = tid_in; asm volatile("" : "+v"(tid_));
  const int tid = tid_, wid = tid >> 6, lane = tid & 63, r32 = lane & 31, hi = lane >> 5;
  char* V_lds = lds; char* K_lds = lds + NBUF * SHM_V;
  float* ws = (float*)(lds + NBUF * SHM_V + NBUF * SHM_K) + wid * 64; float* al_l = ws + 32;
  float M; u32x4 mf; f32x16 o[5] = {}; v8i qr[2];
  const char* ones = lds + NBUF * SHM_V + NBUF * SHM_K + NW * 64 * 4;
  const char* one16 = ones + 32;
  if (tid < 12) ((int*)ones)[tid] = tid < 8 ? 0x38383838 : 0x3F803F80;
  const unsigned char* Qw = Qb + (long)(wid * QBLK + r32) * LDQ + hi * 32;
#pragma unroll
  for (int t = 0; t < 2; ++t) qr[t] = *reinterpret_cast<const v8i*>(Qw + t * 64);
  const int kkey = tid >> 3, kpc = (tid & 7) * 16, kst = KSWZ8(kkey, kpc);
  const int vd = tid >> 2, vst = vd * 64 + (((tid & 3) ^ ((vd >> 2) & 3)) << 4);
  const int vsw = (r32 >> 2) & 3, voff0 = r32 * 64 + (((2 * hi) ^ vsw) << 4), voff1 = r32 * 64 + (((2 * hi + 1) ^ vsw) << 4);
  struct { u32x4 vs0, ks0; } sr_;
  const __amdgpu_buffer_rsrc_t rV = __builtin_amdgcn_make_buffer_rsrc((void*)Vt, (short)0, 0x7fffffff, 0x00020000), rK = __builtin_amdgcn_make_buffer_rsrc((void*)Kh, (short)0, 0x7fffffff, 0x00020000);
  const unsigned vlo = (unsigned)tid * 16u, klo = (unsigned)(kkey * LDK + kpc);
#define SLOAD(k0) do { sr_.vs0 = __builtin_bit_cast(u32x4, __builtin_amdgcn_raw_buffer_load_b128(rV, vlo, (unsigned)(((k0) / KVBLK) * 8192), 0)); \
    sr_.ks0 = __builtin_bit_cast(u32x4, __builtin_amdgcn_raw_buffer_load_b128(rK, klo, (unsigned)((k0) * LDK), 0)); } while (0)
#define SWRITE(b) do { *(u32x4*)(V_lds + (b) * SHM_V + vst) = sr_.vs0; *(u32x4*)(K_lds + (b) * SHM_K + kst) = sr_.ks0; } while (0)
#define SWAIT() asm volatile("s_waitcnt vmcnt(0)" ::: "memory")
  f32x16 pA0, pA1, pB0, pB1; v8i P8; const int NT = seq / KVBLK;
  SLOAD(0); SWAIT(); SWRITE(0); SLOAD(KVBLK); __syncthreads();
  qkt8(pA0, pA1, (const char*)K_lds, qr, r32, hi); partial0(pA0, pA1, M); set_mf(mf, M, hi);
  SWAIT(); SWRITE(1); if (2 < NT) SLOAD(2 * KVBLK); __syncthreads();
  int bt = 1;
#define NXB(b) ((b) == 2 ? 0 : (b) + 1)
  int j = 1;
#define ABLK(Q0, Q1, P0, P1, KB, WB, VB, LT) do { SBAR(); qk_fin8(Q0, Q1, (const char*)K_lds + (KB) * SHM_K, qr, r32, hi, P0, P1, P8, mf, one16); \
    SWAIT(); SWRITE(WB); SLOAD((LT) * KVBLK); SBAR(); pv_sm8(o, V_lds + (VB) * SHM_V, voff0, voff1, P8, ones, Q0, Q1, M, mf, al_l, r32, hi); __syncthreads(); } while (0)
  for (; j + 7 < NT; j += 6) {
    ABLK(pB0, pB1, pA0, pA1, 1, 2, 0, j + 2); ABLK(pA0, pA1, pB0, pB1, 2, 0, 1, j + 3);
    ABLK(pB0, pB1, pA0, pA1, 0, 1, 2, j + 4); ABLK(pA0, pA1, pB0, pB1, 1, 2, 0, j + 5);
    ABLK(pB0, pB1, pA0, pA1, 2, 0, 1, j + 6); ABLK(pA0, pA1, pB0, pB1, 0, 1, 2, j + 7);
  }
#undef ABLK
  for (; j + 1 < NT; j += 2) {
    const int bp = NXB(NXB(bt)), bn = NXB(bt);
    SBAR(); qk_fin8(pB0, pB1, (const char*)K_lds + bt * SHM_K, qr, r32, hi, pA0, pA1, P8, mf, one16);
    SWAIT(); SWRITE(bn); SLOAD((j + 2) * KVBLK); SBAR();
    pv_sm8(o, V_lds + bp * SHM_V, voff0, voff1, P8, ones, pB0, pB1, M, mf, al_l, r32, hi);
    __syncthreads();
    SBAR(); qk_fin8(pA0, pA1, (const char*)K_lds + bn * SHM_K, qr, r32, hi, pB0, pB1, P8, mf, one16);
    SWAIT(); SWRITE(bp); if (j + 3 < NT) SLOAD((j + 3) * KVBLK); SBAR();
    pv_sm8(o, V_lds + bt * SHM_V, voff0, voff1, P8, ones, pA0, pA1, M, mf, al_l, r32, hi);
    __syncthreads();
    bt = bp;
  }
  { const int bp = NXB(NXB(bt));
  SBAR(); qk_fin8(pB0, pB1, (const char*)K_lds + bt * SHM_K, qr, r32, hi, pA0, pA1, P8, mf, one16);
  pv_sm8(o, V_lds + bp * SHM_V, voff0, voff1, P8, ones, pB0, pB1, M, mf, al_l, r32, hi);
  finish8(pB0, pB1, P8); SBAR();
  pv8(o, V_lds + bt * SHM_V, voff0, voff1, P8, ones);
  asm volatile("s_nop 7\n\ts_nop 7\n\ts_nop 7" : "+v"(o[0]), "+v"(o[1]), "+v"(o[2]), "+v"(o[3]), "+v"(o[4]) :: "memory"); }
#undef NXB
  float rli[16];
#pragma unroll
  for (int r = 0; r < 16; ++r) rli[r] = __builtin_amdgcn_rcpf(o[4][r]);
  bf16_t* Ow = Ob + (long)(wid * QBLK) * LDO;
  wave_rows_out<true>((LAS unsigned char*)lds + 65536 + wid * 8192, o, rli, lane, [&](int row, int col8, u32x4 v) { *(u32x4*)(Ow + (long)row * LDO + col8) = v; });
  __syncthreads();
#undef SLOAD
#undef SWRITE
#undef SWAIT
}
#undef KSWZ
#undef KSWZ8
#undef SBAR
}

struct KArgs { const float* in[23]; float* out; unsigned char* ws; };
enum { I_X = 0, I_C, I_CTX, I_CCTX, I_WMOD, I_BMOD, I_WIN, I_BGATE, I_QGAIN, I_KGAIN, I_WAO, I_WFOUR, I_SGUGAIN, I_WSPAT, I_BSPAT, I_WSGUO, I_WOUT, I_WROUTER, I_BROUTER, I_WGU, I_BGU, I_WDN, I_BDN };

typedef __attribute__((address_space(4))) const char* kaptr_t;
__device__ __forceinline__ const float* INP(int i) {
    kaptr_t ka = (kaptr_t)__builtin_amdgcn_kernarg_segment_ptr();
    return (const float*)(const GAS float*)*(const unsigned long long volatile __attribute__((address_space(4)))*)(ka + i * 8);
}
__device__ __forceinline__ float* OUTP() {
    kaptr_t ka = (kaptr_t)__builtin_amdgcn_kernarg_segment_ptr();
    return (float*)(GAS float*)*(const unsigned long long volatile __attribute__((address_space(4)))*)(ka + 23 * 8);
}
struct Frame {
    LAS unsigned char* lds; unsigned char* ws;
    int tid, lane, wave, vcu, G;
};
__device__ __forceinline__ void refresh(Frame& F) {
    int w0 = F.wave; asm volatile("" : "+s"(w0)); int t = (w0 << 6) | lane_id(); asm volatile("" : "+v"(t)); F.tid = t; F.lane = t & 63; F.wave = w0;
    GAS unsigned char* w = (GAS unsigned char*)F.ws; asm volatile("" : "+s"(w)); F.ws = (unsigned char*)w;
    int v = F.vcu; asm volatile("" : "+s"(v)); F.vcu = v;
}
__device__ __forceinline__ int launder_v(int x) { asm volatile("" : "+v"(x)); return x; }
__device__ __forceinline__ int launder_s(int x) { asm volatile("" : "+s"(x)); return x; }
__device__ __forceinline__ int modrow_of(int row) { return row < SEQ ? 0 : (row < NXR ? 1 : 2); }

__device__ __forceinline__ void cvt_item(const float* src, int ldS, bf16_t* dst, int K, int k0, int srccol0, int dstrow0, LAS float* scr, int lane) {
    f32x4 v[16];
#pragma unroll
    for (int it = 0; it < 16; ++it) { const int kk = it * 4 + (lane >> 4), nn = (lane & 15) * 4; v[it] = *(const f32x4*)(src + (size_t)(k0 + kk) * ldS + srccol0 + nn); }
#pragma unroll
    for (int it = 0; it < 16; ++it) { const int kk = it * 4 + (lane >> 4), nn = (lane & 15) * 4; LAS float* s = scr + kk * 65 + nn; s[0] = v[it].x; s[1] = v[it].y; s[2] = v[it].z; s[3] = v[it].w; }
    asm volatile("s_waitcnt lgkmcnt(0)" ::: "memory");
    const int kb = lane & 7;
#pragma unroll
    for (int j = 0; j < 8; ++j) {
        const int n = (lane >> 3) + 8 * j; const LAS float* s = scr + (8 * kb) * 65 + n;
        u32x4 o; o.x = cvt_pk_bf16(s[0], s[65]); o.y = cvt_pk_bf16(s[2 * 65], s[3 * 65]); o.z = cvt_pk_bf16(s[4 * 65], s[5 * 65]); o.w = cvt_pk_bf16(s[6 * 65], s[7 * 65]);
        *(u32x4*)(dst + (size_t)(dstrow0 + n) * K + k0 + 8 * kb) = o;
    }
    asm volatile("s_waitcnt lgkmcnt(0)" ::: "memory");
}

struct CvtDesc { const float* src; unsigned char* dst; int ldS, k0, srccol0, dstrow0; };
__device__ __forceinline__ void cvt_load(const CvtDesc& d, f32x4 (&v)[16], int lane) {
#pragma unroll
    for (int it = 0; it < 16; ++it) { const int kk = it * 4 + (lane >> 4), nn = (lane & 15) * 4; v[it] = *(const f32x4*)(d.src + (size_t)(d.k0 + kk) * d.ldS + d.srccol0 + nn); }
}
__device__ __forceinline__ void cvt_finish(const CvtDesc& d, const f32x4 (&v)[16], LAS float* scr, int lane) {
#pragma unroll
    for (int it = 0; it < 16; ++it) { const int kk = it * 4 + (lane >> 4), nn = (lane & 15) * 4; LAS float* s = scr + kk * 65 + nn; s[0] = v[it].x; s[1] = v[it].y; s[2] = v[it].z; s[3] = v[it].w; }
    asm volatile("s_waitcnt lgkmcnt(0)" ::: "memory");
    const int kb = lane & 7;
#pragma unroll
    for (int j = 0; j < 8; ++j) {
        const int n = (lane >> 3) + 8 * j; const LAS float* s = scr + (8 * kb) * 65 + n;
        u32x2 o; o.x = pk4_fp8(s[0] * 64.f, s[65] * 64.f, s[2 * 65] * 64.f, s[3 * 65] * 64.f); o.y = pk4_fp8(s[4 * 65] * 64.f, s[5 * 65] * 64.f, s[6 * 65] * 64.f, s[7 * 65] * 64.f);
        *(u32x2*)(d.dst + (size_t)(d.dstrow0 + n) * DM + d.k0 + 8 * kb) = o;
    }
    asm volatile("s_waitcnt lgkmcnt(0)" ::: "memory");
}
__device__ __forceinline__ void p0_prologue(Frame& F) {
    const int gw = F.vcu * 8 + F.wave, NGW = F.G * 8;
    LAS float* scr = (LAS float*)(F.lds + F.wave * 16640);
    {
        constexpr int I_IN = 16 * 96, I_SQ = 256, I_S = 128;
        constexpr int PER_L = I_IN + 2 * I_SQ + I_S;
        for (int it = gw; it < DEPTH * PER_L; it += NGW) {
            const int l = it / PER_L; int r = it % PER_L;
            if (r < I_IN) { const int kb = r / 96, nb = r % 96; CvtDesc d; d.src = INP(I_WIN) + (size_t)l * DM * IN_DIM; d.dst = (unsigned char*)(F.ws + WS_WIN) + (size_t)l * IN_DIM * DM; d.ldS = IN_DIM; d.k0 = kb * 64; d.srccol0 = nb * 64; d.dstrow0 = nb * 64;
                f32x4 vv[16]; cvt_load(d, vv, F.lane); cvt_finish(d, vv, scr, F.lane); continue; } r -= I_IN;
            if (r < I_SQ) { const int kb = r / 16, nb = r % 16; cvt_item(INP(I_WAO) + (size_t)l * DM * DM, DM, (bf16_t*)(F.ws + WS_WA) + (size_t)l * DM * DM, DM, kb * 64, nb * 64, nb * 64, scr, F.lane); continue; } r -= I_SQ;
            if (r < I_SQ) { const int kb = r / 16, nb = r % 16; cvt_item(INP(I_WOUT) + (size_t)l * DM * DM, DM, (bf16_t*)(F.ws + WS_WO) + (size_t)l * DM * DM, DM, kb * 64, nb * 64, nb * 64, scr, F.lane); continue; } r -= I_SQ;
            { const int kb = r / 16, nb = r % 16; cvt_item(INP(I_WSGUO) + (size_t)l * 512 * DM, DM, (bf16_t*)(F.ws + WS_WS) + (size_t)l * DM * DM, DM, kb * 64, nb * 64, nb * 64, scr, F.lane); }
        }
    }
    __syncthreads();
    {
        LAS float* red = (LAS float*)F.lds;
        LAS float* sil = (LAS float*)(F.lds + 8192);
        float* MOD = (float*)(F.ws + WS_MOD);
        for (int i = F.tid; i < 3 * DM; i += 512) { const int r = i >> 10, k = i & 1023; const float c = r < 2 ? INP(I_C)[r * DM + k] : INP(I_CCTX)[k]; sil[i] = c * sigmoidf_(c); }
        __syncthreads();
        for (int u = (F.G >= 256 ? (F.vcu < 128 ? F.vcu : DEPTH * 96) : F.vcu); u < DEPTH * 96; u += (F.G >= 256 ? 128 : F.G)) {
            const int l = u / 96, j0 = (u % 96) * 64;
            const float* wm = INP(I_WMOD) + (size_t)l * DM * 6144 + (size_t)(F.wave * 128) * 6144 + j0 + F.lane;
            float a0 = 0.f, a1 = 0.f, a2 = 0.f;
#pragma unroll 32
            for (int kk = 0; kk < 128; ++kk) {
                const float w = wm[(size_t)kk * 6144]; const int k = F.wave * 128 + kk;
                a0 += sil[k] * w; a1 += sil[1024 + k] * w; a2 += sil[2048 + k] * w;
            }
            red[(F.wave * 3 + 0) * 64 + F.lane] = a0; red[(F.wave * 3 + 1) * 64 + F.lane] = a1; red[(F.wave * 3 + 2) * 64 + F.lane] = a2;
            __syncthreads();
            if (F.tid < 192) { const int r = F.tid >> 6, j = F.tid & 63; float sacc = 0.f;
#pragma unroll
                for (int w = 0; w < 8; ++w) sacc += red[(w * 3 + r) * 64 + j];
                MOD[((size_t)l * 3 + r) * 6144 + j0 + j] = sacc + INP(I_BMOD)[(size_t)l * 6144 + j0 + j]; }
            __syncthreads();
        }
    }
    {
        bf16_t* T1 = (bf16_t*)(F.ws + WS_T1); bf16_t* T2 = (bf16_t*)(F.ws + WS_T2); bf16_t* TC = (bf16_t*)(F.ws + WS_TC); bf16_t* WSP = (bf16_t*)(F.ws + WS_WSP);
        const int gt = F.vcu * 512 + F.tid, NGT = F.G * 512;
        for (int i = gt; i < 64 * 256 * 128 / 2; i += NGT) {
            const int n2 = (2 * i) & 127, m = ((2 * i) >> 7) & 255, n1 = (2 * i) >> 15, k2 = m & 127, reim = m >> 7; float v[2];
#pragma unroll
            for (int q = 0; q < 2; ++q) { const int r = (k2 * (n1 + 64 * (n2 + q))) & 8191; float sn, cs; sincospif((float)r * (1.0f / 4096.0f), &sn, &cs); v[q] = (reim ? -sn : cs) * 0.08838834764831845f; }
            ((unsigned*)T1)[i] = cvt_pk_bf16(v[0], v[1]);
        }
        for (int i = gt; i < 128 * 128 / 2; i += NGT) {
            const int j0 = (2 * i) & 127, m = (2 * i) >> 7, ri = j0 >> 6, k1 = m & 63, ro = m >> 6; float v[2];
#pragma unroll
            for (int q = 0; q < 2; ++q) { const int n1 = (j0 + q) & 63; const int r = (k1 * n1) & 63; float sn, cs; sincospif((float)r * (1.0f / 32.0f), &sn, &cs); v[q] = ((ro == ri) ? cs : (ro == 0 ? sn : -sn)) * 0.125f; }
            ((unsigned*)T2)[i] = cvt_pk_bf16(v[0], v[1]);
        }
        for (int i = gt; i < 512 * 256 / 2; i += NGT) {
            const int n = (2 * i) & 255, m = (2 * i) >> 8, k = m & 255, reim = m >> 8; float v[2];
#pragma unroll
            for (int q = 0; q < 2; ++q) { const int r = (k * (n + q)) & 255; float sn, cs; sincospif((float)r * (1.0f / 128.0f), &sn, &cs); v[q] = (reim ? -sn : cs) * 0.0625f; }
            ((unsigned*)TC)[i] = cvt_pk_bf16(v[0], v[1]);
        }
        for (int i = gt; i < 128 * 32; i += NGT) { const int pos = i >> 5, f = i & 31; float sn, cs; sincosf((float)pos * exp2f(-(float)f * (13.287712379549449f / 32.0f)), &sn, &cs);
            ((float*)(F.ws + WS_ROPE))[i] = cs; ((float*)(F.ws + WS_ROPE))[4096 + i] = sn; }
        const float* wsp = INP(I_WSPAT);
        for (int i = gt; i < DEPTH * 4 * 128 * 128 / 2; i += NGT) { const f32x2 v = ((const f32x2*)wsp)[i]; ((unsigned*)WSP)[i] = cvt_pk_bf16(v.x, v.y); }
    }
    {
        LAS float* wt = (LAS float*)F.lds;
        LAS float* tb = (LAS float*)(F.lds + 32768);
        if (F.tid < 128) { float s, c; sincospif((float)F.tid * (1.0f / 64.0f), &s, &c); tb[F.tid] = c; tb[128 + F.tid] = s; }
        for (int u = (F.G >= 256 ? F.vcu - 128 : F.vcu); u < DEPTH * 4 * 16; u += F.G) {
            if (u < 0) continue;
            const int l = u / 64, g = (u / 16) & 3, d0 = (u & 15) * 64;
            __syncthreads();
            for (int i = F.tid; i < 128 * 64; i += 512) { const int m = i >> 6, d = i & 63; wt[i] = INP(I_WFOUR)[((size_t)l * 512 + g * 128 + m) * DM + d0 + d]; }
            __syncthreads();
            const int c = F.tid & 127, dq = F.tid >> 7;
            float ar[16], ai[16];
#pragma unroll
            for (int i = 0; i < 16; ++i) { ar[i] = 0.f; ai[i] = 0.f; }
            for (int m = 0; m < 128; ++m) {
                const int r = (m * c) & 127; const float cs = tb[r], sn = tb[128 + r];
#pragma unroll
                for (int i = 0; i < 16; ++i) { const float w = wt[m * 64 + dq * 16 + i]; ar[i] += cs * w; ai[i] += sn * w; }
            }
            bf16_t* W = (bf16_t*)(F.ws + WS_WFP) + (size_t)l * DM * DM;
            const bool oddc = (c & 1) != 0;
#pragma unroll
            for (int i = 0; i < 16; ++i) { const size_t rowo = (size_t)(d0 + dq * 16 + i) * DM;
                const float a = ar[i] * 0.08838834764831845f, b = ai[i] * 0.08838834764831845f; const float recv = sx<1>(oddc ? a : b);
                *(unsigned*)(W + rowo + (oddc ? 512 : 0) + g * 128 + (c & ~1)) = cvt_pk_bf16(oddc ? recv : a, oddc ? b : recv); }
        }
    }
}

constexpr int MOE_ITEMS = NEXP * (512 + 256);
__device__ __forceinline__ CvtDesc moe_cvt_desc(Frame& F, int l, int it) {
    CvtDesc d; const int e = it / 768; int r = it % 768;
    if (r < 512) { const int kb = r / 32, nb = r % 32;
        const int T = nb >> 2, half = (nb >> 1) & 1, i0 = (nb & 1) * 64;
        d.src = INP(I_WGU) + ((size_t)l * NEXP + e) * DM * 2048; d.ldS = 2048; d.dst = (unsigned char*)(F.ws + WS_WGU) + ((size_t)l * NEXP + e) * 2048 * DM; d.k0 = kb * 64; d.srccol0 = half * 1024 + T * 128 + i0; d.dstrow0 = nb * 64; }
    else { r -= 512; const int kb = r / 16, nb = r % 16;
        d.src = INP(I_WDN) + ((size_t)l * NEXP + e) * DM * DM; d.ldS = DM; d.dst = (unsigned char*)(F.ws + WS_WDN) + ((size_t)l * NEXP + e) * DM * DM; d.k0 = kb * 64; d.srccol0 = nb * 64; d.dstrow0 = nb * 64; }
    return d;
}
struct FillCur { int c0, c1;
    __device__ __forceinline__ int get(int l) const { return l == 0 ? c0 : c1; }
    __device__ __forceinline__ void add(int l, int n) { if (l == 0) c0 += n; else c1 += n; } };
__device__ __forceinline__ void fill_range(Frame& F, int lay, int lo, int hi, int widx, int nw) {
    LAS float* scr = (LAS float*)(F.lds + F.wave * 16640);
    int it = lo + widx; if (it >= hi) return;
    f32x4 va[16], vb[16]; CvtDesc da = moe_cvt_desc(F, lay, it), db = da;
    cvt_load(da, va, F.lane);
    for (;;) {
        const bool hb = it + nw < hi; if (hb) { db = moe_cvt_desc(F, lay, it + nw); cvt_load(db, vb, F.lane); }
        cvt_finish(da, va, scr, F.lane); if (!hb) break;
        const bool ha = it + 2 * nw < hi; if (ha) { da = moe_cvt_desc(F, lay, it + 2 * nw); cvt_load(da, va, F.lane); }
        cvt_finish(db, vb, scr, F.lane); if (!ha) break;
        it += 2 * nw;
    }
}
__device__ __forceinline__ void fill_after(Frame& F, FillCur& C, int lmin, int total, int c, int per_wave) {
    const int rem = total % F.G; if (rem == 0) return;
    const int n_idle = F.G - rem, nw = n_idle * 8; int budget = nw * per_wave;
    const bool idle = c >= rem; const int widx = (c - rem) * 8 + F.wave;
#pragma unroll
    for (int lay = 0; lay < DEPTH; ++lay) { if (lay < lmin) continue;
        const int cu = C.get(lay), take = (MOE_ITEMS - cu < budget) ? MOE_ITEMS - cu : budget;
        if (take > 0) { if (idle) fill_range(F, lay, cu, cu + take, widx, nw); C.add(lay, take); budget -= take; } }
}
__device__ __forceinline__ void fill_cleanup(Frame& F, FillCur& C, int lay) {
    const int cu = C.get(lay); if (cu < MOE_ITEMS) { fill_range(F, lay, cu, MOE_ITEMS, F.vcu * 8 + F.wave, F.G * 8); C.add(lay, MOE_ITEMS - cu); }
}

__device__ __forceinline__ void p_norm1(Frame& F, int l, int nrows) {
    const int gw = F.vcu * 8 + F.wave, NGW = F.G * 8;
    const float* MOD = (const float*)(F.ws + WS_MOD) + (size_t)l * 3 * 6144;
#define N1_SRC(r_) ((const f32x4*)((l == 0) ? ((r_) < NXR ? INP(I_X) + (size_t)(r_) * DM : INP(I_CTX) + (size_t)((r_) - NXR) * DM) : (const float*)(F.ws + WS_XW) + (size_t)(r_) * DM) + F.lane)
    f32x4 nv[4] = {};
    if (gw < nrows) { const f32x4* xr = N1_SRC(gw);
#pragma unroll
        for (int j = 0; j < 4; ++j) nv[j] = xr[64 * j]; }
    for (int row = gw; row < nrows; row += NGW) {
        f32x4 v[4]; float ss = 0.f;
#pragma unroll
        for (int j = 0; j < 4; ++j) v[j] = nv[j];
        if (row + NGW < nrows) { const f32x4* xr = N1_SRC(row + NGW);
#pragma unroll
            for (int j = 0; j < 4; ++j) nv[j] = xr[64 * j]; }
#pragma unroll
        for (int j = 0; j < 4; ++j) ss += (v[j].x * v[j].x + v[j].y * v[j].y) + (v[j].z * v[j].z + v[j].w * v[j].w);
        const float* md = MOD + (size_t)modrow_of(row) * 6144;
        f32x4 sh[4], sc[4];
#pragma unroll
        for (int j = 0; j < 4; ++j) { const int c = 4 * F.lane + 256 * j; sh[j] = *(const f32x4*)(md + c); sc[j] = *(const f32x4*)(md + 1024 + c); }
        const float rstd = rsqrtf(wave_sum(ss) * (1.f / DM) + EPS);
        unsigned* o = (unsigned*)((unsigned char*)(F.ws + WS_HX8) + (size_t)row * DM) + F.lane;
#pragma unroll
        for (int j = 0; j < 4; ++j) { const f32x4 h = v[j] * rstd * (sc[j] + 1.0f) + sh[j]; o[64 * j] = pk4_fp8(h.x, h.y, h.z, h.w); }
    }
#undef N1_SRC
}

struct SchedIn {
    const char* A; const char* B; int G, c, nxt_total, last;
    __device__ __forceinline__ bool next(int i, g8::Unit& u) const {
        const int L = i * G + c; if (L >= nxt_total) return false;
        int pm, pn;
        if (L < 64 * 24) g8::tile_order(L, 64, 24, pm, pn);
        else { const int r = L - 64 * 24; if (last) { pm = 64 + (r >> 1); pn = 4 + (r & 1); } else { pm = 64 + r / 24; pn = r % 24; } }
        u.A = A + (size_t)pm * 256 * 1024; u.B = B + (size_t)pn * 256 * 1024; u.nt = 8; u.pm = pm; u.pn = pn; u.aux = 0; return true;
    }
};
struct EpiIn {
    static constexpr bool PERM = true; static constexpr int NAUX = 0;
    bf16_t* PX; bf16_t* GT; const float* bgate;
    __device__ __forceinline__ bool operator()(f32x4 (&acc)[2][2][4][2], const g8::Unit& u, int wr, int wc, int fr, int fq, const LAS float* aux) const {
        const int row0 = u.pm * 256 + wr * 64 + fr; const bool gates = u.pn >= 12;
        bf16_t* base = gates ? GT : PX; const int colt = (gates ? u.pn - 12 : u.pn) * 256, col0 = colt + wc * 32 + 8 * fq;
        f32x4 bv[2][2];
#pragma unroll
        for (int bj = 0; bj < 2; ++bj)
#pragma unroll
            for (int n = 0; n < 2; ++n) bv[bj][n] = gates ? *(const f32x4*)(bgate + col0 + bj * 128 + 4 * n) : (f32x4){0.f, 0.f, 0.f, 0.f};
#pragma unroll
        for (int ai = 0; ai < 2; ++ai)
#pragma unroll
            for (int m = 0; m < 4; ++m) { bf16_t* rowp = base + (size_t)(row0 + ai * 128 + m * 16) * 3072 + col0;
#pragma unroll
                for (int bj = 0; bj < 2; ++bj) { f32x4 v0 = acc[ai][bj][m][0] * 0.015625f + bv[bj][0], v1 = acc[ai][bj][m][1] * 0.015625f + bv[bj][1];
                    if (gates) {
#pragma unroll
                        for (int j = 0; j < 4; ++j) { v0[j] = sigmoidf_(v0[j]); v1[j] = sigmoidf_(v1[j]); } }
                    u32x4 w; w.x = cvt_pk_bf16(v0[0], v0[1]); w.y = cvt_pk_bf16(v0[2], v0[3]); w.z = cvt_pk_bf16(v1[0], v1[1]); w.w = cvt_pk_bf16(v1[2], v1[3]);
                    *(u32x4*)(rowp + bj * 128) = w; } }
        return false;
    }
};

__device__ __forceinline__ void p_postproj(Frame& F, int l, int nrows) {
    const int gw = F.vcu * 8 + F.wave, NGW = F.G * 8, L = F.lane, hs = L >> 4, j = L & 15;
    const bf16_t* PX = (const bf16_t*)(F.ws + WS_PX);
    const float* qg = INP(I_QGAIN) + l * 128 + 8 * j; const float* kg = INP(I_KGAIN) + l * 128 + 8 * j; const float* sg = INP(I_SGUGAIN) + l * 512 + hs * 128 + 8 * j;
    float qgv[8], kgv[8], sgv[8];
#pragma unroll
    for (int i = 0; i < 8; ++i) { qgv[i] = qg[i]; kgv[i] = kg[i]; sgv[i] = sg[i]; }
    const int ax = j >> 3, half = (j >> 2) & 1, f0 = 8 * (j & 3);
    const float* RC = (const float*)(F.ws + WS_ROPE);
#define PP_LOAD(r_, a0, a1, a2, a3) do { const bf16_t* p_ = PX + (size_t)(r_) * PXW; a0 = *(const u32x4*)(p_ + hs * 128 + 8 * j); a1 = *(const u32x4*)(p_ + (4 + hs) * 128 + 8 * j); \
        if (hs < 2) a2 = *(const u32x4*)(p_ + K_OFF + hs * 128 + 8 * j);   a3 = *(const u32x4*)(p_ + VG_OFF + hs * 128 + 8 * j); } while (0)
#define PP_RC(r_) do { const bool isx_ = (r_) < NXR; const int s_ = isx_ ? ((r_) & 8191) : (((r_) - NXR) & 255); const int pos_ = isx_ ? (ax ? (s_ & 63) : (s_ >> 6)) : 0; \
        nc0 = *(const f32x4*)(RC + pos_ * 32 + f0); nc1 = *(const f32x4*)(RC + pos_ * 32 + f0 + 4); ns0 = *(const f32x4*)(RC + 4096 + pos_ * 32 + f0); ns1 = *(const f32x4*)(RC + 4096 + pos_ * 32 + f0 + 4); } while (0)
    u32x4 nq0 = {}, nq1 = {}, nkv = {}, nvg = {}; f32x4 nc0 = {}, nc1 = {}, ns0 = {}, ns1 = {};
    if (gw < nrows) { PP_LOAD(gw, nq0, nq1, nkv, nvg); PP_RC(gw); }
    for (int row = gw; row < nrows; row += NGW) {
        const bool isx = row < NXR; const int b = isx ? (row >> 13) : ((row - NXR) >> 8), s = isx ? (row & 8191) : ((row - NXR) & 255);
        const int pos = isx ? (ax ? (s & 63) : (s >> 6)) : 0;
        float cs[8], sn[8];
        { const f32x4 c0 = nc0, c1 = nc1, s0 = ns0, s1 = ns1; (void)pos;
#pragma unroll
          for (int i = 0; i < 4; ++i) { cs[i] = c0[i]; cs[4 + i] = c1[i]; sn[i] = half ? s0[i] : -s0[i]; sn[4 + i] = half ? s1[i] : -s1[i]; } }
        const bf16_t* pr = PX + (size_t)row * PXW;
        const size_t krow = (size_t)b * LK + (isx ? s : SEQ + s);
        const u32x4 wq0 = nq0, wq1 = nq1, wkv = nkv, wvg = nvg; (void)pr;
        if (row + NGW < nrows) { PP_LOAD(row + NGW, nq0, nq1, nkv, nvg); PP_RC(row + NGW); }
#pragma unroll
        for (int p = 0; p < 4; ++p) {
            const u32x4 w = p == 0 ? wq0 : p == 1 ? wq1 : p == 2 ? wkv : wvg;
            float v[8] = {bf_lo(w.x), bf_hi(w.x), bf_lo(w.y), bf_hi(w.y), bf_lo(w.z), bf_hi(w.z), bf_lo(w.w), bf_hi(w.w)};
            if (p == 3) {
#pragma unroll
                for (int i = 0; i < 8; ++i) v[i] = gelu_tanh(v[i]); }
            float ss = 0.f;
#pragma unroll
            for (int i = 0; i < 8; ++i) ss += v[i] * v[i];
            ss += sx<1>(ss); ss += sx<2>(ss); ss += sx<4>(ss); ss += sx<8>(ss);
            const float rstd = rsqrtf(ss * (1.f / 128.f) + EPS);
            const bool plain = (p == 2 && hs >= 2);
            const bool rope = isx && (p < 2 || (p == 2 && hs < 2));
            float o[8];
#pragma unroll
            for (int i = 0; i < 8; ++i) { const float gn = p < 2 ? qgv[i] : p == 2 ? kgv[i] : sgv[i]; o[i] = v[i] * rstd * gn; }
            if (p < 3) {
#pragma unroll
                for (int i = 0; i < 8; ++i) { const float pa = sx<4>(o[i]); if (rope) o[i] = o[i] * cs[i] + pa * sn[i]; } }
            const bool f8 = p < 2 || (p == 2 && hs < 2);
            const float qs = p < 2 ? att::SCALE * 1.4426950408889634f : 1.f;
            u32x2 q8; q8.x = pk4_fp8(o[0] * qs, o[1] * qs, o[2] * qs, o[3] * qs); q8.y = pk4_fp8(o[4] * qs, o[5] * qs, o[6] * qs, o[7] * qs);
            u32x4 q; q.x = plain ? w.x : cvt_pk_bf16(o[0], o[1]); q.y = plain ? w.y : cvt_pk_bf16(o[2], o[3]); q.z = plain ? w.z : cvt_pk_bf16(o[4], o[5]); q.w = plain ? w.w : cvt_pk_bf16(o[6], o[7]);
            if (f8) { unsigned char* d8 = p == 0 ? (unsigned char*)(F.ws + WS_QN) + (size_t)row * DM + hs * 128 : p == 1 ? (unsigned char*)(F.ws + WS_QN) + (size_t)row * DM + (4 + hs) * 128
                                         : (unsigned char*)(F.ws + WS_KN) + krow * 256 + hs * 128;
                *(u32x2*)(d8 + 8 * j) = q8; }
            else if (p == 3) *(u32x4*)((bf16_t*)(F.ws + WS_VGN) + (size_t)row * 512 + hs * 128 + 8 * j) = q;
        }
    }
#undef PP_LOAD
#undef PP_RC
}

__device__ __forceinline__ void p_vblocks(Frame& F) {
    LAS unsigned char* T = F.lds;
    const bf16_t* PX = (const bf16_t*)(F.ws + WS_PX);
    const int key = F.tid >> 3, pc = F.tid & 7, w = key & 31, pos = 32 * ((w >> 2) & 1) + 16 * (key >> 5) + (w & 3) + 4 * (w >> 3);
#define VB_LOAD(u_, A, C) do { const int t_ = (u_) % 132, kvh_ = ((u_) / 132) & 1, b_ = (u_) / 264; \
        const size_t row_ = t_ < 128 ? (size_t)b_ * SEQ + 64 * t_ + key : (size_t)NXR + b_ * CTX + 64 * (t_ - 128) + key; \
        const u32x4* src_ = (const u32x4*)(PX + row_ * PXW + V_OFF + kvh_ * 128 + 16 * pc); A = src_[0]; C = src_[1]; } while (0)
    u32x4 na = {}, nc = {};
    if (F.vcu < NB * 2 * 132) VB_LOAD(F.vcu, na, nc);
    for (int u = F.vcu; u < NB * 2 * 132; u += F.G) {
        const u32x4 a = na, c = nc;
        const unsigned q0 = pk4_fp8(bf_lo(a.x), bf_hi(a.x), bf_lo(a.y), bf_hi(a.y)), q1 = pk4_fp8(bf_lo(a.z), bf_hi(a.z), bf_lo(a.w), bf_hi(a.w));
        const unsigned q2 = pk4_fp8(bf_lo(c.x), bf_hi(c.x), bf_lo(c.y), bf_hi(c.y)), q3 = pk4_fp8(bf_lo(c.z), bf_hi(c.z), bf_lo(c.w), bf_hi(c.w));
        __syncthreads();
#pragma unroll
        for (int i = 0; i < 4; ++i) { T[(16 * pc + i) * 64 + pos] = (unsigned char)(q0 >> (8 * i)); T[(16 * pc + 4 + i) * 64 + pos] = (unsigned char)(q1 >> (8 * i));
            T[(16 * pc + 8 + i) * 64 + pos] = (unsigned char)(q2 >> (8 * i)); T[(16 * pc + 12 + i) * 64 + pos] = (unsigned char)(q3 >> (8 * i)); }
        __syncthreads();
        if (u + F.G < NB * 2 * 132) VB_LOAD(u + F.G, na, nc);
        *(u32x4*)((unsigned char*)(F.ws + WS_VN) + (size_t)u * 8192 + F.tid * 16) = *(const LAS u32x4*)(T + F.tid * 16);
    }
#undef VB_LOAD
    __syncthreads();
}

template <int M, int K, class Epi>
__device__ __forceinline__ void lm_unit(Frame& F, const bf16_t* __restrict__ Wm, const bf16_t* __restrict__ in, size_t in_stride, const Epi& E) {
    constexpr int NTL = K / 64;
    constexpr bool HOIST = (M / 32 == 8) && NTL <= 2;
    const int r32 = F.lane & 31, hi = F.lane >> 5;
    bf16x8 pw[NTL][4];
    __syncthreads();
    {
        const int sr = F.tid >> 4, sc = (F.tid & 15) * 8, vst0 = att::v_st(sr, sc), vst1 = att::v_st(32 + sr, sc);
        bf16x8 t0[NTL], t1[NTL];
#pragma unroll
        for (int t = 0; t < NTL; ++t) { t0[t] = *(const bf16x8*)(in + (size_t)(t * 64 + sr) * in_stride + sc); t1[t] = *(const bf16x8*)(in + (size_t)(t * 64 + 32 + sr) * in_stride + sc); }
        if constexpr (HOIST) { const bf16_t* wrow = Wm + (size_t)(F.wave * 32 + r32) * K + hi * 8;
#pragma unroll
            for (int t = 0; t < NTL; ++t)
#pragma unroll
                for (int i = 0; i < 4; ++i) pw[t][i] = *(const bf16x8*)(wrow + t * 64 + 16 * i); }
#pragma unroll
        for (int t = 0; t < NTL; ++t) { *(LAS bf16x8*)(F.lds + t * 16384 + vst0) = t0[t]; *(LAS bf16x8*)(F.lds + t * 16384 + vst1) = t1[t]; }
    }
    __syncthreads();
    const int vb0 = (int)(unsigned)(uintptr_t)F.lds + att::v_rd_base(F.lane);
    for (int rb = F.wave; rb < M / 32; rb += 8) {
        f32x16 o[4] = {};
        const bf16_t* wrow = Wm + (size_t)(rb * 32 + r32) * K + hi * 8;
#pragma unroll
        for (int t = 0; t < NTL; ++t) {
            if constexpr (HOIST) att::pv_d0(o, vb0 + t * 16384, pw[t][0], pw[t][1], pw[t][2], pw[t][3]);
            else { const bf16x8 pa0 = *(const bf16x8*)(wrow + t * 64), pa1 = *(const bf16x8*)(wrow + t * 64 + 16), pa2 = *(const bf16x8*)(wrow + t * 64 + 32), pa3 = *(const bf16x8*)(wrow + t * 64 + 48);
                att::pv_d0(o, vb0 + t * 16384, pa0, pa1, pa2, pa3); }
        }
        if constexpr (HOIST) { const float one[16] = {};
            att::wave_rows_out<false>(F.lds + 65536 + F.wave * 8192, o, one, F.lane, [&](int row, int col8, u32x4 v) { E.rows(rb * 32 + row, col8, v); }); }
        else {
        const bool odd = (F.lane & 1) != 0;
#pragma unroll
        for (int r = 0; r < 16; ++r) { const int row = rb * 32 + att::crow(r, hi);
#pragma unroll
            for (int dp = 0; dp < 4; dp += 2) {
                const float recv = sx<1>(odd ? o[dp][r] : o[dp + 1][r]);
                E(row, odd ? (dp + 1) * 32 + r32 - 1 : dp * 32 + r32, odd ? recv : o[dp][r], odd ? o[dp + 1][r] : recv); } }
        }
    }
}
template <class EpiA, class EpiB>
__device__ __forceinline__ void lm_unit_pair(Frame& F, const bf16_t* __restrict__ WmA, const bf16_t* __restrict__ inA, const EpiA& EA, const bf16_t* __restrict__ WmB, const bf16_t* __restrict__ inB, const EpiB& EB, size_t in_stride, bool hasB) {
    const int r32 = F.lane & 31, hi = F.lane >> 5;
    bf16x8 pw[2][4];
    __syncthreads();
    {
        const int sr = F.tid >> 4, sc = (F.tid & 15) * 8, vst0 = att::v_st(sr, sc), vst1 = att::v_st(32 + sr, sc);
        bf16x8 t0[4], t1[4];
#pragma unroll
        for (int t = 0; t < 4; ++t) { const bf16_t* in = (t < 2 || !hasB) ? inA : inB; const int tt = t & 1;
            t0[t] = *(const bf16x8*)(in + (size_t)(tt * 64 + sr) * in_stride + sc); t1[t] = *(const bf16x8*)(in + (size_t)(tt * 64 + 32 + sr) * in_stride + sc); }
        { const bf16_t* wrow = ((F.wave >> 2) ? WmB : WmA) + (size_t)((F.wave & 3) * 32 + r32) * 128 + hi * 8;
#pragma unroll
            for (int t = 0; t < 2; ++t)
#pragma unroll
                for (int i = 0; i < 4; ++i) pw[t][i] = *(const bf16x8*)(wrow + t * 64 + 16 * i); }
#pragma unroll
        for (int t = 0; t < 4; ++t) { *(LAS bf16x8*)(F.lds + t * 16384 + vst0) = t0[t]; *(LAS bf16x8*)(F.lds + t * 16384 + vst1) = t1[t]; }
    }
    __syncthreads();
    const int pb = F.wave >> 2, rb = F.wave & 3;
    if (pb == 0 || hasB) {
        const int vb0 = (int)(unsigned)(uintptr_t)F.lds + att::v_rd_base(F.lane) + pb * 32768;
        f32x16 o[4] = {};
#pragma unroll
        for (int t = 0; t < 2; ++t) att::pv_d0(o, vb0 + t * 16384, pw[t][0], pw[t][1], pw[t][2], pw[t][3]);
        const bool odd = (F.lane & 1) != 0;
#pragma unroll
        for (int r = 0; r < 16; ++r) { const int row = rb * 32 + att::crow(r, hi);
#pragma unroll
            for (int dp = 0; dp < 4; dp += 2) {
                const float recv = sx<1>(odd ? o[dp][r] : o[dp + 1][r]);
                const int col = odd ? (dp + 1) * 32 + r32 - 1 : dp * 32 + r32; const float v0 = odd ? recv : o[dp][r], v1 = odd ? o[dp + 1][r] : recv;
                if (pb == 0) EA(row, col, v0, v1); else EB(row, col, v0, v1); } }
    }
}
__device__ __forceinline__ unsigned lm_dma_lane_off(int wave, int lane, int i, unsigned in_stride) {
    const int g = wave * 128 + i * 64 + lane, blk = g >> 5, within = g & 31, kk = (blk >> 2) * 8 + (within >> 2), c = (blk & 3) * 32 + (within & 3) * 8;
    const int k = (kk & ~0xC) | ((kk & 4) << 1) | ((kk & 8) >> 1);
    return ((unsigned)k * in_stride + (unsigned)c) * 2u;
}
__device__ __forceinline__ void lm_dma_pair(Frame& F, const bf16_t* inA, const bf16_t* inB, unsigned in_stride, int bufoff, unsigned lo0, unsigned lo1) {
#pragma unroll
    for (int t = 0; t < 4; ++t) { const char* base = (const char*)((t < 2 ? inA : inB) + (size_t)((t & 1) * 64) * in_stride);
        unsigned a0 = lo0, a1 = lo1; asm volatile("" : "+v"(a0), "+v"(a1));
        __builtin_amdgcn_global_load_lds((const unsigned*)(base + a0), (LAS unsigned*)(F.lds + bufoff + t * 16384 + F.wave * 2048), 16, 0, 0);
        __builtin_amdgcn_global_load_lds((const unsigned*)(base + a1), (LAS unsigned*)(F.lds + bufoff + t * 16384 + F.wave * 2048 + 1024), 16, 0, 0); }
}
template <class Epi>
__device__ __forceinline__ void lm_pair_compute(Frame& F, const bf16x8 (&pw)[2][4], int bufoff, const Epi& E) {
    const int r32 = F.lane & 31, hi = F.lane >> 5, pb = F.wave >> 2, rb = F.wave & 3;
    const int vb0 = (int)(unsigned)(uintptr_t)F.lds + bufoff + att::v_rd_base(F.lane) + pb * 32768;
    f32x16 o[4] = {};
#pragma unroll
    for (int t = 0; t < 2; ++t) att::pv_d0(o, vb0 + t * 16384, pw[t][0], pw[t][1], pw[t][2], pw[t][3]);
    __syncthreads();
    const float one[16] = {};
    att::wave_rows_out<false>(F.lds + bufoff + F.wave * 8192, o, one, F.lane, [&](int row, int col8, u32x4 v) { E.rows(rb * 32 + row, col8, v); });
    (void)r32; (void)hi;
}
__device__ __forceinline__ void lm_load_w(Frame& F, bf16x8 (&pw)[2][4], const bf16_t* Wm) {
    const bf16_t* wrow = Wm + (size_t)((F.wave & 3) * 32 + (F.lane & 31)) * 128 + (F.lane >> 5) * 8;
#pragma unroll
    for (int t = 0; t < 2; ++t)
#pragma unroll
        for (int i = 0; i < 4; ++i) pw[t][i] = *(const bf16x8*)(wrow + t * 64 + 16 * i);
}
struct EpiStore2 {
    bf16_t* base; int Mh; size_t s1, s2;
    __device__ __forceinline__ void operator()(int m, int col, float v0, float v1) const {
        const int hi = m >= Mh ? 1 : 0, lo = m - hi * Mh;
        *(unsigned*)(base + (size_t)lo * s1 + (size_t)hi * s2 + col) = cvt_pk_bf16(v0, v1);
    }
    __device__ __forceinline__ void rows(int m, int col8, u32x4 v) const {
        const int hi = m >= Mh ? 1 : 0, lo = m - hi * Mh; *(u32x4*)(base + (size_t)lo * s1 + (size_t)hi * s2 + col8) = v;
    }
};
struct EpiSgu {
    bf16_t* sg; const bf16_t* u; const float* bs;
    __device__ __forceinline__ void operator()(int m, int col, float v0, float v1) const {
        const unsigned w = *(const unsigned*)(u + (size_t)m * PXW + col); const float b = bs[m];
        *(unsigned*)(sg + (size_t)m * DM + col) = cvt_pk_bf16((v0 + b) * gelu_tanh(bf_lo(w)), (v1 + b) * gelu_tanh(bf_hi(w)));
    }
    __device__ __forceinline__ void pre(int rbase, int lane, u32x4 (&uw)[8], float (&ub)[8]) const {
#pragma unroll
        for (int i = 0; i < 8; ++i) { const int m = rbase + 4 * i + (lane >> 4); uw[i] = *(const u32x4*)(u + (size_t)m * PXW + (lane & 15) * 8); ub[i] = bs[m]; }
    }
    __device__ __forceinline__ void rows2(int m, int col8, u32x4 v, u32x4 w, float b) const {
        u32x4 r;
        r.x = cvt_pk_bf16((bf_lo(v.x) + b) * gelu_tanh(bf_lo(w.x)), (bf_hi(v.x) + b) * gelu_tanh(bf_hi(w.x))); r.y = cvt_pk_bf16((bf_lo(v.y) + b) * gelu_tanh(bf_lo(w.y)), (bf_hi(v.y) + b) * gelu_tanh(bf_hi(w.y)));
        r.z = cvt_pk_bf16((bf_lo(v.z) + b) * gelu_tanh(bf_lo(w.z)), (bf_hi(v.z) + b) * gelu_tanh(bf_hi(w.z))); r.w = cvt_pk_bf16((bf_lo(v.w) + b) * gelu_tanh(bf_lo(w.w)), (bf_hi(v.w) + b) * gelu_tanh(bf_hi(w.w)));
        *(u32x4*)(sg + (size_t)m * DM + col8) = r;
    }
    __device__ __forceinline__ void rows(int m, int col8, u32x4 v) const {
        const u32x4 w = *(const u32x4*)(u + (size_t)m * PXW + col8); const float b = bs[m]; u32x4 r;
        r.x = cvt_pk_bf16((bf_lo(v.x) + b) * gelu_tanh(bf_lo(w.x)), (bf_hi(v.x) + b) * gelu_tanh(bf_hi(w.x))); r.y = cvt_pk_bf16((bf_lo(v.y) + b) * gelu_tanh(bf_lo(w.y)), (bf_hi(v.y) + b) * gelu_tanh(bf_hi(w.y)));
        r.z = cvt_pk_bf16((bf_lo(v.z) + b) * gelu_tanh(bf_lo(w.z)), (bf_hi(v.z) + b) * gelu_tanh(bf_hi(w.z))); r.w = cvt_pk_bf16((bf_lo(v.w) + b) * gelu_tanh(bf_lo(w.w)), (bf_hi(v.w) + b) * gelu_tanh(bf_hi(w.w)));
        *(u32x4*)(sg + (size_t)m * DM + col8) = r;
    }
};

constexpr int RT_R = 22, RT_P = 23;
__device__ __forceinline__ void p_route(Frame& F, int l, int nrows, int cbank = 0) {
    LAS float* hsT = (LAS float*)F.lds;
    LAS float* part = (LAS float*)(F.lds + 98304);
    LAS float* lgs = (LAS float*)(F.lds + 122880);
    LAS float* tval = (LAS float*)(F.lds + 122880 + 3072);
    LAS int* tk_e = (LAS int*)(F.lds + LDS_X_OFF);
    LAS float* tk_w = (LAS float*)(F.lds + LDS_X_OFF + 2048);
    LAS int* wcnt = (LAS int*)(F.lds + LDS_X_OFF + 4096);
    LAS int* ebase = (LAS int*)(F.lds + LDS_X_OFF + 4096 + 1024);
    const int chunk = (nrows + F.G - 1) / F.G;
    const int rA = F.vcu * chunk, rB = (rA + chunk < nrows) ? rA + chunk : nrows;
    const int e = F.lane & 31, kh = F.lane >> 5;
    float wreg[64];
    { const float* wr = INP(I_WROUTER) + (size_t)l * DM * NEXP + e;
#pragma unroll
      for (int m = 0; m < 64; ++m) { const int sidx = 128 * F.wave + 2 * m + kh; wreg[m] = wr[(size_t)(4 * (sidx & 255) + (sidx >> 8)) * NEXP]; } }
    const float* MOD = (const float*)(F.ws + WS_MOD) + (size_t)l * 3 * 6144;
    const float* XW = (const float*)(F.ws + WS_XW);
    __syncthreads();
    f32x4 v[3][4] = {};
#define RT_ROWS(r0_) do { const int nr_ = ((r0_) + RT_R < rB) ? RT_R : rB - (r0_); _Pragma("unroll") for (int t = 0; t < 3; ++t) { const int rr = F.wave + 8 * t; if (rr < nr_) { \
        const f32x4* xr = (const f32x4*)(XW + (size_t)((r0_) + rr) * DM) + F.lane; _Pragma("unroll") for (int j = 0; j < 4; ++j) v[t][j] = xr[64 * j]; } } } while (0)
    if (rA < rB) RT_ROWS(rA);
    for (int r0 = rA; r0 < rB; r0 += RT_R) {
        const int nr = (r0 + RT_R < rB) ? RT_R : rB - r0;
        {
#pragma unroll
            for (int t = 0; t < 3; ++t) { const int rr = F.wave + 8 * t;
              if (rr < nr) { const int row = r0 + rr; float ss = 0.f;
                const float* md = MOD + (size_t)modrow_of(row) * 6144;
                f32x4 sh[4], sc[4];
#pragma unroll
                for (int j = 0; j < 4; ++j) { const int c = 4 * F.lane + 256 * j; sh[j] = *(const f32x4*)(md + 3072 + c); sc[j] = *(const f32x4*)(md + 4096 + c); }
#pragma unroll
                for (int j = 0; j < 4; ++j) ss += (v[t][j].x * v[t][j].x + v[t][j].y * v[t][j].y) + (v[t][j].z * v[t][j].z + v[t][j].w * v[t][j].w);
                const float rstd = rsqrtf(wave_sum(ss) * (1.f / DM) + EPS);
                unsigned* o = (unsigned*)((unsigned char*)(F.ws + WS_HX) + (size_t)row * DM) + F.lane;
#pragma unroll
                for (int j = 0; j < 4; ++j) {
                    const f32x4 h = v[t][j] * rstd * (sc[j] + 1.0f) + sh[j]; o[64 * j] = pk4_fp8(h.x, h.y, h.z, h.w);
                    LAS float* d = hsT + (F.lane + 64 * j) * RT_P + rr;
                    d[0] = h.x; d[256 * RT_P] = h.y; d[512 * RT_P] = h.z; d[768 * RT_P] = h.w; } } }
            if (r0 + RT_R < rB) RT_ROWS(r0 + RT_R);
        }
        __syncthreads();
        {
            f32x16 D = {};
            const LAS float* hp = hsT + (128 * F.wave + kh) * RT_P + e;
#pragma unroll
            for (int m0 = 0; m0 < 64; m0 += 8) { float av[8];
#pragma unroll
                for (int q = 0; q < 8; ++q) av[q] = hp[(2 * (m0 + q)) * RT_P];
#pragma unroll
                for (int q = 0; q < 8; ++q) D = __builtin_amdgcn_mfma_f32_32x32x2f32(av[q], wreg[m0 + q], D, 0, 0, 0); }
#pragma unroll
            for (int r = 0; r < 16; ++r) { const int row = (r & 3) + 8 * (r >> 2) + 4 * kh; if (row < nr) part[(row * 8 + F.wave) * 32 + e] = D[r]; }
        }
        __syncthreads();
        for (int i = F.tid; i < nr * 32; i += 512) { const int r = i >> 5, ee = i & 31; float sacc = INP(I_BROUTER)[l * NEXP + ee];
#pragma unroll
            for (int w = 0; w < 8; ++w) sacc += part[(r * 8 + w) * 32 + ee];
            lgs[i] = sacc; }
        __syncthreads();
        for (int i = F.tid; i < nr * 32; i += 512) { const int r = i >> 5, ee = i & 31; const float mine = lgs[i]; int rank = 0;
#pragma unroll
            for (int q = 0; q < 8; ++q) { const f32x4 o4 = *(const LAS f32x4*)(lgs + r * 32 + 4 * q);
                rank += (o4.x > mine || (o4.x == mine && 4 * q + 0 < ee)) ? 1 : 0; rank += (o4.y > mine || (o4.y == mine && 4 * q + 1 < ee)) ? 1 : 0;
                rank += (o4.z > mine || (o4.z == mine && 4 * q + 2 < ee)) ? 1 : 0; rank += (o4.w > mine || (o4.w == mine && 4 * q + 3 < ee)) ? 1 : 0; }
            if (rank < 4) { tk_e[(r0 - rA + r) * 4 + rank] = ee; tval[r * 4 + rank] = mine; } }
        __syncthreads();
        for (int i = F.tid; i < nr * 4; i += 512) { const int r = i >> 2; const f32x4 t4 = *(const LAS f32x4*)(tval + r * 4);
            const float e1 = __expf(t4.y - t4.x), e2 = __expf(t4.z - t4.x), e3 = __expf(t4.w - t4.x), inv = __builtin_amdgcn_rcpf(1.0f + e1 + e2 + e3); const int k = i & 3;
            tk_w[(r0 - rA) * 4 + i] = (k == 0 ? 1.0f : k == 1 ? e1 : k == 2 ? e2 : e3) * inv; }
        __syncthreads();
    }
#undef RT_ROWS
    const int nent = (rB > rA ? rB - rA : 0) * 4;
    const int myent = F.tid < nent ? tk_e[F.tid] : -1; int rank_w = 0;
#pragma unroll 4
    for (int ee = 0; ee < 32; ++ee) { const unsigned long long m = __ballot(myent == ee); if (myent == ee) rank_w = __popcll(m & ((1ull << F.lane) - 1ull)); if (F.lane == 0) wcnt[F.wave * 32 + ee] = __popcll(m); }
    __syncthreads();
    if (F.tid < 32) { int c = 0;
#pragma unroll
        for (int w = 0; w < 8; ++w) { const int t = wcnt[w * 32 + F.tid]; wcnt[w * 32 + F.tid] = c; c += t; }
        unsigned* cnt = (unsigned*)(F.ws + WS_CTL) + CW_CNT + cbank * 4096 + l * 64 + F.tid;
        ebase[F.tid] = c ? (int)__hip_atomic_fetch_add(cnt, (unsigned)c, __ATOMIC_RELAXED, __HIP_MEMORY_SCOPE_AGENT) : 0; }
    __syncthreads();
    LAS int* tk_pos = (LAS int*)(F.lds + LDS_X_OFF + 5632);
    if (F.tid < nent) { const int pos = ebase[myent] + wcnt[F.wave * 32 + myent] + rank_w; const size_t gi = (size_t)rA * 4 + F.tid;
        ((unsigned*)(F.ws + WS_TSLOT))[gi] = ((unsigned)myent << 16) | (unsigned)pos; ((float*)(F.ws + WS_TW))[gi] = tk_w[F.tid]; tk_pos[F.tid] = pos; }
    asm volatile("s_waitcnt vmcnt(0)" ::: "memory");
    __syncthreads();
    {
        u32x4 v[4] = {}; size_t dst[4] = {};
#define RC_LOAD(i0_) _Pragma("unroll") for (int q = 0; q < 4; ++q) { const int i = (i0_) + 8 * q; const bool ok = i < nent; const int ii = ok ? i : (i0_); \
            dst[q] = (size_t)tk_e[ii] * CAPR + tk_pos[ii]; v[q] = ((const u32x4*)((const unsigned char*)(F.ws + WS_HX) + (size_t)(rA + (ii >> 2)) * DM))[F.lane]; }
        if (F.wave < nent) { RC_LOAD(F.wave) }
        for (int i0 = F.wave; i0 < nent; i0 += 32) {
            u32x4 cv[4]; size_t cd[4];
#pragma unroll
            for (int q = 0; q < 4; ++q) { cv[q] = v[q]; cd[q] = dst[q]; }
            if (i0 + 32 < nent) { RC_LOAD(i0 + 32) }
#pragma unroll
            for (int q = 0; q < 4; ++q) { const int i = i0 + 8 * q; if (i < nent) {
                ((u32x4*)((unsigned char*)(F.ws + WS_HXS) + cd[q] * DM))[F.lane] = cv[q];
                if (F.lane == 0) ((float*)(F.ws + WS_WSLOT))[cd[q]] = tk_w[i]; } }
        }
#undef RC_LOAD
    }
    __syncthreads();
}

__device__ __forceinline__ void moe_tables(Frame& F, int l) {
    LAS int* cum = (LAS int*)(F.lds + LDS_X_OFF + 8192); LAS int* texp = (LAS int*)(F.lds + LDS_X_OFF + 8192 + 256); LAS int* ntl = (LAS int*)(F.lds + LDS_X_OFF + 8192 + 256 + 1280);
    __syncthreads();
    if (F.tid < NEXP) { const unsigned* cnt = (const unsigned*)(F.ws + WS_CTL) + CW_CNT + l * 64;
        ntl[F.tid] = ((int)__hip_atomic_load(cnt + F.tid, __ATOMIC_RELAXED, __HIP_MEMORY_SCOPE_AGENT) + 255) >> 8; }
    __syncthreads();
    if (F.tid < NEXP) { int t = 0; for (int e = 0; e < F.tid; ++e) t += ntl[e]; const int n = ntl[F.tid];
        cum[F.tid] = t; if (F.tid == NEXP - 1) cum[NEXP] = t + n;
        for (int i = 0; i < n; ++i) texp[t + i] = F.tid; }
    __syncthreads();
}
__device__ __forceinline__ void p_scatter(Frame& F, int nrows) {
    const LAS int* cum = (const LAS int*)(F.lds + LDS_X_OFF + 8192);
    const int gw = F.vcu * 8 + F.wave, NGW = F.G * 8, nent = nrows * 4;
    for (int i0 = gw * 4; i0 < nent; i0 += NGW * 4) {
        const int row = i0 >> 2;
        const u32x4 ts = *(const u32x4*)((const unsigned*)(F.ws + WS_TSLOT) + i0);
        const f32x4 tw = *(const f32x4*)((const float*)(F.ws + WS_TW) + i0);
        const u32x4 o = ((const u32x4*)((const unsigned char*)(F.ws + WS_HX) + (size_t)row * DM))[F.lane];
#pragma unroll
        for (int k = 0; k < 4; ++k) { const unsigned t = ts[k]; const int slot = cum[t >> 16] * 256 + (int)(t & 0xffff);
            ((u32x4*)((unsigned char*)(F.ws + WS_HXS) + (size_t)slot * DM))[F.lane] = o;
            if (F.lane == 0) ((float*)(F.ws + WS_WSLOT))[slot] = tw[k]; }
    }
}
struct SchedMoe {
    const char* A; const char* B; size_t bstride; int G, c, ncol, total; const LAS int* texp; const LAS int* cum; size_t acap;
    __device__ __forceinline__ bool next(int i, g8::Unit& u) const {
        const int L = i * G + c; if (L >= total) return false;
        const int gt = L / ncol, pn = L % ncol; const int e = __builtin_amdgcn_readfirstlane(texp[gt]);
        const size_t arow = acap ? (size_t)e * acap + (size_t)(gt - __builtin_amdgcn_readfirstlane(cum[e])) * 256 : (size_t)gt * 256;
        u.A = A + arow * 1024; u.B = B + (size_t)e * bstride + (size_t)pn * 256 * 1024; u.nt = 8; u.pm = gt; u.pn = pn; u.aux = e; return true;
    }
};
struct EpiUp {
    static constexpr bool PERM = true; static constexpr int NAUX = 4;
    unsigned char* HID; const float* bgu;
    __device__ __forceinline__ const float* aux_src(const g8::Unit& u, int piece) const { return bgu + (size_t)u.aux * 2048 + (piece >> 1) * 1024 + u.pn * 128 + (piece & 1) * 64; }
    __device__ __forceinline__ bool operator()(f32x4 (&acc)[2][2][4][2], const g8::Unit& u, int wr, int wc, int fr, int fq, const LAS float* aux) const {
        const int row0 = u.pm * 256 + wr * 64 + fr, hl = wc * 32 + 8 * fq, hc0 = u.pn * 128 + hl;
        f32x4 bgt[2], bup[2];
#pragma unroll
        for (int n = 0; n < 2; ++n) { bgt[n] = *(const LAS f32x4*)(aux + hl + 4 * n); bup[n] = *(const LAS f32x4*)(aux + 128 + hl + 4 * n); }
#pragma unroll
        for (int ai = 0; ai < 2; ++ai)
#pragma unroll
            for (int m = 0; m < 4; ++m) { float h[8];
#pragma unroll
                for (int n = 0; n < 2; ++n) { const f32x4 g4 = acc[ai][0][m][n] * 0.015625f + bgt[n], u4 = acc[ai][1][m][n] * 0.015625f + bup[n];
#pragma unroll
                    for (int j = 0; j < 4; ++j) { const float g = fminf(g4[j], 7.0f), up = fminf(fmaxf(u4[j], -7.0f), 7.0f); h[4 * n + j] = __builtin_fmaf(up, g, g) * __builtin_amdgcn_rcpf(1.0f + __builtin_amdgcn_exp2f(g * -2.4554669595930157f)); } }
                u32x2 w; w.x = pk4_fp8(h[0], h[1], h[2], h[3]); w.y = pk4_fp8(h[4], h[5], h[6], h[7]);
                *(u32x2*)(HID + (size_t)(row0 + ai * 128 + m * 16) * DM + hc0) = w; }
        return false;
    }
};
struct EpiDown {
    static constexpr bool PERM = true; static constexpr int NAUX = 4;
    bf16_t* Y; const float* bdn; const float* wslot; const LAS int* cum;
    __device__ __forceinline__ const float* aux_src(const g8::Unit& u, int piece) const { return bdn + (size_t)u.aux * DM + u.pn * 256 + piece * 64; }
    __device__ __forceinline__ bool operator()(f32x4 (&acc)[2][2][4][2], const g8::Unit& u, int wr, int wc, int fr, int fq, const LAS float* aux) const {
        const int cl = wc * 32 + 8 * fq, col0 = u.pn * 256 + cl;
        f32x4 bv[2][2];
#pragma unroll
        for (int bj = 0; bj < 2; ++bj)
#pragma unroll
            for (int n = 0; n < 2; ++n) bv[bj][n] = *(const LAS f32x4*)(aux + bj * 128 + cl + 4 * n);
#pragma unroll
        for (int ai = 0; ai < 2; ++ai)
#pragma unroll
            for (int m = 0; m < 4; ++m) { const int rl = ai * 128 + wr * 64 + m * 16 + fr; bf16_t* rowp = Y + (size_t)(u.pm * 256 + rl) * DM + col0;
#pragma unroll
                for (int bj = 0; bj < 2; ++bj) { const f32x4 v0 = acc[ai][bj][m][0] * 0.015625f + bv[bj][0], v1 = acc[ai][bj][m][1] * 0.015625f + bv[bj][1];
                    u32x4 w; w.x = cvt_pk_bf16(v0[0], v0[1]); w.y = cvt_pk_bf16(v0[2], v0[3]); w.z = cvt_pk_bf16(v1[0], v1[1]); w.w = cvt_pk_bf16(v1[2], v1[3]);
                    *(u32x4*)(rowp + bj * 128) = w; } }
        return false;
    }
};

struct SchedMerge {
    const char* ws; size_t woff; int G, c, nM, total;
    __device__ __forceinline__ bool next(int i, g8::Unit& u) const {
        const int br = i % 3, T = (i / 3) * G + c; if (T >= total) return false;
        int pm, pn; g8::tile_order(T, nM, 4, pm, pn);
        const size_t aoff = WS_ATT + (br > 0 ? (WS_FX - WS_ATT) : 0) + (br > 1 ? (WS_SG - WS_FX) : 0);
        const size_t boff = WS_WA + (br > 0 ? (WS_WFP - WS_WA) : 0) + (br > 1 ? (WS_WS - WS_WFP) : 0);
        u.A = ws + aoff + (size_t)pm * 256 * 2048; u.B = ws + boff + woff + (size_t)pn * 256 * 2048; u.nt = br == 2 ? 8 : 16; u.pm = pm; u.pn = pn; u.aux = br; return true;
    }
};
struct EpiMerge {
    static constexpr bool PERM = true; static constexpr int NAUX = 0;
    const bf16_t* GT; bf16_t* MRG;
    __device__ __forceinline__ bool operator()(f32x4 (&acc)[2][2][4][2], const g8::Unit& u, int wr, int wc, int fr, int fq, const LAS float* aux) const {
        const int row0 = u.pm * 256 + wr * 64 + fr, col0 = u.pn * 256 + wc * 32 + 8 * fq, br = u.aux;
        const bf16_t* gp = GT + (size_t)row0 * 3072 + br * 1024 + col0;
        if (br < 2) {
#pragma unroll
            for (int ai = 0; ai < 2; ++ai) { u32x4 gw[4][2], hw[4][2];
#pragma unroll
                for (int m = 0; m < 4; ++m)
#pragma unroll
                    for (int bj = 0; bj < 2; ++bj) { const bf16_t* p = gp + (size_t)(ai * 128 + m * 16) * 3072 + bj * 128; gw[m][bj] = *(const u32x4*)p; hw[m][bj] = *(const u32x4*)(p + 1024); }
#pragma unroll
                for (int m = 0; m < 4; ++m)
#pragma unroll
                    for (int bj = 0; bj < 2; ++bj) { const u32x4 g4 = gw[m][bj], h4 = hw[m][bj];
                        const float g[8] = {bf_lo(g4.x), bf_hi(g4.x), bf_lo(g4.y), bf_hi(g4.y), bf_lo(g4.z), bf_hi(g4.z), bf_lo(g4.w), bf_hi(g4.w)};
                        const float h[8] = {bf_lo(h4.x), bf_hi(h4.x), bf_lo(h4.y), bf_hi(h4.y), bf_lo(h4.z), bf_hi(h4.z), bf_lo(h4.w), bf_hi(h4.w)};
#pragma unroll
                        for (int j = 0; j < 8; ++j) { const float gg = br > 0 ? fmaxf(g[j], 1e-20f) : g[j]; acc[ai][bj][m][j >> 2][j & 3] *= gg * __builtin_amdgcn_rcpf(fmaxf(h[j], 1e-20f)); } } }
        } else {
            u32x4 gw[2][4][2];
#pragma unroll
            for (int ai = 0; ai < 2; ++ai)
#pragma unroll
                for (int m = 0; m < 4; ++m)
#pragma unroll
                    for (int bj = 0; bj < 2; ++bj) gw[ai][m][bj] = *(const u32x4*)(gp + (size_t)(ai * 128 + m * 16) * 3072 + bj * 128);
#pragma unroll
            for (int ai = 0; ai < 2; ++ai)
#pragma unroll
                for (int m = 0; m < 4; ++m)
#pragma unroll
                    for (int bj = 0; bj < 2; ++bj) { const u32x4 g4 = gw[ai][m][bj];
                        const float g[8] = {bf_lo(g4.x), bf_hi(g4.x), bf_lo(g4.y), bf_hi(g4.y), bf_lo(g4.z), bf_hi(g4.z), bf_lo(g4.w), bf_hi(g4.w)};
                        float v[8];
#pragma unroll
                        for (int j = 0; j < 8; ++j) v[j] = fmaxf(g[j], 1e-20f) * acc[ai][bj][m][j >> 2][j & 3];
                        u32x4 w; w.x = cvt_pk_bf16(v[0], v[1]); w.y = cvt_pk_bf16(v[2], v[3]); w.z = cvt_pk_bf16(v[4], v[5]); w.w = cvt_pk_bf16(v[6], v[7]);
                        *(u32x4*)(MRG + (size_t)(row0 + ai * 128 + m * 16) * DM + col0 + bj * 128) = w; }
        }
        return br < 2;
    }
};
struct SchedPlain {
    const char* A; const char* B; int G, c, nM, nN, nt;
    __device__ __forceinline__ bool next(int i, g8::Unit& u) const {
        const int L = i * G + c; if (L >= nM * nN) return false;
        int pm, pn; g8::tile_order(L, nM, nN, pm, pn);
        u.A = A + (size_t)pm * 256 * 2048; u.B = B + (size_t)pn * 256 * 2048; u.nt = nt; u.pm = pm; u.pn = pn; u.aux = 0; return true;
    }
};
struct EpiOut {
    static constexpr bool PERM = false; static constexpr int NAUX = 0;
    const float* rx; const float* rc; float* XW; const float* mod;
    __device__ __forceinline__ bool operator()(f32x4 (&acc)[2][2][4][2], const g8::Unit& u, int wr, int wc, int fr, int fq, const LAS float* aux) const {
        const int row0 = u.pm * 256 + wr * 64 + fr, col0 = u.pn * 256 + wc * 32 + 4 * fq;
        const float* res = u.pm < 64 ? rx : rc; const float* g1 = mod + (size_t)(u.pm < 32 ? 0 : (u.pm < 64 ? 1 : 2)) * 6144 + 2048;
        f32x4 gv[2][2];
#pragma unroll
        for (int bj = 0; bj < 2; ++bj)
#pragma unroll
            for (int n = 0; n < 2; ++n) gv[bj][n] = *(const f32x4*)(g1 + col0 + bj * 128 + n * 16);
        f32x4 r0[8], r1[8];
#define EO_OFF(gi, mm) ((size_t)(row0 + ((gi) >> 1) * 128 + ((((gi) & 1) << 1) + (mm)) * 16) * DM + col0)
#define EO_LD(r, gi) _Pragma("unroll") for (int mm = 0; mm < 2; ++mm) _Pragma("unroll") for (int bj = 0; bj < 2; ++bj) _Pragma("unroll") for (int n = 0; n < 2; ++n) \
            r[mm * 4 + bj * 2 + n] = *(const f32x4*)(res + EO_OFF(gi, mm) + bj * 128 + n * 16);
#define EO_ST(r, gi) _Pragma("unroll") for (int mm = 0; mm < 2; ++mm) _Pragma("unroll") for (int bj = 0; bj < 2; ++bj) _Pragma("unroll") for (int n = 0; n < 2; ++n) \
            *(f32x4*)(XW + EO_OFF(gi, mm) + bj * 128 + n * 16) = r[mm * 4 + bj * 2 + n] + gv[bj][n] * acc[(gi) >> 1][bj][(((gi) & 1) << 1) + mm][n];
        EO_LD(r0, 0) EO_LD(r1, 1)
        EO_ST(r0, 0) EO_LD(r0, 2)
        EO_ST(r1, 1) EO_LD(r1, 3)
        EO_ST(r0, 2) EO_ST(r1, 3)
#undef EO_OFF
#undef EO_LD
#undef EO_ST
        return false;
    }
};

__device__ __forceinline__ void p_combine(Frame& F, int l, int nrows, bool last) {
    const LAS int* cum = (const LAS int*)(F.lds + LDS_X_OFF + 8192);
    const int gw = F.vcu * 8 + F.wave, NGW = F.G * 8;
    const float* MOD = (const float*)(F.ws + WS_MOD) + (size_t)l * 3 * 6144;
    const bool poison = last && __hip_atomic_load((const unsigned*)(F.ws + WS_CTL) + CW_BAR + XB_TMO, __ATOMIC_RELAXED, __HIP_MEMORY_SCOPE_AGENT) != 0u;
    const float qn = __builtin_nanf("");
    float* outp = last ? OUTP() : (float*)(F.ws + WS_XW);
    const bf16_t* Y = (const bf16_t*)(F.ws + WS_Y);
    const float* MODN = MOD + 3 * 6144;
    u32x4 w[4][2] = {}; f32x4 xv[2][2] = {}, gv[2][2] = {}, shv[2][2] = {}, scv[2][2] = {}, twv = {};
#define CB_ISSUE(r_, ts_, W, XV, GV, SHV, SCV) do { twv = *(const f32x4*)((const float*)(F.ws + WS_TW) + (size_t)(r_) * 4); \
        const u32x4* y0 = (const u32x4*)(Y + (size_t)(cum[(ts_).x >> 16] * 256 + (int)((ts_).x & 0xffff)) * DM) + F.lane; \
        const u32x4* y1 = (const u32x4*)(Y + (size_t)(cum[(ts_).y >> 16] * 256 + (int)((ts_).y & 0xffff)) * DM) + F.lane; \
        const u32x4* y2 = (const u32x4*)(Y + (size_t)(cum[(ts_).z >> 16] * 256 + (int)((ts_).z & 0xffff)) * DM) + F.lane; \
        const u32x4* y3 = (const u32x4*)(Y + (size_t)(cum[(ts_).w >> 16] * 256 + (int)((ts_).w & 0xffff)) * DM) + F.lane; \
        _Pragma("unroll") for (int j = 0; j < 2; ++j) { W[0][j] = y0[64 * j]; W[1][j] = y1[64 * j]; W[2][j] = y2[64 * j]; W[3][j] = y3[64 * j]; } \
        const float* xr_ = (const float*)(F.ws + WS_XW) + (size_t)(r_) * DM; const int mr_ = modrow_of(r_); const float* g2_ = MOD + (size_t)mr_ * 6144 + 5120; const float* md_ = MODN + (size_t)mr_ * 6144; \
        _Pragma("unroll") for (int j = 0; j < 2; ++j) { const int c = 8 * F.lane + 512 * j; XV[j][0] = *(const f32x4*)(xr_ + c); XV[j][1] = *(const f32x4*)(xr_ + c + 4); GV[j][0] = *(const f32x4*)(g2_ + c); GV[j][1] = *(const f32x4*)(g2_ + c + 4); \
            if (!last) { SHV[j][0] = *(const f32x4*)(md_ + c); SHV[j][1] = *(const f32x4*)(md_ + c + 4); SCV[j][0] = *(const f32x4*)(md_ + 1024 + c); SCV[j][1] = *(const f32x4*)(md_ + 1024 + c + 4); } } } while (0)
    if (gw < nrows) { const u32x4 ts0 = *(const u32x4*)((const unsigned*)(F.ws + WS_TSLOT) + (size_t)gw * 4); CB_ISSUE(gw, ts0, w, xv, gv, shv, scv); }
    for (int row = gw; row < nrows; row += NGW) {
        const int nrow = row + NGW; const bool hn = nrow < nrows;
        u32x4 tsn = {}; if (hn) tsn = *(const u32x4*)((const unsigned*)(F.ws + WS_TSLOT) + (size_t)nrow * 4);
        f32x4 xn[2][2]; const f32x4 tw = twv;
#pragma unroll
        for (int j = 0; j < 2; ++j) {
            f32x4 a0 = (f32x4){0.f, 0.f, 0.f, 0.f}, a1 = a0;
#pragma unroll
            for (int k = 0; k < 4; ++k) { const u32x4 q = w[k][j]; a0 += (f32x4){bf_lo(q.x), bf_hi(q.x), bf_lo(q.y), bf_hi(q.y)} * tw[k]; a1 += (f32x4){bf_lo(q.z), bf_hi(q.z), bf_lo(q.w), bf_hi(q.w)} * tw[k]; }
            f32x4 r0 = xv[j][0] + gv[j][0] * a0, r1 = xv[j][1] + gv[j][1] * a1;
            if (poison) { r0 = (f32x4){qn, qn, qn, qn}; r1 = r0; }
            xn[j][0] = r0; xn[j][1] = r1;
        }
        f32x4 sh[2][2], sc[2][2];
#pragma unroll
        for (int j = 0; j < 2; ++j)
#pragma unroll
            for (int q = 0; q < 2; ++q) { sh[j][q] = shv[j][q]; sc[j][q] = scv[j][q]; }
        if (hn) CB_ISSUE(nrow, tsn, w, xv, gv, shv, scv);
#pragma unroll
        for (int j = 0; j < 2; ++j) { const int c = 8 * F.lane + 512 * j; *(f32x4*)(outp + (size_t)row * DM + c) = xn[j][0]; *(f32x4*)(outp + (size_t)row * DM + c + 4) = xn[j][1]; }
        if (!last) {
            float ss = 0.f;
#pragma unroll
            for (int j = 0; j < 2; ++j)
#pragma unroll
                for (int q = 0; q < 2; ++q) ss += (xn[j][q].x * xn[j][q].x + xn[j][q].y * xn[j][q].y) + (xn[j][q].z * xn[j][q].z + xn[j][q].w * xn[j][q].w);
            const float rstd = rsqrtf(wave_sum(ss) * (1.f / DM) + EPS);
#pragma unroll
            for (int j = 0; j < 2; ++j) { const int c = 8 * F.lane + 512 * j;
                const f32x4 h0 = xn[j][0] * rstd * (sc[j][0] + 1.0f) + sh[j][0], h1 = xn[j][1] * rstd * (sc[j][1] + 1.0f) + sh[j][1];
                u32x2 w2; w2.x = pk4_fp8(h0.x, h0.y, h0.z, h0.w); w2.y = pk4_fp8(h1.x, h1.y, h1.z, h1.w);
                *(u32x2*)((unsigned char*)(F.ws + WS_HX8) + (size_t)row * DM + c) = w2; }
        }
    }
#undef CB_ISSUE
}

#ifndef EPI_ALIGN
#define EPI_ALIGN true
#endif
#ifndef BF_SP2
#define BF_SP2 true
#endif
#ifndef MOE_SP2
#define MOE_SP2 true
#endif
#ifndef DUP
#define DUP 0
#endif
#define REPB(bit, stmt) do { stmt; if (DUP & (bit)) { GRID_BAR(); refresh(F); stmt; } } while (0)
#define REP(bit) for (int rep_ = 0; rep_ < ((DUP & (bit)) ? 2 : 1); ++rep_)
#ifndef PHM
#define PHM 0xffff
#endif
__global__ void __launch_bounds__(512, 2) mk_fwd(KArgs args) {
    extern __shared__ __attribute__((aligned(16))) unsigned char lds_raw[];
    Frame F;
    F.lds = (LAS unsigned char*)lds_raw; F.ws = args.ws;
    F.tid = threadIdx.x; F.lane = F.tid & 63; F.wave = __builtin_amdgcn_readfirstlane(F.tid >> 6);
    F.G = gridDim.x; { const int bx = blockIdx.x; F.vcu = (F.G % 8 == 0) ? (bx % 8) * (F.G / 8) + bx / 8 : bx; }
    volatile LAS unsigned* MISC = (volatile LAS unsigned*)(F.lds + LDS_MISC_OFF);
    for (int u = F.tid; u < (LDS_BYTES - LDS_MISC_OFF) / 4; u += 512) MISC[u] = 0u;
    __syncthreads();
    XcdBarrier bar = xcd_barrier_post((unsigned*)(F.ws + WS_CTL) + CW_BAR, MISC + 8);
    const int bid = (int)blockIdx.x;
#define GRID_BAR() do { XcdBarrier b_ = bar; b_.seam = (unsigned)(__LINE__); asm volatile("" : "+s"(b_.x)); asm volatile("" : "+s"(b_.bar)); asm volatile("" : "+s"(b_.wave)); xcd_barrier(b_); if (DUP & 16384) xcd_barrier(b_); } while (0)

    refresh(F);
    REP(1) if (PHM & 1) p0_prologue(F);
    GRID_BAR();

    FillCur FC; FC.c0 = 0; FC.c1 = 0;
    for (int l_ = 0; l_ < DEPTH; ++l_) {
        const int l = launder_s(l_);
        const bool last = (l == DEPTH - 1);
        const int nrows = last ? NXR : NROW;
        const bf16_t* HX = (const bf16_t*)(F.ws + WS_HX);
        refresh(F);
        if (l == 0) { p_norm1(F, l, NROW); GRID_BAR(); }
        refresh(F);
        REP(4) if (PHM & 4) {
            SchedIn S{(const char*)(F.ws + WS_HX8), (const char*)(F.ws + WS_WIN) + (size_t)l * IN_DIM * DM, F.G, bid, 64 * 24 + (last ? 4 : 48), last ? 1 : 0};
            EpiIn E{(bf16_t*)(F.ws + WS_PX), (bf16_t*)(F.ws + WS_GT), INP(I_BGATE) + (size_t)l * 3072};
            g8::gemm_phase<EpiIn, SchedIn, true, BF_SP2, EPI_ALIGN>(F.lds, S, E, F.tid);
            fill_after(F, FC, l, 64 * 24 + (last ? 4 : 48), bid, 4);
        }
        GRID_BAR();
        refresh(F);
        if (PHM & 8) p_postproj(F, l, NROW);
        refresh(F);
        p_vblocks(F);
        refresh(F);
        if (PHM & 16) {
            const bf16_t* PX = (const bf16_t*)(F.ws + WS_PX);
            for (int u = F.vcu; u < 512; u += F.G) {
                const int n1 = u >> 3, b = (u >> 2) & 1, cb = u & 3;
                EpiStore2 E{(bf16_t*)(F.ws + WS_Y1) + ((size_t)b * 128 * 2 * 64 + n1) * 512 + cb * 128, 128, (size_t)2 * 64 * 512, (size_t)64 * 512};
                lm_unit<256, 128>(F, (const bf16_t*)(F.ws + WS_T1) + (size_t)n1 * 256 * 128, PX + ((size_t)b * SEQ + n1) * PXW + F_OFF + cb * 128, (size_t)64 * PXW, E);
            }
            if (!last) for (int u = (F.G >= 16 ? F.vcu - (F.G - 8) : F.vcu); u < 8; u += F.G) {
                if (u < 0) continue;
                const int b = u >> 2, cb = u & 3;
                EpiStore2 E{(bf16_t*)(F.ws + WS_FX) + (size_t)(NXR + b * CTX) * DM + cb * 128, 256, (size_t)DM, (size_t)512};
                lm_unit<512, 256>(F, (const bf16_t*)(F.ws + WS_TC), PX + (size_t)(NXR + b * CTX) * PXW + F_OFF + cb * 128, (size_t)PXW, E);
            }
        }
        GRID_BAR();
        refresh(F);
        REP(32) if (PHM & 32) {
            const unsigned char* QN = (const unsigned char*)(F.ws + WS_QN); const unsigned char* KN = (const unsigned char*)(F.ws + WS_KN); const unsigned char* VT = (const unsigned char*)(F.ws + WS_VN); bf16_t* ATT = (bf16_t*)(F.ws + WS_ATT);
            REP(8192) for (int u = bid; u < 512; u += F.G) {
                const int b = u >> 8, kvh = (u >> 7) & 1, hq = (u >> 5) & 3, qb = u & 31, h = kvh * 4 + hq;
                const size_t q0 = ((size_t)b * SEQ + qb * 256) * DM + h * 128, k0 = (size_t)b * LK * 256 + kvh * 128;
                att::attn_dense_body(QN + q0, KN + k0, VT + (size_t)((b * 2 + kvh) * 132) * 8192, ATT + q0, LK, (char*)lds_raw, F.tid);
            }
            if (!last) for (int u = bid; u < 16; u += F.G) {
                const int b = u >> 3, h = u & 7, kvh = h >> 2;
                const size_t q0 = (size_t)(NXR + b * CTX) * DM + h * 128, k0 = ((size_t)b * LK + SEQ) * 256 + kvh * 128;
                att::attn_dense_body(QN + q0, KN + k0, VT + (size_t)((b * 2 + kvh) * 132 + 128) * 8192, ATT + q0, CTX, (char*)lds_raw, F.tid);
            }
            refresh(F);
            const unsigned lo0 = lm_dma_lane_off(F.wave, F.lane, 0, 512u), lo1 = lm_dma_lane_off(F.wave, F.lane, 1, 512u);
            {
                const bf16_t* T2 = (const bf16_t*)(F.ws + WS_T2);
#define P2_IN(uu) ((const bf16_t*)(F.ws + WS_Y1) + ((size_t)((uu) >> 9) * 128 + (((uu) >> 2) & 127)) * 2 * 64 * 512 + ((uu) & 3) * 128)
                int p = F.vcu, buf = 0;
                __syncthreads();
                if (p < 512) lm_dma_pair(F, P2_IN(2 * p), P2_IN(2 * p + 1), 512u, 0, lo0, lo1);
                for (; p < 512; p += F.G) {
                    asm volatile("s_waitcnt vmcnt(0)" ::: "memory"); __syncthreads();
                    bf16x8 pw[2][4]; lm_load_w(F, pw, T2);
                    if (p + F.G < 512) lm_dma_pair(F, P2_IN(2 * (p + F.G)), P2_IN(2 * (p + F.G) + 1), 512u, (buf ^ 1) * 65536, lo0, lo1);
                    const int u = 2 * p + (F.wave >> 2), b = u >> 9, k2 = (u >> 2) & 127, cb = u & 3;
                    EpiStore2 E{(bf16_t*)(F.ws + WS_FX) + ((size_t)b * SEQ + k2) * DM + cb * 128, 64, (size_t)128 * DM, (size_t)512};
                    lm_pair_compute(F, pw, buf * 65536, E);
                    buf ^= 1;
                }
#undef P2_IN
            }
            {
                const int np = (nrows / 128) * 2;
                const bf16_t* WSPl = (const bf16_t*)(F.ws + WS_WSP) + (size_t)l * 4 * 128 * 128;
#define SG_IN(uu) ((const bf16_t*)(F.ws + WS_VGN) + (size_t)((uu) >> 2) * 128 * 512 + ((uu) & 3) * 128)
                int p = F.vcu, buf = 0;
                __syncthreads();
                if (p < np) lm_dma_pair(F, SG_IN(2 * p), SG_IN(2 * p + 1), 512u, 0, lo0, lo1);
                for (; p < np; p += F.G) {
                    asm volatile("s_waitcnt vmcnt(0)" ::: "memory"); __syncthreads();
                    const int u = 2 * p + (F.wave >> 2), ch = u >> 2, g = u & 3; const size_t row0 = (size_t)ch * 128;
                    bf16x8 pw[2][4]; lm_load_w(F, pw, WSPl + (size_t)g * 128 * 128);
                    EpiSgu E{(bf16_t*)(F.ws + WS_SG) + row0 * DM + g * 128, (const bf16_t*)(F.ws + WS_PX) + row0 * PXW + U_OFF + g * 128, INP(I_BSPAT) + (size_t)l * 512 + g * 128};
                    u32x4 uw[8]; float ub[8]; E.pre((F.wave & 3) * 32, F.lane, uw, ub);
                    if (p + F.G < np) lm_dma_pair(F, SG_IN(2 * (p + F.G)), SG_IN(2 * (p + F.G) + 1), 512u, (buf ^ 1) * 65536, lo0, lo1);
                    {
                        const int pb = F.wave >> 2, rb = F.wave & 3;
                        const int vb0 = (int)(unsigned)(uintptr_t)F.lds + buf * 65536 + att::v_rd_base(F.lane) + pb * 32768;
                        f32x16 o[4] = {};
#pragma unroll
                        for (int t = 0; t < 2; ++t) att::pv_d0(o, vb0 + t * 16384, pw[t][0], pw[t][1], pw[t][2], pw[t][3]);
                        __syncthreads();
                        att::wave_rows_out_i(F.lds + buf * 65536 + F.wave * 8192, o, F.lane, [&](int i, int row, int col8, u32x4 v) { E.rows2(rb * 32 + row, col8, v, uw[i], ub[i]); });
                    }
                    buf ^= 1;
                }
#undef SG_IN
            }
            __syncthreads();
        }
        GRID_BAR();
        refresh(F);
        REP(64) if (PHM & 64) {
            const int nM = nrows / 256;
            SchedMerge S{(const char*)F.ws, (size_t)l * DM * DM * 2, F.G, bid, nM, nM * 4};
            EpiMerge E{(const bf16_t*)(F.ws + WS_GT), (bf16_t*)(F.ws + WS_MRG)};
            g8::gemm_phase<EpiMerge, SchedMerge, false, BF_SP2, true>(F.lds, S, E, F.tid);
            fill_after(F, FC, l, nM * 4, bid, 12);
        }
        GRID_BAR();
        refresh(F);
        for (int rep_ = 0; rep_ < (((DUP & 128) && l == 0) ? 2 : 1); ++rep_) {
            SchedPlain S{(const char*)(F.ws + WS_MRG), (const char*)((const bf16_t*)(F.ws + WS_WO) + (size_t)l * DM * DM), F.G, bid, nrows / 256, 4, 16};
            const float* XWc = (const float*)(F.ws + WS_XW);
            EpiOut E{l == 0 ? INP(I_X) : XWc, l == 0 ? INP(I_CTX) - (size_t)NXR * DM : XWc, (float*)(F.ws + WS_XW), (const float*)(F.ws + WS_MOD) + (size_t)l * 3 * 6144};
            g8::gemm_phase<EpiOut, SchedPlain, false, BF_SP2, true>(F.lds, S, E, F.tid);
            fill_after(F, FC, l, (nrows / 256) * 4, bid, 5);
        }
        GRID_BAR();
        refresh(F);
        if (DUP & 256) { p_route(F, l, nrows, 1); GRID_BAR(); refresh(F); }
        if (PHM & 256) p_route(F, l, nrows);
        refresh(F);
        fill_cleanup(F, FC, l);
        GRID_BAR();
        moe_tables(F, l);
        refresh(F);
        const LAS int* cum = (const LAS int*)(F.lds + LDS_X_OFF + 8192); const LAS int* texp = (const LAS int*)(F.lds + LDS_X_OFF + 8192 + 256);
        const int ntile = __builtin_amdgcn_readfirstlane(cum[NEXP]);
        int vup = bid, vdn = bid;
        if (F.G == 256) { const int x = bid & 7, r = bid >> 3; vup = (8 * (x >> 1) + (r >> 2)) * 8 + 4 * (x & 1) + (r & 3); vdn = (8 * x + (r >> 2)) * 4 + (r & 3); }
        refresh(F);
        REP(1024) if (PHM & 1024) {
            SchedMoe S{(const char*)(F.ws + WS_HXS), (const char*)(F.ws + WS_WGU) + (size_t)l * NEXP * 2048 * DM, (size_t)2048 * DM, F.G, vup, 8, ntile * 8, texp, cum, (size_t)CAPR};
            EpiUp E{(unsigned char*)(F.ws + WS_HID), INP(I_BGU) + (size_t)l * NEXP * 2048};
            g8::gemm_phase<EpiUp, SchedMoe, true, MOE_SP2, EPI_ALIGN>(F.lds, S, E, F.tid);
            if (!last) fill_after(F, FC, l + 1, ntile * 8, vup, 4);
        }
        GRID_BAR();
        refresh(F);
        REP(2048) if (PHM & 2048) {
            SchedMoe S{(const char*)(F.ws + WS_HID), (const char*)(F.ws + WS_WDN) + (size_t)l * NEXP * DM * DM, (size_t)DM * DM, F.G, vdn, 4, ntile * 4, texp, cum, (size_t)0};
            EpiDown E{(bf16_t*)(F.ws + WS_Y), INP(I_BDN) + (size_t)l * NEXP * DM, (const float*)(F.ws + WS_WSLOT), cum};
            g8::gemm_phase<EpiDown, SchedMoe, true, MOE_SP2, EPI_ALIGN>(F.lds, S, E, F.tid);
            if (!last) fill_after(F, FC, l + 1, ntile * 4, vdn, 2);
        }
        GRID_BAR();
        refresh(F);
        if (last) { REPB(4096, p_combine(F, l, nrows, last)); } else p_combine(F, l, nrows, last);
        GRID_BAR();
    }
}

extern "C" void kernel_launch(void* const* d_in, const int* in_sizes, int n_in, void* d_out, int out_size, void* d_ws, size_t ws_size, hipStream_t stream) {
    static int grid = 0;
    if (grid == 0) {
        if (n_in != 23 || out_size != NXR * DM || ws_size < WS_END) { fprintf(stderr, "kernel_launch: unexpected shapes: n_in %d out %d ws %zu (need %zu)\n", n_in, out_size, ws_size, (size_t)WS_END); grid = -1; return; }
        int dev = 0, cus = 0, per_cu = 0;
        if (hipGetDevice(&dev) != hipSuccess || hipDeviceGetAttribute(&cus, hipDeviceAttributeMultiprocessorCount, dev) != hipSuccess) { grid = -1; return; }
        if (hipFuncSetAttribute((const void*)mk_fwd, hipFuncAttributeMaxDynamicSharedMemorySize, LDS_BYTES) != hipSuccess) { fprintf(stderr, "kernel_launch: hipFuncSetAttribute failed\n"); grid = -1; return; }
        if (hipOccupancyMaxActiveBlocksPerMultiprocessor(&per_cu, (const void*)mk_fwd, 512, LDS_BYTES) != hipSuccess || per_cu < 1) { fprintf(stderr, "kernel_launch: occupancy query says %d\n", per_cu); (void)hipGetLastError(); }
        grid = cus;
    }
    if (grid < 0) return;
    if (hipMemsetAsync((char*)d_ws + WS_CTL, 0, CTL_ZERO_BYTES, stream) != hipSuccess) return;
    KArgs a{};
    for (int i = 0; i < 23; ++i) a.in[i] = (const float*)d_in[i];
    a.out = (float*)d_out; a.ws = (unsigned char*)d_ws;
    hipLaunchKernelGGL(mk_fwd, dim3(grid), dim3(512), LDS_BYTES, stream, a);
}
```

```cpp
#include <hip/hip_runtime.h>
#include <cstdio>
#include <cstdint>

#define LAS __attribute__((address_space(3)))
#define GAS __attribute__((address_space(1)))
typedef unsigned short bf16_t;
typedef short bf16x8 __attribute__((ext_vector_type(8)));
typedef int v8i __attribute__((ext_vector_type(8)));
typedef int v4i __attribute__((ext_vector_type(4)));
typedef short s16x4 __attribute__((ext_vector_type(4)));
typedef float f32x2 __attribute__((ext_vector_type(2)));
typedef float f32x4 __attribute__((ext_vector_type(4)));
typedef float f32x16 __attribute__((ext_vector_type(16)));
typedef unsigned u32x2 __attribute__((ext_vector_type(2)));
typedef unsigned u32x4 __attribute__((ext_vector_type(4)));

constexpr int DM = 1024, NB = 2, SEQ = 8192, CTX = 256, DEPTH = 2;
constexpr int NXR = NB * SEQ;
constexpr int NCR = NB * CTX;
constexpr int NROW = NXR + NCR;
constexpr int LK = SEQ + CTX;
constexpr int IN_DIM = 6144, Q_OFF = 0, K_OFF = 1024, V_OFF = 1280, F_OFF = 1536, U_OFF = 2048, VG_OFF = 2560, G_OFF = 3072;
constexpr int PXW = 3072;
constexpr int NEXP = 32, TOPK = 4;
constexpr int MAXT = 296;
constexpr int SROWS = MAXT * 256;
constexpr float EPS = 1e-6f;

constexpr size_t al256(size_t x) { return (x + 255) / 256 * 256; }
constexpr size_t WS_CTL = 0, CTL_BYTES = 1u << 20, CTL_ZERO_BYTES = 128u << 10;
constexpr size_t WS_MOD = WS_CTL + CTL_BYTES;
constexpr size_t WS_T1 = al256(WS_MOD + (size_t)DEPTH * 3 * 6144 * 4);
constexpr size_t WS_T2 = al256(WS_T1 + (size_t)64 * 256 * 128 * 4);
constexpr size_t WS_WSP = WS_T1 + (size_t)6 * 1024 * 1024;
constexpr size_t WS_ROPE = WS_T1 + (size_t)7 * 1024 * 1024;
constexpr size_t WS_TC = al256(WS_T2 + (size_t)128 * 128 * 4);
constexpr size_t WS_WIN = al256(WS_TC + (size_t)512 * 256 * 4);
constexpr size_t WS_WA = al256(WS_WIN + (size_t)DEPTH * IN_DIM * DM * 2);
constexpr size_t WS_WFP = al256(WS_WA + (size_t)DEPTH * DM * DM * 2);
constexpr size_t WS_WS = al256(WS_WFP + (size_t)DEPTH * DM * DM * 2);
constexpr size_t WS_WO = al256(WS_WS + (size_t)DEPTH * DM * DM * 2);
constexpr size_t WS_WGU = al256(WS_WO + (size_t)DEPTH * DM * DM * 2);
constexpr size_t WS_WDN = al256(WS_WGU + (size_t)DEPTH * NEXP * 2048 * DM);
constexpr size_t WS_XW = al256(WS_WDN + (size_t)DEPTH * NEXP * DM * DM);
constexpr size_t WS_HX = al256(WS_XW + (size_t)NROW * DM * 4);
constexpr size_t WS_PX = al256(WS_HX + (size_t)NROW * DM * 2);
constexpr size_t WS_GT = al256(WS_PX + (size_t)NROW * PXW * 2);
constexpr size_t WS_QN = al256(WS_GT + (size_t)NROW * 3072 * 2);
constexpr size_t WS_KN = al256(WS_QN + (size_t)NROW * DM * 2);
constexpr size_t WS_VN = al256(WS_KN + (size_t)NB * LK * 256 * 2);
constexpr size_t WS_VGN = al256(WS_VN + (size_t)NB * LK * 256 * 2);
constexpr size_t WS_Y1 = al256(WS_VGN + (size_t)NROW * 512 * 2);
constexpr size_t WS_FX = al256(WS_Y1 + (size_t)NB * 128 * 2 * 64 * 512 * 2);
constexpr size_t WS_ATT = al256(WS_FX + (size_t)NROW * DM * 2);
constexpr size_t WS_SG = al256(WS_ATT + (size_t)NROW * DM * 2);
constexpr size_t WS_PART = al256(WS_SG + (size_t)NROW * DM * 2);
constexpr size_t WS_MRG = al256(WS_PART + (size_t)NROW * DM * 4);
constexpr size_t WS_TSLOT = al256(WS_MRG + (size_t)NROW * DM * 2);
constexpr size_t WS_TW = al256(WS_TSLOT + (size_t)NROW * 4 * 4);
constexpr int CAPR = NROW;
constexpr size_t WS_WSLOT = al256(WS_TW + (size_t)NROW * 4 * 4);
constexpr size_t WS_HXS = al256(WS_WSLOT + (size_t)NEXP * CAPR * 4);
constexpr size_t WS_HID = al256(WS_HXS + (size_t)NEXP * CAPR * DM);
constexpr size_t WS_Y = al256(WS_HID + (size_t)SROWS * DM * 2);
constexpr size_t WS_HX8 = al256(WS_Y + (size_t)SROWS * DM * 2);
constexpr size_t WS_END = al256(WS_HX8 + (size_t)NROW * DM);
static_assert(WS_END < (size_t)2000 * 1024 * 1024, "workspace map beyond the guaranteed 4 x largest-input size");
constexpr int CW_BAR = 4096;
constexpr int CW_CNT = 8192;

constexpr int LDS_X_OFF = 131072;
constexpr int LDS_MISC_OFF = 143360;
constexpr int LDS_BYTES = 147456;

__device__ __forceinline__ unsigned cvt_pk_bf16(float lo, float hi) { unsigned r; asm volatile("v_cvt_pk_bf16_f32 %0, %1, %2" : "=v"(r) : "v"(lo), "v"(hi)); return r; }
__device__ __forceinline__ unsigned pk4_fp8(float a, float b, float c, float d) { int p = __builtin_amdgcn_cvt_pk_fp8_f32(a, b, 0, false); return (unsigned)__builtin_amdgcn_cvt_pk_fp8_f32(c, d, p, true); }
__device__ __forceinline__ unsigned pk4_fp8u(float a, float b, float c, float d) { int u; asm("" : "=v"(u) : "v"(a)); int p = __builtin_amdgcn_cvt_pk_fp8_f32(a, b, u, false); return (unsigned)__builtin_amdgcn_cvt_pk_fp8_f32(c, d, p, true); }
__device__ __forceinline__ float bf_lo(unsigned w) { return __uint_as_float(w << 16); }
__device__ __forceinline__ float bf_hi(unsigned w) { return __uint_as_float(w & 0xffff0000u); }
__device__ __forceinline__ float bf2f(bf16_t h) { return __uint_as_float(((unsigned)h) << 16); }
__device__ __forceinline__ int lane_id() { int l; asm volatile("v_mbcnt_lo_u32_b32 %0, -1, 0\n\tv_mbcnt_hi_u32_b32 %0, -1, %0" : "=v"(l)); return l; }
template <int M> __device__ __forceinline__ float sx(float v) {
    if constexpr (M < 32) return __int_as_float(__builtin_amdgcn_ds_swizzle(__float_as_int(v), (M << 10) | 0x1f));
    else { const auto rr = __builtin_amdgcn_permlane32_swap(__float_as_uint(v), __float_as_uint(v), false, false); return (lane_id() & 32) ? __uint_as_float(rr[0]) : __uint_as_float(rr[1]); }
}
__device__ __forceinline__ float wave_sum(float v) {
    v += sx<1>(v); v += sx<2>(v); v += sx<4>(v); v += sx<8>(v); v += sx<16>(v);
    const auto rr = __builtin_amdgcn_permlane32_swap(__float_as_uint(v), __float_as_uint(v), false, false); return __uint_as_float(rr[0]) + __uint_as_float(rr[1]);
}
__device__ __forceinline__ float sigmoidf_(float x) { return __builtin_amdgcn_rcpf(1.0f + __expf(-x)); }
__device__ __forceinline__ float gelu_tanh(float x) { const float z = 0.7978845608028654f * (x + 0.044715f * x * x * x); const float t = 1.0f - 2.0f * __builtin_amdgcn_rcpf(1.0f + __expf(2.0f * z)); return 0.5f * x * (1.0f + t); }

#define XB_TMO      128
#define XB_XCNT(j)  (256  + 64 * (j))
#define XB_XSUB(j)  (1280 + 64 * (j))
#define XB_XGEN(j)  (2304 + 64 * (j))
#define XB_TOP      3328
#define XB_TOPGEN   3392
#define XCD_BAR_WORDS 3456
#define XB_SPIN_CAP (1u << 20)
__device__ __forceinline__ unsigned xb_ld(unsigned* p)              { return __hip_atomic_load(p, __ATOMIC_RELAXED, __HIP_MEMORY_SCOPE_AGENT); }
__device__ __forceinline__ unsigned xb_add(unsigned* p, unsigned v) { return __hip_atomic_fetch_add(p, v, __ATOMIC_RELAXED, __HIP_MEMORY_SCOPE_AGENT); }
__device__ __forceinline__ unsigned xb_xcc_id() { return (unsigned)__builtin_amdgcn_s_getreg((3 << 11) | 20) & 0xFu; }
#define XB_SPIN(cond, bar) do { unsigned _sp = 0; while (cond) { __builtin_amdgcn_s_sleep(1); \
    if ((++_sp & 255u) == 0u) { if (xb_ld(&(bar)[XB_TMO])) break; if (_sp > XB_SPIN_CAP) { __hip_atomic_fetch_max(&(bar)[XB_TMO + 1], 100000u - b.seam, __ATOMIC_RELAXED, __HIP_MEMORY_SCOPE_AGENT); atomicAdd(&(bar)[XB_TMO], 1u); break; } } } } while (0)
struct XcdBarrier { unsigned* bar; unsigned x; volatile LAS unsigned* st; unsigned seam; int wave; };
__device__ __forceinline__ XcdBarrier xcd_barrier_post(unsigned* bar, volatile LAS unsigned* st) {
    XcdBarrier b; b.bar = bar; b.x = xb_xcc_id(); b.st = st; b.seam = 1u; b.wave = __builtin_amdgcn_readfirstlane((int)(threadIdx.x >> 6));
    if (threadIdx.x == 0) (void)xb_add(&bar[XB_XCNT(b.x)], 1u);
    return b;
}
__device__ __forceinline__ void xcd_barrier_complete(unsigned* bar, unsigned x, unsigned& nloc, unsigned& nx) {
    const unsigned G = gridDim.x * gridDim.y * gridDim.z;
    unsigned sum, cnt, mine, sp = 0u;
    for (;;) {
        sum = 0u; cnt = 0u;
#pragma nounroll
        for (unsigned j = 0; j < 16; ++j) { const unsigned c = xb_ld(&bar[XB_XCNT(j)]); sum += c; cnt += (c > 0u) ? 1u : 0u; }
        mine = xb_ld(&bar[XB_XCNT(x)]);
        if (sum == G) break;
        __builtin_amdgcn_s_sleep(1);
        if ((++sp & 255u) == 0u) { if (xb_ld(&bar[XB_TMO])) break; if (sp > XB_SPIN_CAP) { atomicAdd(&bar[XB_TMO], 1u); break; } }
    }
    nloc = mine > 0u ? mine : 1u; nx = cnt > 0u ? cnt : 1u;
}
__device__ __forceinline__ void xcd_barrier(const XcdBarrier& b) {
    asm volatile("s_waitcnt vmcnt(0)" ::: "memory");
    __syncthreads();
    if (b.wave == 0 && lane_id() == 0) {
        unsigned* bar = b.bar;
        __builtin_amdgcn_s_waitcnt(0);
        unsigned nloc = b.st[0], nx = b.st[1];
        if (nloc == 0u) { xcd_barrier_complete(bar, b.x, nloc, nx); b.st[0] = nloc; b.st[1] = nx; }
        const unsigned old = xb_add(&bar[XB_XSUB(b.x)], 1u);
        const unsigned gen = old / nloc;
        if (old + 1u == (gen + 1u) * nloc) {
            __builtin_amdgcn_fence(__ATOMIC_RELEASE, "agent");
            asm volatile("s_waitcnt vmcnt(0)" ::: "memory");
            const unsigned og = xb_add(&bar[XB_TOP], 1u);
            const unsigned tg = og / nx;
            if (og + 1u == (tg + 1u) * nx) xb_add(&bar[XB_TOPGEN], 1u);
            else XB_SPIN(xb_ld(&bar[XB_TOPGEN]) == tg, bar);
            __builtin_amdgcn_fence(__ATOMIC_ACQUIRE, "agent");
            xb_add(&bar[XB_XGEN(b.x)], 1u);
            asm volatile("s_waitcnt vmcnt(0)" ::: "memory");
        } else {
            XB_SPIN(xb_ld(&bar[XB_XGEN(b.x)]) == gen, bar);
            __builtin_amdgcn_fence(__ATOMIC_ACQUIRE, "agent");
            asm volatile("s_waitcnt vmcnt(0)" ::: "memory");
        }
    }
    __syncthreads();
}

namespace g8 {
constexpr int BM = 256, BK = 64, HALF = 128, HTB = HALF * BK * 2, STAGE_BYTES = 8 * HTB, NXCD = 8, WGM = 8;
__host__ __device__ __forceinline__ int lds_byte(int r, int c) { const int st = (r >> 4) * 2 + (c >> 5), rr = r & 15, cc = c & 31, ob = rr * 64 + cc * 2; return st * 1024 + (ob ^ (((ob >> 9) & 1) << 5)); }
__host__ __device__ __forceinline__ void stage_rc(int b, int& R, int& C) { const int st = b / 1024, sb = b % 1024, swz = sb ^ (((sb >> 9) & 1) << 5); R = (st >> 1) * 16 + swz / 64; C = (st & 1) * 32 + (swz % 64) / 2; }
__host__ __device__ __forceinline__ int perm32(int rho) { const int n = rho >> 4, i = rho & 15; return 8 * (i >> 2) + 4 * n + (i & 3); }

struct Unit { const char* A; const char* B; int nt; int pm, pn, aux; };
__host__ __device__ __forceinline__ int lds_byte8(int r, int cb) { const int st = (r >> 4) * 2 + (cb >> 6), ob = (r & 15) * 64 + (cb & 63); return st * 1024 + (ob ^ (((ob >> 9) & 1) << 5)); }

__device__ __forceinline__ void tile_order(int L, int nM, int nN, int& pm, int& pn) {
    const int nwg = nM * nN; int wgid = L; { const int q = nwg / NXCD, r = nwg % NXCD, xcd = wgid % NXCD, off = wgid / NXCD; wgid = (xcd < r ? xcd * (q + 1) : r * (q + 1) + (xcd - r) * q) + off; }
    const int nig = WGM * nN, gid = wgid / nig, fm = gid * WGM, gsz = (nM - fm) < WGM ? (nM - fm) : WGM;
    pm = fm + ((wgid % nig) % gsz); pn = (wgid % nig) / gsz;
}

template <class Epi, class Sched, bool FP8 = false, bool SP2 = false, bool ALIGN_EPI = false>
__device__ __forceinline__ void gemm_phase(LAS unsigned char* lds, const Sched& S, const Epi& E, int tid_in) {
    constexpr unsigned LD = FP8 ? 1024u : 2048u;
    int tid_ = tid_in; asm volatile("" : "+v"(tid_));
    const int tid = tid_, wid = __builtin_amdgcn_readfirstlane(tid >> 6), lane = tid & 63, wr = wid >> 2, wc = wid & 3, fr = lane & 15, fq = lane >> 4;
    int R0, C0; stage_rc(tid * 16, R0, C0);
    const int Rb0 = Epi::PERM ? ((R0 & ~31) + perm32(R0 & 31)) : R0;
    const unsigned c2 = (unsigned)C0 * 2u;
    const unsigned ldsw = (unsigned)wid * 1024u;
    const int aoff = FP8 ? lds_byte8(wr * 64 + fr, fq * 32) : lds_byte(wr * 64 + fr, fq * 8), boff = FP8 ? lds_byte8(wc * 32 + fr, fq * 32) : lds_byte(wc * 32 + fr, fq * 8);
#define G8_SA(b, h) (((b) * 2 + (h)) * HTB)
#define G8_SB(b, h) ((4 + (b) * 2 + (h)) * HTB)
#define G8_DMA(gp, off) __builtin_amdgcn_global_load_lds((const unsigned*)(gp), (LAS unsigned*)(lds + (off)), 16, 0, 0)
#define G8_STAGE(bufoff, base, v) do { const char* _p = (base); G8_DMA(_p + (v), (bufoff) + ldsw); G8_DMA(_p + (size_t)64 * LD + (v), (bufoff) + ldsw + 8192); } while (0)
#define G8_LDA(dst, b, h) do { if constexpr (FP8) { _Pragma("unroll") for (int m = 0; m < 4; ++m) { const v4i lo_ = *(const LAS v4i*)(lds + G8_SA(b, h) + aoff + m * 2048), hi_ = *(const LAS v4i*)(lds + G8_SA(b, h) + aoff + m * 2048 + 16); dst##8[m] = __builtin_shufflevector(lo_, hi_, 0, 1, 2, 3, 4, 5, 6, 7); } } \
        else { _Pragma("unroll") for (int m = 0; m < 4; ++m) _Pragma("unroll") for (int k = 0; k < 2; ++k) dst[m][k] = *(const LAS bf16x8*)(lds + G8_SA(b, h) + aoff + m * 2048 + k * 1024); } } while (0)
#define G8_LDB(dst, b, h) do { if constexpr (FP8) { _Pragma("unroll") for (int n = 0; n < 2; ++n) { const v4i lo_ = *(const LAS v4i*)(lds + G8_SB(b, h) + boff + n * 2048), hi_ = *(const LAS v4i*)(lds + G8_SB(b, h) + boff + n * 2048 + 16); dst##8[n] = __builtin_shufflevector(lo_, hi_, 0, 1, 2, 3, 4, 5, 6, 7); } } \
        else { _Pragma("unroll") for (int n = 0; n < 2; ++n) _Pragma("unroll") for (int k = 0; k < 2; ++k) dst[n][k] = *(const LAS bf16x8*)(lds + G8_SB(b, h) + boff + n * 2048 + k * 1024); } } while (0)
#define G8_MMA(ai, bj, At, Bt) do { __builtin_amdgcn_s_setprio(1); _Pragma("unroll") for (int m = 0; m < 4; ++m) _Pragma("unroll") for (int n = 0; n < 2; ++n) { \
        if constexpr (FP8) asm volatile("v_mfma_f32_16x16x128_f8f6f4 %0, %1, %2, %0" : "+v"(acc[ai][bj][m][n]) : "v"(Bt##8[n]), "v"(At##8[m]));   \
        else { _Pragma("unroll") for (int k = 0; k < 2; ++k) acc[ai][bj][m][n] = __builtin_amdgcn_mfma_f32_16x16x32_bf16(Bt[n][k], At[m][k], acc[ai][bj][m][n], 0, 0, 0); } } \
        __builtin_amdgcn_s_setprio(0); } while (0)
#define G8_WAIT_V(n) asm volatile("s_waitcnt vmcnt(" #n ")" ::: "memory")
#define G8_WAIT_L(n) asm volatile("s_waitcnt lgkmcnt(" #n ")" ::: "memory")
#define G8_BAR __builtin_amdgcn_s_barrier()
#define G8_SCHED __builtin_amdgcn_sched_barrier(0)
    Unit cur, nxt; int ui = 0;
    if (!S.next(0, cur)) return;
    f32x4 acc[2][2][4][2];
#pragma unroll
    for (int a = 0; a < 2; ++a)
#pragma unroll
        for (int b = 0; b < 2; ++b)
#pragma unroll
            for (int m = 0; m < 4; ++m)
#pragma unroll
                for (int n = 0; n < 2; ++n) acc[a][b][m][n] = (f32x4){0.f, 0.f, 0.f, 0.f};
    bf16x8 At[4][2], B0[2][2], B1[2][2]; v8i At8[4], B08[2], B18[2];
    const unsigned vA = (unsigned)R0 * LD + c2, vB = (unsigned)Rb0 * LD + c2;
    constexpr size_t hS = (size_t)HALF * LD;
    {
        if constexpr (SP2) {
            G8_STAGE(G8_SB(0, 0), cur.B, vB); G8_STAGE(G8_SB(0, 1), cur.B + hS, vB); G8_STAGE(G8_SA(0, 0), cur.A, vA); G8_STAGE(G8_SA(0, 1), cur.A + hS, vA);
            if (wr == 1) G8_BAR;
            G8_WAIT_V(2); G8_BAR;
        } else {
            G8_STAGE(G8_SB(0, 0), cur.B, vB); G8_STAGE(G8_SA(0, 0), cur.A, vA); G8_STAGE(G8_SB(0, 1), cur.B + hS, vB); G8_STAGE(G8_SA(0, 1), cur.A + hS, vA);
            if (wr == 1) G8_BAR;
            G8_WAIT_V(4); G8_BAR;
        }
        G8_STAGE(G8_SB(1, 0), cur.B + 128, vB); G8_STAGE(G8_SA(1, 0), cur.A + 128, vA); G8_STAGE(G8_SB(1, 1), cur.B + hS + 128, vB);
        G8_WAIT_V(6); G8_BAR;
    }
    for (;;) {
        const bool has_next = S.next(ui + 1, nxt);
        if (!has_next) nxt = cur;
        const int nt = cur.nt;
        for (int t = 0; t < nt; t += 2) {
            const bool last = (t == nt - 2);
            const char* a1 = cur.A + (size_t)(t + 1) * 128 + hS;
            const char* a2 = last ? nxt.A : cur.A + (size_t)(t + 2) * 128; const char* b2 = last ? nxt.B : cur.B + (size_t)(t + 2) * 128;
            if constexpr (Epi::NAUX > 0) { if (t == 0 && wid < Epi::NAUX) __builtin_amdgcn_global_load_lds((const unsigned*)(E.aux_src(cur, wid) + lane), (LAS unsigned*)(lds + STAGE_BYTES + (ui & 1) * 2048 + wid * 256), 4, 0, 0); }
            if constexpr (SP2) {
            G8_LDB(B0, 0, 0); G8_LDB(B1, 0, 1); G8_SCHED; G8_LDA(At, 0, 0); G8_STAGE(G8_SA(1, 1), a1, vA);
            G8_WAIT_V(8); G8_WAIT_L(0); G8_BAR; G8_MMA(0, 0, At, B0); G8_MMA(0, 1, At, B1); G8_BAR; G8_SCHED;
            G8_LDA(At, 0, 1); G8_STAGE(G8_SB(0, 0), b2, vB); G8_STAGE(G8_SB(0, 1), b2 + hS, vB); G8_STAGE(G8_SA(0, 0), a2, vA);
            G8_WAIT_V(8); G8_WAIT_L(0); G8_BAR; G8_MMA(1, 0, At, B0); G8_MMA(1, 1, At, B1); G8_BAR; G8_SCHED;
            G8_LDB(B0, 1, 0); G8_LDB(B1, 1, 1); G8_SCHED; G8_LDA(At, 1, 0); G8_STAGE(G8_SA(0, 1), a2 + hS, vA);
            G8_WAIT_V(8); G8_WAIT_L(0); G8_BAR; G8_MMA(0, 0, At, B0); G8_MMA(0, 1, At, B1); G8_BAR; G8_SCHED;
            G8_LDA(At, 1, 1); G8_STAGE(G8_SB(1, 0), b2 + 128, vB); G8_STAGE(G8_SB(1, 1), b2 + hS + 128, vB); G8_STAGE(G8_SA(1, 0), a2 + 128, vA);
            G8_WAIT_V(8); G8_WAIT_L(0); G8_BAR; G8_MMA(1, 0, At, B0); G8_MMA(1, 1, At, B1); G8_BAR; G8_SCHED;
            } else {
            G8_LDB(B0, 0, 0); G8_SCHED; G8_LDA(At, 0, 0); G8_STAGE(G8_SA(1, 1), a1, vA);
            G8_WAIT_L(8); G8_BAR; G8_WAIT_L(0); G8_MMA(0, 0, At, B0); G8_BAR; G8_SCHED;
            G8_LDB(B1, 0, 1); G8_STAGE(G8_SB(0, 0), b2, vB);
            G8_BAR; G8_WAIT_L(0); G8_MMA(0, 1, At, B1); G8_BAR;
            G8_LDA(At, 0, 1); G8_STAGE(G8_SA(0, 0), a2, vA);
            G8_BAR; G8_WAIT_L(0); G8_MMA(1, 0, At, B0); G8_BAR; G8_SCHED;
            G8_STAGE(G8_SB(0, 1), b2 + hS, vB);
            G8_WAIT_V(6); G8_BAR; G8_MMA(1, 1, At, B1); G8_BAR;
            G8_LDB(B0, 1, 0); G8_SCHED; G8_LDA(At, 1, 0); G8_STAGE(G8_SA(0, 1), a2 + hS, vA);
            G8_WAIT_L(8); G8_BAR; G8_WAIT_L(0); G8_MMA(0, 0, At, B0); G8_BAR; G8_SCHED;
            G8_LDB(B1, 1, 1); G8_STAGE(G8_SB(1, 0), b2 + 128, vB);
            G8_BAR; G8_WAIT_L(0); G8_MMA(0, 1, At, B1); G8_BAR;
            G8_LDA(At, 1, 1); G8_STAGE(G8_SA(1, 0), a2 + 128, vA);
            G8_BAR; G8_WAIT_L(0); G8_MMA(1, 0, At, B0); G8_BAR; G8_SCHED;
            G8_STAGE(G8_SB(1, 1), b2 + hS + 128, vB);
            G8_WAIT_V(6); G8_BAR; G8_MMA(1, 1, At, B1); G8_BAR;
            }
        }
        if constexpr (ALIGN_EPI) { if (wr == 0) G8_BAR; }
        if constexpr (FP8) asm volatile("s_nop 7\n\ts_nop 7\n\ts_nop 7" ::: "memory");
        const bool keep = E(acc, cur, wr, wc, fr, fq, (const LAS float*)(lds + STAGE_BYTES + (ui & 1) * 2048));
        if (!has_next) break;
        if (!keep)
#pragma unroll
        for (int a = 0; a < 2; ++a)
#pragma unroll
            for (int b = 0; b < 2; ++b)
#pragma unroll
                for (int m = 0; m < 4; ++m)
#pragma unroll
                    for (int n = 0; n < 2; ++n) acc[a][b][m][n] = (f32x4){0.f, 0.f, 0.f, 0.f};
        cur = nxt; ++ui;
        if constexpr (ALIGN_EPI) { if (wr == 1) G8_BAR; }
    }
    G8_WAIT_V(0);
    if constexpr (!ALIGN_EPI) { if (wr == 0) G8_BAR; }
    G8_BAR;
#undef G8_SA
#undef G8_SB
#undef G8_DMA
#undef G8_STAGE
#undef G8_LDA
#undef G8_LDB
#undef G8_MMA
#undef G8_WAIT_V
#undef G8_WAIT_L
#undef G8_BAR
#undef G8_SCHED
}
}

namespace att {
constexpr int D = 128, NW = 8, QBLK = 32, KVBLK = 64;
constexpr float SCALE = 0.088388347648318440f;
constexpr float THR = 5.f;
constexpr int LDQ = 1024, LDK = 256, LDO = 1024;
constexpr size_t SHM_V = KVBLK * D  , SHM_K = KVBLK * D  , NBUF = 3, SHM_ATTN = NBUF * SHM_V + NBUF * SHM_K + NW * 64 * 4 + 48;
#define KSWZ(row, colB) ((row) * 256 + ((colB) ^ (((row) & 7) << 4)))
#define SBAR() __builtin_amdgcn_sched_barrier(0)
#define PIN(a, b) asm volatile("" : "+v"(a), "+v"(b))
__device__ __forceinline__ int crow(int r, int hi) { return (r & 3) + 8 * (r >> 2) + 4 * hi; }
template <bool SC, class RowFn>
__device__ __forceinline__ void wave_rows_out(LAS unsigned char* st, const f32x16* o, const float (&sc)[16], int lane, RowFn fn) {
  const int r32 = lane & 31, hi = lane >> 5; const bool odd = (lane & 1) != 0;
  LAS unsigned char* wp = st + (odd ? (32 + r32 - 1) * 2 : r32 * 2);
#pragma unroll
  for (int r = 0; r < 16; ++r) {
#pragma unroll
    for (int dp = 0; dp < 4; dp += 2) {
      const float s = SC ? sc[r] : 1.f; const float a = o[dp][r] * s, b = o[dp + 1][r] * s; const float recv = sx<1>(odd ? a : b);
      *(LAS unsigned*)(wp + crow(r, hi) * 256 + dp * 64) = cvt_pk_bf16(odd ? recv : a, odd ? b : recv); } }
  asm volatile("s_waitcnt lgkmcnt(0)" ::: "memory");
  const LAS unsigned char* rp = st + (lane >> 4) * 256 + (lane & 15) * 16;
#pragma unroll
  for (int i = 0; i < 8; ++i) fn(4 * i + (lane >> 4), (lane & 15) * 8, *(const LAS u32x4*)(rp + i * 1024));
}
template <class RowFn>
__device__ __forceinline__ void wave_rows_out_i(LAS unsigned char* st, const f32x16* o, int lane, RowFn fn) {
  const int r32 = lane & 31, hi = lane >> 5; const bool odd = (lane & 1) != 0;
  LAS unsigned char* wp = st + (odd ? (32 + r32 - 1) * 2 : r32 * 2);
#pragma unroll
  for (int r = 0; r < 16; ++r) {
#pragma unroll
    for (int dp = 0; dp < 4; dp += 2) {
      const float a = o[dp][r], b = o[dp + 1][r]; const float recv = sx<1>(odd ? a : b);
      *(LAS unsigned*)(wp + crow(r, hi) * 256 + dp * 64) = cvt_pk_bf16(odd ? recv : a, odd ? b : recv); } }
  asm volatile("s_waitcnt lgkmcnt(0)" ::: "memory");
  const LAS unsigned char* rp = st + (lane >> 4) * 256 + (lane & 15) * 16;
#pragma unroll
  for (int i = 0; i < 8; ++i) fn(i, 4 * i + (lane >> 4), (lane & 15) * 8, *(const LAS u32x4*)(rp + i * 1024));
}
__device__ __forceinline__ void partial0(f32x16& p0, f32x16& p1, float& M) {
  float pmax = p0[0]; for (int r = 1; r < 16; ++r) pmax = fmaxf(pmax, p0[r]); for (int r = 0; r < 16; ++r) pmax = fmaxf(pmax, p1[r]);
  { auto rr = __builtin_amdgcn_permlane32_swap(__float_as_uint(pmax), __float_as_uint(pmax), false, false);
    pmax = fmaxf(__uint_as_float(rr[0]), __uint_as_float(rr[1])); }
  M = pmax;
  for (int r = 0; r < 16; ++r) { p0[r] -= M; p1[r] -= M; }
}
template <bool EXP0 = true>
__device__ __forceinline__ void partialSM(f32x16& p0, f32x16& p1, float& m_reg, float& mn, float& alpha) {
  constexpr float C = SCALE * 1.4426950408889634f;
  float pmax = p0[0]; for (int r = 1; r < 16; ++r) pmax = fmaxf(pmax, p0[r]); for (int r = 0; r < 16; ++r) pmax = fmaxf(pmax, p1[r]);
  { auto rr = __builtin_amdgcn_permlane32_swap(__float_as_uint(pmax), __float_as_uint(pmax), false, false);
    pmax = fmaxf(__uint_as_float(rr[0]), __uint_as_float(rr[1])); }
  if (__builtin_expect(__all(pmax - m_reg <= THR / SCALE), 1)) { mn = m_reg; alpha = 1.f; }
  else { mn = fmaxf(m_reg, pmax); alpha = __builtin_amdgcn_exp2f((m_reg - mn) * C); m_reg = mn; }
  float mnC = -mn * C;
  for (int r = 0; r < 16; ++r) p0[r] = fmaf(p0[r], C, mnC); for (int r = 0; r < 16; ++r) p1[r] = fmaf(p1[r], C, mnC);
  if (EXP0) { for (int r = 0; r < 16; ++r) p0[r] = __builtin_amdgcn_exp2f(p0[r]); }
}
__device__ __forceinline__ void finishSM(f32x16& p0, f32x16& p1, float alpha, float& l_reg, bf16x8& pa0, bf16x8& pa1, bf16x8& pa2, bf16x8& pa3) {
  for (int r = 0; r < 16; ++r) p1[r] = __builtin_amdgcn_exp2f(p1[r]);
  float ps = 0; for (int r = 0; r < 16; ++r) ps += p0[r]; for (int r = 0; r < 16; ++r) ps += p1[r];
  { auto rr = __builtin_amdgcn_permlane32_swap(__float_as_uint(ps), __float_as_uint(ps), false, false);
    ps = __uint_as_float(rr[0]) + __uint_as_float(rr[1]); }
  l_reg = l_reg * alpha + ps;
#define PK4(P, BASE, OUT) do { unsigned a0 = cvt_pk_bf16(P[BASE + 0], P[BASE + 1]), a1 = cvt_pk_bf16(P[BASE + 2], P[BASE + 3]);   \
    unsigned b0 = cvt_pk_bf16(P[BASE + 4], P[BASE + 5]), b1 = cvt_pk_bf16(P[BASE + 6], P[BASE + 7]);                              \
    auto r0 = __builtin_amdgcn_permlane32_swap(a0, b0, false, false); auto r1 = __builtin_amdgcn_permlane32_swap(a1, b1, false, false); \
    u32x4 w = {r0[0], r1[0], r0[1], r1[1]}; OUT = *reinterpret_cast<bf16x8*>(&w); } while (0)
  PK4(p0, 0, pa0); PK4(p0, 8, pa1); PK4(p1, 0, pa2); PK4(p1, 8, pa3);
#undef PK4
}
#define KSWZ8(row, cb) ((row) * 128 + ((cb) ^ ((((row) >> 1) & 7) << 4)))
__device__ __forceinline__ void qkt8(f32x16& p0, f32x16& p1, const char* Ks, const v8i (&qr)[2], int r32, int hi) {
  v8i kf[2][2];
#pragma unroll
  for (int kb = 0; kb < 2; ++kb)
#pragma unroll
    for (int t = 0; t < 2; ++t) { const int row = 32 * kb + r32, cb = 64 * t + 32 * hi;
      const v4i lo = *reinterpret_cast<const v4i*>(Ks + KSWZ8(row, cb)), hh = *reinterpret_cast<const v4i*>(Ks + KSWZ8(row, cb + 16));
      kf[kb][t] = __builtin_shufflevector(lo, hh, 0, 1, 2, 3, 4, 5, 6, 7); }
  asm volatile("v_mfma_f32_32x32x64_f8f6f4 %0, %1, %2, 0" : "=&v"(p0) : "v"(kf[0][0]), "v"(qr[0]));
  asm volatile("v_mfma_f32_32x32x64_f8f6f4 %0, %1, %2, 0" : "=&v"(p1) : "v"(kf[1][0]), "v"(qr[0]));
  asm volatile("v_mfma_f32_32x32x64_f8f6f4 %0, %1, %2, %0" : "+v"(p0) : "v"(kf[0][1]), "v"(qr[1]));
  asm volatile("v_mfma_f32_32x32x64_f8f6f4 %0, %1, %2, %0" : "+v"(p1) : "v"(kf[1][1]), "v"(qr[1]));
  asm volatile("s_nop 7\n\ts_nop 7\n\ts_nop 7" ::: "memory");
}
__device__ __forceinline__ int v_st(int k, int c) { const int kk = (k & ~0xC) | ((k & 4) << 1) | ((k & 8) >> 1); return ((kk >> 3) * 4 + (c >> 5)) * 512 + ((kk & 7) * 32 + (c & 31)) * 2; }
__device__ __forceinline__ int v_rd_base(int lane) { return ((lane & 3) << 3) | (((lane >> 2) & 3) << 6) | (((lane >> 4) & 1) << 5) | (((lane >> 5) & 1) << 8); }
constexpr int v_rd_off(int d0, int ks, int half) { return d0 * 512 + ks * 4096 + half * 2048; }
template <int OFF> __device__ __forceinline__ s16x4 tr_read(int vb) {
  s16x4 r; asm volatile("ds_read_b64_tr_b16 %0, %1 offset:%2" : "=&v"(r) : "v"(vb), "i"(OFF) : "memory"); return r;
}
template <int D0> __device__ __forceinline__ void pv_one(f32x16& od, int vb, bf16x8 pa0, bf16x8 pa1, bf16x8 pa2, bf16x8 pa3) {
  const s16x4 l0 = tr_read<v_rd_off(D0, 0, 0)>(vb), h0 = tr_read<v_rd_off(D0, 0, 1)>(vb), l1 = tr_read<v_rd_off(D0, 1, 0)>(vb), h1 = tr_read<v_rd_off(D0, 1, 1)>(vb);
  const s16x4 l2 = tr_read<v_rd_off(D0, 2, 0)>(vb), h2 = tr_read<v_rd_off(D0, 2, 1)>(vb), l3 = tr_read<v_rd_off(D0, 3, 0)>(vb), h3 = tr_read<v_rd_off(D0, 3, 1)>(vb);
  asm volatile("s_waitcnt lgkmcnt(0)" ::: "memory"); SBAR();
#define PK(L, H) (bf16x8){L[0], L[1], L[2], L[3], H[0], H[1], H[2], H[3]}
  od = __builtin_amdgcn_mfma_f32_32x32x16_bf16(pa0, PK(l0, h0), od, 0, 0, 0);
  od = __builtin_amdgcn_mfma_f32_32x32x16_bf16(pa1, PK(l1, h1), od, 0, 0, 0);
  od = __builtin_amdgcn_mfma_f32_32x32x16_bf16(pa2, PK(l2, h2), od, 0, 0, 0);
  od = __builtin_amdgcn_mfma_f32_32x32x16_bf16(pa3, PK(l3, h3), od, 0, 0, 0);
#undef PK
}
__device__ __forceinline__ void pv_d0(f32x16* o, int vb, bf16x8 pa0, bf16x8 pa1, bf16x8 pa2, bf16x8 pa3) {
  pv_one<0>(o[0], vb, pa0, pa1, pa2, pa3); pv_one<1>(o[1], vb, pa0, pa1, pa2, pa3); pv_one<2>(o[2], vb, pa0, pa1, pa2, pa3); pv_one<3>(o[3], vb, pa0, pa1, pa2, pa3);
}
__device__ __forceinline__ void finish8(f32x16& p0, f32x16& p1, v8i& P8) {
  for (int r = 0; r < 16; ++r) p0[r] = __builtin_amdgcn_exp2f(p0[r]); for (int r = 0; r < 16; ++r) p1[r] = __builtin_amdgcn_exp2f(p1[r]);
#pragma unroll
  for (int w = 0; w < 4; ++w) { P8[w] = (int)pk4_fp8(p0[4 * w], p0[4 * w + 1], p0[4 * w + 2], p0[4 * w + 3]); P8[4 + w] = (int)pk4_fp8(p1[4 * w], p1[4 * w + 1], p1[4 * w + 2], p1[4 * w + 3]); }
}
__device__ __forceinline__ void pv8(f32x16* o, const char* Vs, int off0, int off1, const v8i& P8, const char* ones_lds) {
  v8i vf[4];
#pragma unroll
  for (int d0 = 0; d0 < 4; ++d0) { const v4i lo = *reinterpret_cast<const v4i*>(Vs + d0 * 2048 + off0), hh = *reinterpret_cast<const v4i*>(Vs + d0 * 2048 + off1);
    vf[d0] = __builtin_shufflevector(lo, hh, 0, 1, 2, 3, 4, 5, 6, 7); }
  asm volatile("s_nop 4\n\tv_mfma_f32_32x32x64_f8f6f4 %0, %1, %2, %0" : "+v"(o[0]) : "v"(P8), "v"(vf[0]));
  asm volatile("v_mfma_f32_32x32x64_f8f6f4 %0, %1, %2, %0" : "+v"(o[1]) : "v"(P8), "v"(vf[1]));
  asm volatile("v_mfma_f32_32x32x64_f8f6f4 %0, %1, %2, %0" : "+v"(o[2]) : "v"(P8), "v"(vf[2]));
  asm volatile("v_mfma_f32_32x32x64_f8f6f4 %0, %1, %2, %0" : "+v"(o[3]) : "v"(P8), "v"(vf[3]));
  { const v8i ones = *reinterpret_cast<const v8i*>(ones_lds);
  asm volatile("v_mfma_f32_32x32x64_f8f6f4 %0, %1, %2, %0" : "+v"(o[4]) : "v"(P8), "v"(ones)); }
}
#define MFMA8(ACC, A, B) asm volatile("v_mfma_f32_32x32x64_f8f6f4 %0, %1, %2, %0" : "+v"(ACC) : "v"(A), "v"(B))
#define KEEP(x) asm volatile("" :: "v"(x))
#define MFMA8Z(ACC, A, B) asm volatile("v_mfma_f32_32x32x64_f8f6f4 %0, %1, %2, 0" : "=&v"(ACC) : "v"(A), "v"(B))
__device__ __forceinline__ float amax3(float a, float b, float c) { float d; asm("v_max3_f32 %0, %1, %2, %3" : "=v"(d) : "v"(a), "v"(b), "v"(c)); return d; }
constexpr float THR2 = THR * 1.4426950408889634f;
typedef short s16x8 __attribute__((ext_vector_type(8)));
#define MFMA16Z(ACC, A, B) asm volatile("v_mfma_f32_32x32x16_bf16 %0, %1, %2, 0" : "=&v"(ACC) : "v"(A), "v"(B))
__device__ __forceinline__ void set_mf(u32x4& mf, float M, int hi) {
  const float n = -M; const unsigned b0 = __float_as_uint(n) & 0xFFFF0000u; const float r1 = n - __uint_as_float(b0);
  const unsigned b1 = __float_as_uint(r1) & 0xFFFF0000u; const float r2 = r1 - __uint_as_float(b1); const unsigned b2 = __float_as_uint(r2) & 0xFFFF0000u;
  mf.x = hi ? 0u : ((b0 >> 16) | b1); mf.y = hi ? 0u : (b2 >> 16); mf.z = 0u; mf.w = 0u;
}
__device__ __forceinline__ void qk_fin8(f32x16& q0, f32x16& q1, const char* Ks, const v8i (&qr)[2], int r32, int hi, f32x16& p0, f32x16& p1, v8i& P8, const u32x4& mf, const char* one16_lds) {
  v8i kf[2][2];
  const u32x4 one16 = *reinterpret_cast<const u32x4*>(one16_lds);
#pragma unroll
  for (int kb = 0; kb < 2; ++kb)
#pragma unroll
    for (int t = 0; t < 2; ++t) { const int row = 32 * kb + r32, cb = 64 * t + 32 * hi;
      const v4i lo = *reinterpret_cast<const v4i*>(Ks + KSWZ8(row, cb)), hh = *reinterpret_cast<const v4i*>(Ks + KSWZ8(row, cb + 16));
      kf[kb][t] = __builtin_shufflevector(lo, hh, 0, 1, 2, 3, 4, 5, 6, 7); }
  SBAR(); MFMA16Z(q0, one16, mf); MFMA16Z(q1, one16, mf); SBAR();
#pragma unroll
  for (int r = 0; r < 8; ++r) p0[r] = __builtin_amdgcn_exp2f(p0[r]);
  SBAR(); MFMA8(q0, kf[0][0], qr[0]); KEEP(one16); SBAR();
#pragma unroll
  for (int r = 8; r < 16; ++r) p0[r] = __builtin_amdgcn_exp2f(p0[r]);
  SBAR(); MFMA8(q1, kf[1][0], qr[0]); KEEP(kf[0][0]); SBAR();
#pragma unroll
  for (int r = 0; r < 8; ++r) p1[r] = __builtin_amdgcn_exp2f(p1[r]);
  SBAR(); MFMA8(q0, kf[0][1], qr[1]); KEEP(kf[1][0]); SBAR();
#pragma unroll
  for (int r = 8; r < 16; ++r) p1[r] = __builtin_amdgcn_exp2f(p1[r]);
  SBAR(); MFMA8(q1, kf[1][1], qr[1]); KEEP(kf[0][1]); SBAR();
#pragma unroll
  for (int w = 0; w < 4; ++w) { P8[w] = (int)pk4_fp8u(p0[4 * w], p0[4 * w + 1], p0[4 * w + 2], p0[4 * w + 3]); P8[4 + w] = (int)pk4_fp8u(p1[4 * w], p1[4 * w + 1], p1[4 * w + 2], p1[4 * w + 3]); }
  KEEP(kf[1][1]);
  SBAR();
}
__device__ __forceinline__ void pv_sm8(f32x16* o, const char* Vs, int off0, int off1, const v8i& P8, const char* ones_lds, f32x16& p0, f32x16& p1, float& M, u32x4& mf, float* al_l, int r32, int hi) {
  v8i vf[4];
  const v8i ones = *reinterpret_cast<const v8i*>(ones_lds);
#pragma unroll
  for (int d0 = 0; d0 < 4; ++d0) { const v4i lo = *reinterpret_cast<const v4i*>(Vs + d0 * 2048 + off0), hh = *reinterpret_cast<const v4i*>(Vs + d0 * 2048 + off1);
    vf[d0] = __builtin_shufflevector(lo, hh, 0, 1, 2, 3, 4, 5, 6, 7); }
  SBAR(); MFMA8(o[0], P8, vf[0]); SBAR();
  const float t0 = amax3(p0[0], p0[1], p0[2]), t1 = amax3(p0[3], p0[4], p0[5]), t2 = amax3(p0[6], p0[7], p0[8]), t3 = amax3(p0[9], p0[10], p0[11]), t4 = amax3(p0[12], p0[13], p0[14]);
  SBAR(); MFMA8(o[1], P8, vf[1]); KEEP(vf[0]); SBAR();
  const float u0 = amax3(p1[0], p1[1], p1[2]), u1 = amax3(p1[3], p1[4], p1[5]), u2 = amax3(p1[6], p1[7], p1[8]), u3 = amax3(p1[9], p1[10], p1[11]), u4 = amax3(p1[12], p1[13], p1[14]);
  SBAR(); MFMA8(o[2], P8, vf[2]); KEEP(vf[1]); SBAR();
  float pm = amax3(amax3(amax3(t0, t1, t2), amax3(t3, t4, p0[15]), amax3(u0, u1, u2)), amax3(u3, u4, p1[15]), 0.f);
  { auto rr = __builtin_amdgcn_permlane32_swap(__float_as_uint(pm), __float_as_uint(pm), false, false);
    pm = amax3(__uint_as_float(rr[0]), __uint_as_float(rr[1]), 0.f); }
  SBAR(); MFMA8(o[3], P8, vf[3]); KEEP(vf[2]); SBAR();
  MFMA8(o[4], P8, ones); KEEP(vf[3]); SBAR();
  const bool moved = !__all(pm <= THR2);
  KEEP(ones);
  if (__builtin_expect(moved, 0)) {
    const float d = pm, alpha = __builtin_amdgcn_exp2f(-d);
    M += d; set_mf(mf, M, hi);
#pragma unroll
    for (int r = 0; r < 16; ++r) { p0[r] -= d; p1[r] -= d; }
    asm volatile("s_nop 7\n\ts_nop 7\n\ts_nop 7" ::: "memory");
    if (hi == 0) al_l[r32] = alpha; asm volatile("s_waitcnt lgkmcnt(0)" ::: "memory");
    for (int dd = 0; dd < 5; ++dd) for (int r = 0; r < 16; ++r) o[dd][r] *= al_l[crow(r, hi)];
  }
}
__device__ __forceinline__ void attn_dense_body(const unsigned char* __restrict__ Qb, const unsigned char* __restrict__ Kh, const unsigned char* __restrict__ Vt,
                                                bf16_t* __restrict__ Ob, int seq, char* lds, int tid_in) {
  int tid_ = tid_in; asm volatile("" : "+v"(tid_));
  const int tid = tid_, wid = tid >> 6, lane = tid & 63, r32 = lane & 31, hi = lane >> 5;
  char* V_lds = lds; char* K_lds = lds + NBUF * SHM_V;
  float* ws = (float*)(lds + NBUF * SHM_V + NBUF * SHM_K) + wid * 64; float* al_l = ws + 32;
  float M; u32x4 mf; f32x16 o[5] = {}; v8i qr[2];
  const char* ones = lds + NBUF * SHM_V + NBUF * SHM_K + NW * 64 * 4;
  const char* one16 = ones + 32;
  if (tid < 12) ((int*)ones)[tid] = tid < 8 ? 0x38383838 : 0x3F803F80;
  const unsigned char* Qw = Qb + (long)(wid * QBLK + r32) * LDQ + hi * 32;
#pragma unroll
  for (int t = 0; t < 2; ++t) qr[t] = *reinterpret_cast<const v8i*>(Qw + t * 64);
  const int kkey = tid >> 3, kpc = (tid & 7) * 16, kst = KSWZ8(kkey, kpc);
  const int vd = tid >> 2, vst = vd * 64 + (((tid & 3) ^ ((vd >> 2) & 3)) << 4);
  const int vsw = (r32 >> 2) & 3, voff0 = r32 * 64 + (((2 * hi) ^ vsw) << 4), voff1 = r32 * 64 + (((2 * hi + 1) ^ vsw) << 4);
  struct { u32x4 vs0, ks0; } sr_;
  const __amdgpu_buffer_rsrc_t rV = __builtin_amdgcn_make_buffer_rsrc((void*)Vt, (short)0, 0x7fffffff, 0x00020000), rK = __builtin_amdgcn_make_buffer_rsrc((void*)Kh, (short)0, 0x7fffffff, 0x00020000);
  const unsigned vlo = (unsigned)tid * 16u, klo = (unsigned)(kkey * LDK + kpc);
#define SLOAD(k0) do { sr_.vs0 = __builtin_bit_cast(u32x4, __builtin_amdgcn_raw_buffer_load_b128(rV, vlo, (unsigned)(((k0) / KVBLK) * 8192), 0)); \
    sr_.ks0 = __builtin_bit_cast(u32x4, __builtin_amdgcn_raw_buffer_load_b128(rK, klo, (unsigned)((k0) * LDK), 0)); } while (0)
#define SWRITE(b) do { *(u32x4*)(V_lds + (b) * SHM_V + vst) = sr_.vs0; *(u32x4*)(K_lds + (b) * SHM_K + kst) = sr_.ks0; } while (0)
#define SWAIT() asm volatile("s_waitcnt vmcnt(0)" ::: "memory")
  f32x16 pA0, pA1, pB0, pB1; v8i P8; const int NT = seq / KVBLK;
  SLOAD(0); SWAIT(); SWRITE(0); SLOAD(KVBLK); __syncthreads();
  qkt8(pA0, pA1, (const char*)K_lds, qr, r32, hi); partial0(pA0, pA1, M); set_mf(mf, M, hi);
  SWAIT(); SWRITE(1); if (2 < NT) SLOAD(2 * KVBLK); __syncthreads();
  int bt = 1;
#define NXB(b) ((b) == 2 ? 0 : (b) + 1)
  int j = 1;
#define ABLK(Q0, Q1, P0, P1, KB, WB, VB, LT) do { SBAR(); qk_fin8(Q0, Q1, (const char*)K_lds + (KB) * SHM_K, qr, r32, hi, P0, P1, P8, mf, one16); \
    SWAIT(); SWRITE(WB); SLOAD((LT) * KVBLK); SBAR(); pv_sm8(o, V_lds + (VB) * SHM_V, voff0, voff1, P8, ones, Q0, Q1, M, mf, al_l, r32, hi); __syncthreads(); } while (0)
  for (; j + 7 < NT; j += 6) {
    ABLK(pB0, pB1, pA0, pA1, 1, 2, 0, j + 2); ABLK(pA0, pA1, pB0, pB1, 2, 0, 1, j + 3);
    ABLK(pB0, pB1, pA0, pA1, 0, 1, 2, j + 4); ABLK(pA0, pA1, pB0, pB1, 1, 2, 0, j + 5);
    ABLK(pB0, pB1, pA0, pA1, 2, 0, 1, j + 6); ABLK(pA0, pA1, pB0, pB1, 0, 1, 2, j + 7);
  }
#undef ABLK
  for (; j + 1 < NT; j += 2) {
    const int bp = NXB(NXB(bt)), bn = NXB(bt);
    SBAR(); qk_fin8(pB0, pB1, (const char*)K_lds + bt * SHM_K, qr, r32, hi, pA0, pA1, P8, mf, one16);
    SWAIT(); SWRITE(bn); SLOAD((j + 2) * KVBLK); SBAR();
    pv_sm8(o, V_lds + bp * SHM_V, voff0, voff1, P8, ones, pB0, pB1, M, mf, al_l, r32, hi);
    __syncthreads();
    SBAR(); qk_fin8(pA0, pA1, (const char*)K_lds + bn * SHM_K, qr, r32, hi, pB0, pB1, P8, mf, one16);
    SWAIT(); SWRITE(bp); if (j + 3 < NT) SLOAD((j + 3) * KVBLK); SBAR();
    pv_sm8(o, V_lds + bt * SHM_V, voff0, voff1, P8, ones, pA0, pA1, M, mf, al_l, r32, hi);
    __syncthreads();
    bt = bp;
  }
  { const int bp = NXB(NXB(bt));
  SBAR(); qk_fin8(pB0, pB1, (const char*)K_lds + bt * SHM_K, qr, r32, hi, pA0, pA1, P8, mf, one16);
  pv_sm8(o, V_lds + bp * SHM_V, voff0, voff1, P8, ones, pB0, pB1, M, mf, al_l, r32, hi);
  finish8(pB0, pB1, P8); SBAR();
  pv8(o, V_lds + bt * SHM_V, voff0, voff1, P8, ones);
  asm volatile("s_nop 7\n\ts_nop 7\n\ts_nop 7" : "+v"(o[0]), "+v"(o[1]), "+v"(o[2]), "+v"(o[3]), "+v"(o[4]) :: "memory"); }
#undef NXB
  float rli[16];
#pragma unroll
  for (int r = 0; r < 16; ++r) rli[r] = __builtin_amdgcn_rcpf(o[4][r]);
  bf16_t* Ow = Ob + (long)(wid * QBLK) * LDO;
  wave_rows_out<true>((LAS unsigned char*)lds + 65536 + wid * 8192, o, rli, lane, [&](int row, int col8, u32x4 v) { *(u32x4*)(Ow + (long)row * LDO + col8) = v; });
  __syncthreads();
#undef SLOAD
#undef SWRITE
#undef SWAIT
}
#undef KSWZ
#undef KSWZ8
#undef SBAR
}

struct KArgs { const float* in[23]; float* out; unsigned char* ws; };
enum { I_X = 0, I_C, I_CTX, I_CCTX, I_WMOD, I_BMOD, I_WIN, I_BGATE, I_QGAIN, I_KGAIN, I_WAO, I_WFOUR, I_SGUGAIN, I_WSPAT, I_BSPAT, I_WSGUO, I_WOUT, I_WROUTER, I_BROUTER, I_WGU, I_BGU, I_WDN, I_BDN };

typedef __attribute__((address_space(4))) const char* kaptr_t;
__device__ __forceinline__ const float* INP(int i) {
    kaptr_t ka = (kaptr_t)__builtin_amdgcn_kernarg_segment_ptr();
    return (const float*)(const GAS float*)*(const unsigned long long volatile __attribute__((address_space(4)))*)(ka + i * 8);
}
__device__ __forceinline__ float* OUTP() {
    kaptr_t ka = (kaptr_t)__builtin_amdgcn_kernarg_segment_ptr();
    return (float*)(GAS float*)*(const unsigned long long volatile __attribute__((address_space(4)))*)(ka + 23 * 8);
}
struct Frame {
    LAS unsigned char* lds; unsigned char* ws;
    int tid, lane, wave, vcu, G;
};
__device__ __forceinline__ void refresh(Frame& F) {
    int w0 = F.wave; asm volatile("" : "+s"(w0)); int t = (w0 << 6) | lane_id(); asm volatile("" : "+v"(t)); F.tid = t; F.lane = t & 63; F.wave = w0;
    GAS unsigned char* w = (GAS unsigned char*)F.ws; asm volatile("" : "+s"(w)); F.ws = (unsigned char*)w;
    int v = F.vcu; asm volatile("" : "+s"(v)); F.vcu = v;
}
__device__ __forceinline__ int launder_v(int x) { asm volatile("" : "+v"(x)); return x; }
__device__ __forceinline__ int launder_s(int x) { asm volatile("" : "+s"(x)); return x; }
__device__ __forceinline__ int modrow_of(int row) { return row < SEQ ? 0 : (row < NXR ? 1 : 2); }

__device__ __forceinline__ void cvt_item(const float* src, int ldS, bf16_t* dst, int K, int k0, int srccol0, int dstrow0, LAS float* scr, int lane) {
    f32x4 v[16];
#pragma unroll
    for (int it = 0; it < 16; ++it) { const int kk = it * 4 + (lane >> 4), nn = (lane & 15) * 4; v[it] = *(const f32x4*)(src + (size_t)(k0 + kk) * ldS + srccol0 + nn); }
#pragma unroll
    for (int it = 0; it < 16; ++it) { const int kk = it * 4 + (lane >> 4), nn = (lane & 15) * 4; LAS float* s = scr + kk * 65 + nn; s[0] = v[it].x; s[1] = v[it].y; s[2] = v[it].z; s[3] = v[it].w; }
    asm volatile("s_waitcnt lgkmcnt(0)" ::: "memory");
    const int kb = lane & 7;
#pragma unroll
    for (int j = 0; j < 8; ++j) {
        const int n = (lane >> 3) + 8 * j; const LAS float* s = scr + (8 * kb) * 65 + n;
        u32x4 o; o.x = cvt_pk_bf16(s[0], s[65]); o.y = cvt_pk_bf16(s[2 * 65], s[3 * 65]); o.z = cvt_pk_bf16(s[4 * 65], s[5 * 65]); o.w = cvt_pk_bf16(s[6 * 65], s[7 * 65]);
        *(u32x4*)(dst + (size_t)(dstrow0 + n) * K + k0 + 8 * kb) = o;
    }
    asm volatile("s_waitcnt lgkmcnt(0)" ::: "memory");
}

struct CvtDesc { const float* src; unsigned char* dst; int ldS, k0, srccol0, dstrow0; };
__device__ __forceinline__ void cvt_load(const CvtDesc& d, f32x4 (&v)[16], int lane) {
#pragma unroll
    for (int it = 0; it < 16; ++it) { const int kk = it * 4 + (lane >> 4), nn = (lane & 15) * 4; v[it] = *(const f32x4*)(d.src + (size_t)(d.k0 + kk) * d.ldS + d.srccol0 + nn); }
}
__device__ __forceinline__ void cvt_finish(const CvtDesc& d, const f32x4 (&v)[16], LAS float* scr, int lane) {
#pragma unroll
    for (int it = 0; it < 16; ++it) { const int kk = it * 4 + (lane >> 4), nn = (lane & 15) * 4; LAS float* s = scr + kk * 65 + nn; s[0] = v[it].x; s[1] = v[it].y; s[2] = v[it].z; s[3] = v[it].w; }
    asm volatile("s_waitcnt lgkmcnt(0)" ::: "memory");
    const int kb = lane & 7;
#pragma unroll
    for (int j = 0; j < 8; ++j) {
        const int n = (lane >> 3) + 8 * j; const LAS float* s = scr + (8 * kb) * 65 + n;
        u32x2 o; o.x = pk4_fp8(s[0] * 64.f, s[65] * 64.f, s[2 * 65] * 64.f, s[3 * 65] * 64.f); o.y = pk4_fp8(s[4 * 65] * 64.f, s[5 * 65] * 64.f, s[6 * 65] * 64.f, s[7 * 65] * 64.f);
        *(u32x2*)(d.dst + (size_t)(d.dstrow0 + n) * DM + d.k0 + 8 * kb) = o;
    }
    asm volatile("s_waitcnt lgkmcnt(0)" ::: "memory");
}
__device__ __forceinline__ void p0_prologue(Frame& F) {
    const int gw = F.vcu * 8 + F.wave, NGW = F.G * 8;
    LAS float* scr = (LAS float*)(F.lds + F.wave * 16640);
    {
        constexpr int I_IN = 16 * 96, I_SQ = 256, I_S = 128;
        constexpr int PER_L = I_IN + 2 * I_SQ + I_S;
        for (int it = gw; it < DEPTH * PER_L; it += NGW) {
            const int l = it / PER_L; int r = it % PER_L;
            if (r < I_IN) { const int kb = r / 96, nb = r % 96; CvtDesc d; d.src = INP(I_WIN) + (size_t)l * DM * IN_DIM; d.dst = (unsigned char*)(F.ws + WS_WIN) + (size_t)l * IN_DIM * DM; d.ldS = IN_DIM; d.k0 = kb * 64; d.srccol0 = nb * 64; d.dstrow0 = nb * 64;
                f32x4 vv[16]; cvt_load(d, vv, F.lane); cvt_finish(d, vv, scr, F.lane); continue; } r -= I_IN;
            if (r < I_SQ) { const int kb = r / 16, nb = r % 16; cvt_item(INP(I_WAO) + (size_t)l * DM * DM, DM, (bf16_t*)(F.ws + WS_WA) + (size_t)l * DM * DM, DM, kb * 64, nb * 64, nb * 64, scr, F.lane); continue; } r -= I_SQ;
            if (r < I_SQ) { const int kb = r / 16, nb = r % 16; cvt_item(INP(I_WOUT) + (size_t)l * DM * DM, DM, (bf16_t*)(F.ws + WS_WO) + (size_t)l * DM * DM, DM, kb * 64, nb * 64, nb * 64, scr, F.lane); continue; } r -= I_SQ;
            { const int kb = r / 16, nb = r % 16; cvt_item(INP(I_WSGUO) + (size_t)l * 512 * DM, DM, (bf16_t*)(F.ws + WS_WS) + (size_t)l * DM * DM, DM, kb * 64, nb * 64, nb * 64, scr, F.lane); }
        }
    }
    __syncthreads();
    {
        LAS float* red = (LAS float*)F.lds;
        LAS float* sil = (LAS float*)(F.lds + 8192);
        float* MOD = (float*)(F.ws + WS_MOD);
        for (int i = F.tid; i < 3 * DM; i += 512) { const int r = i >> 10, k = i & 1023; const float c = r < 2 ? INP(I_C)[r * DM + k] : INP(I_CCTX)[k]; sil[i] = c * sigmoidf_(c); }
        __syncthreads();
        for (int u = (F.G >= 256 ? (F.vcu < 128 ? F.vcu : DEPTH * 96) : F.vcu); u < DEPTH * 96; u += (F.G >= 256 ? 128 : F.G)) {
            const int l = u / 96, j0 = (u % 96) * 64;
            const float* wm = INP(I_WMOD) + (size_t)l * DM * 6144 + (size_t)(F.wave * 128) * 6144 + j0 + F.lane;
            float a0 = 0.f, a1 = 0.f, a2 = 0.f;
#pragma unroll 32
            for (int kk = 0; kk < 128; ++kk) {
                const float w = wm[(size_t)kk * 6144]; const int k = F.wave * 128 + kk;
                a0 += sil[k] * w; a1 += sil[1024 + k] * w; a2 += sil[2048 + k] * w;
            }
            red[(F.wave * 3 + 0) * 64 + F.lane] = a0; red[(F.wave * 3 + 1) * 64 + F.lane] = a1; red[(F.wave * 3 + 2) * 64 + F.lane] = a2;
            __syncthreads();
            if (F.tid < 192) { const int r = F.tid >> 6, j = F.tid & 63; float sacc = 0.f;
#pragma unroll
                for (int w = 0; w < 8; ++w) sacc += red[(w * 3 + r) * 64 + j];
                MOD[((size_t)l * 3 + r) * 6144 + j0 + j] = sacc + INP(I_BMOD)[(size_t)l * 6144 + j0 + j]; }
            __syncthreads();
        }
    }
    {
        bf16_t* T1 = (bf16_t*)(F.ws + WS_T1); bf16_t* T2 = (bf16_t*)(F.ws + WS_T2); bf16_t* TC = (bf16_t*)(F.ws + WS_TC); bf16_t* WSP = (bf16_t*)(F.ws + WS_WSP);
        const int gt = F.vcu * 512 + F.tid, NGT = F.G * 512;
        for (int i = gt; i < 64 * 256 * 128 / 2; i += NGT) {
            const int n2 = (2 * i) & 127, m = ((2 * i) >> 7) & 255, n1 = (2 * i) >> 15, k2 = m & 127, reim = m >> 7; float v[2];
#pragma unroll
            for (int q = 0; q < 2; ++q) { const int r = (k2 * (n1 + 64 * (n2 + q))) & 8191; float sn, cs; sincospif((float)r * (1.0f / 4096.0f), &sn, &cs); v[q] = (reim ? -sn : cs) * 0.08838834764831845f; }
            ((unsigned*)T1)[i] = cvt_pk_bf16(v[0], v[1]);
        }
        for (int i = gt; i < 128 * 128 / 2; i += NGT) {
            const int j0 = (2 * i) & 127, m = (2 * i) >> 7, ri = j0 >> 6, k1 = m & 63, ro = m >> 6; float v[2];
#pragma unroll
            for (int q = 0; q < 2; ++q) { const int n1 = (j0 + q) & 63; const int r = (k1 * n1) & 63; float sn, cs; sincospif((float)r * (1.0f / 32.0f), &sn, &cs); v[q] = ((ro == ri) ? cs : (ro == 0 ? sn : -sn)) * 0.125f; }
            ((unsigned*)T2)[i] = cvt_pk_bf16(v[0], v[1]);
        }
        for (int i = gt; i < 512 * 256 / 2; i += NGT) {
            const int n = (2 * i) & 255, m = (2 * i) >> 8, k = m & 255, reim = m >> 8; float v[2];
#pragma unroll
            for (int q = 0; q < 2; ++q) { const int r = (k * (n + q)) & 255; float sn, cs; sincospif((float)r * (1.0f / 128.0f), &sn, &cs); v[q] = (reim ? -sn : cs) * 0.0625f; }
            ((unsigned*)TC)[i] = cvt_pk_bf16(v[0], v[1]);
        }
        for (int i = gt; i < 128 * 32; i += NGT) { const int pos = i >> 5, f = i & 31; float sn, cs; sincosf((float)pos * exp2f(-(float)f * (13.287712379549449f / 32.0f)), &sn, &cs);
            ((float*)(F.ws + WS_ROPE))[i] = cs; ((float*)(F.ws + WS_ROPE))[4096 + i] = sn; }
        const float* wsp = INP(I_WSPAT);
        for (int i = gt; i < DEPTH * 4 * 128 * 128 / 2; i += NGT) { const f32x2 v = ((const f32x2*)wsp)[i]; ((unsigned*)WSP)[i] = cvt_pk_bf16(v.x, v.y); }
    }
    {
        LAS float* wt = (LAS float*)F.lds;
        LAS float* tb = (LAS float*)(F.lds + 32768);
        if (F.tid < 128) { float s, c; sincospif((float)F.tid * (1.0f / 64.0f), &s, &c); tb[F.tid] = c; tb[128 + F.tid] = s; }
        for (int u = (F.G >= 256 ? F.vcu - 128 : F.vcu); u < DEPTH * 4 * 16; u += F.G) {
            if (u < 0) continue;
            const int l = u / 64, g = (u / 16) & 3, d0 = (u & 15) * 64;
            __syncthreads();
            for (int i = F.tid; i < 128 * 64; i += 512) { const int m = i >> 6, d = i & 63; wt[i] = INP(I_WFOUR)[((size_t)l * 512 + g * 128 + m) * DM + d0 + d]; }
            __syncthreads();
            const int c = F.tid & 127, dq = F.tid >> 7;
            float ar[16], ai[16];
#pragma unroll
            for (int i = 0; i < 16; ++i) { ar[i] = 0.f; ai[i] = 0.f; }
            for (int m = 0; m < 128; ++m) {
                const int r = (m * c) & 127; const float cs = tb[r], sn = tb[128 + r];
#pragma unroll
                for (int i = 0; i < 16; ++i) { const float w = wt[m * 64 + dq * 16 + i]; ar[i] += cs * w; ai[i] += sn * w; }
            }
            bf16_t* W = (bf16_t*)(F.ws + WS_WFP) + (size_t)l * DM * DM;
            const bool oddc = (c & 1) != 0;
#pragma unroll
            for (int i = 0; i < 16; ++i) { const size_t rowo = (size_t)(d0 + dq * 16 + i) * DM;
                const float a = ar[i] * 0.08838834764831845f, b = ai[i] * 0.08838834764831845f; const float recv = sx<1>(oddc ? a : b);
                *(unsigned*)(W + rowo + (oddc ? 512 : 0) + g * 128 + (c & ~1)) = cvt_pk_bf16(oddc ? recv : a, oddc ? b : recv); }
        }
    }
}

constexpr int MOE_ITEMS = NEXP * (512 + 256);
__device__ __forceinline__ CvtDesc moe_cvt_desc(Frame& F, int l, int it) {
    CvtDesc d; const int e = it / 768; int r = it % 768;
    if (r < 512) { const int kb = r / 32, nb = r % 32;
        const int T = nb >> 2, half = (nb >> 1) & 1, i0 = (nb & 1) * 64;
        d.src = INP(I_WGU) + ((size_t)l * NEXP + e) * DM * 2048; d.ldS = 2048; d.dst = (unsigned char*)(F.ws + WS_WGU) + ((size_t)l * NEXP + e) * 2048 * DM; d.k0 = kb * 64; d.srccol0 = half * 1024 + T * 128 + i0; d.dstrow0 = nb * 64; }
    else { r -= 512; const int kb = r / 16, nb = r % 16;
        d.src = INP(I_WDN) + ((size_t)l * NEXP + e) * DM * DM; d.ldS = DM; d.dst = (unsigned char*)(F.ws + WS_WDN) + ((size_t)l * NEXP + e) * DM * DM; d.k0 = kb * 64; d.srccol0 = nb * 64; d.dstrow0 = nb * 64; }
    return d;
}
struct FillCur { int c0, c1;
    __device__ __forceinline__ int get(int l) const { return l == 0 ? c0 : c1; }
    __device__ __forceinline__ void add(int l, int n) { if (l == 0) c0 += n; else c1 += n; } };
__device__ __forceinline__ void fill_range(Frame& F, int lay, int lo, int hi, int widx, int nw) {
    LAS float* scr = (LAS float*)(F.lds + F.wave * 16640);
    int it = lo + widx; if (it >= hi) return;
    f32x4 va[16], vb[16]; CvtDesc da = moe_cvt_desc(F, lay, it), db = da;
    cvt_load(da, va, F.lane);
    for (;;) {
        const bool hb = it + nw < hi; if (hb) { db = moe_cvt_desc(F, lay, it + nw); cvt_load(db, vb, F.lane); }
        cvt_finish(da, va, scr, F.lane); if (!hb) break;
        const bool ha = it + 2 * nw < hi; if (ha) { da = moe_cvt_desc(F, lay, it + 2 * nw); cvt_load(da, va, F.lane); }
        cvt_finish(db, vb, scr, F.lane); if (!ha) break;
        it += 2 * nw;
    }
}
__device__ __forceinline__ void fill_after(Frame& F, FillCur& C, int lmin, int total, int c, int per_wave) {
    const int rem = total % F.G; if (rem == 0) return;
    const int n_idle = F.G - rem, nw = n_idle * 8; int budget = nw * per_wave;
    const bool idle = c >= rem; const int widx = (c - rem) * 8 + F.wave;
#pragma unroll
    for (int lay = 0; lay < DEPTH; ++lay) { if (lay < lmin) continue;
        const int cu = C.get(lay), take = (MOE_ITEMS - cu < budget) ? MOE_ITEMS - cu : budget;
        if (take > 0) { if (idle) fill_range(F, lay, cu, cu + take, widx, nw); C.add(lay, take); budget -= take; } }
}
__device__ __forceinline__ void fill_cleanup(Frame& F, FillCur& C, int lay) {
    const int cu = C.get(lay); if (cu < MOE_ITEMS) { fill_range(F, lay, cu, MOE_ITEMS, F.vcu * 8 + F.wave, F.G * 8); C.add(lay, MOE_ITEMS - cu); }
}

__device__ __forceinline__ void p_norm1(Frame& F, int l, int nrows) {
    const int gw = F.vcu * 8 + F.wave, NGW = F.G * 8;
    const float* MOD = (const float*)(F.ws + WS_MOD) + (size_t)l * 3 * 6144;
#define N1_SRC(r_) ((const f32x4*)((l == 0) ? ((r_) < NXR ? INP(I_X) + (size_t)(r_) * DM : INP(I_CTX) + (size_t)((r_) - NXR) * DM) : (const float*)(F.ws + WS_XW) + (size_t)(r_) * DM) + F.lane)
    f32x4 nv[4] = {};
    if (gw < nrows) { const f32x4* xr = N1_SRC(gw);
#pragma unroll
        for (int j = 0; j < 4; ++j) nv[j] = xr[64 * j]; }
    for (int row = gw; row < nrows; row += NGW) {
        f32x4 v[4]; float ss = 0.f;
#pragma unroll
        for (int j = 0; j < 4; ++j) v[j] = nv[j];
        if (row + NGW < nrows) { const f32x4* xr = N1_SRC(row + NGW);
#pragma unroll
            for (int j = 0; j < 4; ++j) nv[j] = xr[64 * j]; }
#pragma unroll
        for (int j = 0; j < 4; ++j) ss += (v[j].x * v[j].x + v[j].y * v[j].y) + (v[j].z * v[j].z + v[j].w * v[j].w);
        const float* md = MOD + (size_t)modrow_of(row) * 6144;
        f32x4 sh[4], sc[4];
#pragma unroll
        for (int j = 0; j < 4; ++j) { const int c = 4 * F.lane + 256 * j; sh[j] = *(const f32x4*)(md + c); sc[j] = *(const f32x4*)(md + 1024 + c); }
        const float rstd = rsqrtf(wave_sum(ss) * (1.f / DM) + EPS);
        unsigned* o = (unsigned*)((unsigned char*)(F.ws + WS_HX8) + (size_t)row * DM) + F.lane;
#pragma unroll
        for (int j = 0; j < 4; ++j) { const f32x4 h = v[j] * rstd * (sc[j] + 1.0f) + sh[j]; o[64 * j] = pk4_fp8(h.x, h.y, h.z, h.w); }
    }
#undef N1_SRC
}

struct SchedIn {
    const char* A; const char* B; int G, c, nxt_total, last;
    __device__ __forceinline__ bool next(int i, g8::Unit& u) const {
        const int L = i * G + c; if (L >= nxt_total) return false;
        int pm, pn;
        if (L < 64 * 24) g8::tile_order(L, 64, 24, pm, pn);
        else { const int r = L - 64 * 24; if (last) { pm = 64 + (r >> 1); pn = 4 + (r & 1); } else { pm = 64 + r / 24; pn = r % 24; } }
        u.A = A + (size_t)pm * 256 * 1024; u.B = B + (size_t)pn * 256 * 1024; u.nt = 8; u.pm = pm; u.pn = pn; u.aux = 0; return true;
    }
};
struct EpiIn {
    static constexpr bool PERM = true; static constexpr int NAUX = 0;
    bf16_t* PX; bf16_t* GT; const float* bgate;
    __device__ __forceinline__ bool operator()(f32x4 (&acc)[2][2][4][2], const g8::Unit& u, int wr, int wc, int fr, int fq, const LAS float* aux) const {
        const int row0 = u.pm * 256 + wr * 64 + fr; const bool gates = u.pn >= 12;
        bf16_t* base = gates ? GT : PX; const int colt = (gates ? u.pn - 12 : u.pn) * 256, col0 = colt + wc * 32 + 8 * fq;
        f32x4 bv[2][2];
#pragma unroll
        for (int bj = 0; bj < 2; ++bj)
#pragma unroll
            for (int n = 0; n < 2; ++n) bv[bj][n] = gates ? *(const f32x4*)(bgate + col0 + bj * 128 + 4 * n) : (f32x4){0.f, 0.f, 0.f, 0.f};
#pragma unroll
        for (int ai = 0; ai < 2; ++ai)
#pragma unroll
            for (int m = 0; m < 4; ++m) { bf16_t* rowp = base + (size_t)(row0 + ai * 128 + m * 16) * 3072 + col0;
#pragma unroll
                for (int bj = 0; bj < 2; ++bj) { f32x4 v0 = acc[ai][bj][m][0] * 0.015625f + bv[bj][0], v1 = acc[ai][bj][m][1] * 0.015625f + bv[bj][1];
                    if (gates) {
#pragma unroll
                        for (int j = 0; j < 4; ++j) { v0[j] = sigmoidf_(v0[j]); v1[j] = sigmoidf_(v1[j]); } }
                    u32x4 w; w.x = cvt_pk_bf16(v0[0], v0[1]); w.y = cvt_pk_bf16(v0[2], v0[3]); w.z = cvt_pk_bf16(v1[0], v1[1]); w.w = cvt_pk_bf16(v1[2], v1[3]);
                    *(u32x4*)(rowp + bj * 128) = w; } }
        return false;
    }
};

__device__ __forceinline__ void p_postproj(Frame& F, int l, int nrows) {
    const int gw = F.vcu * 8 + F.wave, NGW = F.G * 8, L = F.lane, hs = L >> 4, j = L & 15;
    const bf16_t* PX = (const bf16_t*)(F.ws + WS_PX);
    const float* qg = INP(I_QGAIN) + l * 128 + 8 * j; const float* kg = INP(I_KGAIN) + l * 128 + 8 * j; const float* sg = INP(I_SGUGAIN) + l * 512 + hs * 128 + 8 * j;
    float qgv[8], kgv[8], sgv[8];
#pragma unroll
    for (int i = 0; i < 8; ++i) { qgv[i] = qg[i]; kgv[i] = kg[i]; sgv[i] = sg[i]; }
    const int ax = j >> 3, half = (j >> 2) & 1, f0 = 8 * (j & 3);
    const float* RC = (const float*)(F.ws + WS_ROPE);
#define PP_LOAD(r_, a0, a1, a2, a3) do { const bf16_t* p_ = PX + (size_t)(r_) * PXW; a0 = *(const u32x4*)(p_ + hs * 128 + 8 * j); a1 = *(const u32x4*)(p_ + (4 + hs) * 128 + 8 * j); \
        if (hs < 2) a2 = *(const u32x4*)(p_ + K_OFF + hs * 128 + 8 * j);   a3 = *(const u32x4*)(p_ + VG_OFF + hs * 128 + 8 * j); } while (0)
#define PP_RC(r_) do { const bool isx_ = (r_) < NXR; const int s_ = isx_ ? ((r_) & 8191) : (((r_) - NXR) & 255); const int pos_ = isx_ ? (ax ? (s_ & 63) : (s_ >> 6)) : 0; \
        nc0 = *(const f32x4*)(RC + pos_ * 32 + f0); nc1 = *(const f32x4*)(RC + pos_ * 32 + f0 + 4); ns0 = *(const f32x4*)(RC + 4096 + pos_ * 32 + f0); ns1 = *(const f32x4*)(RC + 4096 + pos_ * 32 + f0 + 4); } while (0)
    u32x4 nq0 = {}, nq1 = {}, nkv = {}, nvg = {}; f32x4 nc0 = {}, nc1 = {}, ns0 = {}, ns1 = {};
    if (gw < nrows) { PP_LOAD(gw, nq0, nq1, nkv, nvg); PP_RC(gw); }
    for (int row = gw; row < nrows; row += NGW) {
        const bool isx = row < NXR; const int b = isx ? (row >> 13) : ((row - NXR) >> 8), s = isx ? (row & 8191) : ((row - NXR) & 255);
        const int pos = isx ? (ax ? (s & 63) : (s >> 6)) : 0;
        float cs[8], sn[8];
        { const f32x4 c0 = nc0, c1 = nc1, s0 = ns0, s1 = ns1; (void)pos;
#pragma unroll
          for (int i = 0; i < 4; ++i) { cs[i] = c0[i]; cs[4 + i] = c1[i]; sn[i] = half ? s0[i] : -s0[i]; sn[4 + i] = half ? s1[i] : -s1[i]; } }
        const bf16_t* pr = PX + (size_t)row * PXW;
        const size_t krow = (size_t)b * LK + (isx ? s : SEQ + s);
        const u32x4 wq0 = nq0, wq1 = nq1, wkv = nkv, wvg = nvg; (void)pr;
        if (row + NGW < nrows) { PP_LOAD(row + NGW, nq0, nq1, nkv, nvg); PP_RC(row + NGW); }
#pragma unroll
        for (int p = 0; p < 4; ++p) {
            const u32x4 w = p == 0 ? wq0 : p == 1 ? wq1 : p == 2 ? wkv : wvg;
            float v[8] = {bf_lo(w.x), bf_hi(w.x), bf_lo(w.y), bf_hi(w.y), bf_lo(w.z), bf_hi(w.z), bf_lo(w.w), bf_hi(w.w)};
            if (p == 3) {
#pragma unroll
                for (int i = 0; i < 8; ++i) v[i] = gelu_tanh(v[i]); }
            float ss = 0.f;
#pragma unroll
            for (int i = 0; i < 8; ++i) ss += v[i] * v[i];
            ss += sx<1>(ss); ss += sx<2>(ss); ss += sx<4>(ss); ss += sx<8>(ss);
            const float rstd = rsqrtf(ss * (1.f / 128.f) + EPS);
            const bool plain = (p == 2 && hs >= 2);
            const bool rope = isx && (p < 2 || (p == 2 && hs < 2));
            float o[8];
#pragma unroll
            for (int i = 0; i < 8; ++i) { const float gn = p < 2 ? qgv[i] : p == 2 ? kgv[i] : sgv[i]; o[i] = v[i] * rstd * gn; }
            if (p < 3) {
#pragma unroll
                for (int i = 0; i < 8; ++i) { const float pa = sx<4>(o[i]); if (rope) o[i] = o[i] * cs[i] + pa * sn[i]; } }
            const bool f8 = p < 2 || (p == 2 && hs < 2);
            const float qs = p < 2 ? att::SCALE * 1.4426950408889634f : 1.f;
            u32x2 q8; q8.x = pk4_fp8(o[0] * qs, o[1] * qs, o[2] * qs, o[3] * qs); q8.y = pk4_fp8(o[4] * qs, o[5] * qs, o[6] * qs, o[7] * qs);
            u32x4 q; q.x = plain ? w.x : cvt_pk_bf16(o[0], o[1]); q.y = plain ? w.y : cvt_pk_bf16(o[2], o[3]); q.z = plain ? w.z : cvt_pk_bf16(o[4], o[5]); q.w = plain ? w.w : cvt_pk_bf16(o[6], o[7]);
            if (f8) { unsigned char* d8 = p == 0 ? (unsigned char*)(F.ws + WS_QN) + (size_t)row * DM + hs * 128 : p == 1 ? (unsigned char*)(F.ws + WS_QN) + (size_t)row * DM + (4 + hs) * 128
                                         : (unsigned char*)(F.ws + WS_KN) + krow * 256 + hs * 128;
                *(u32x2*)(d8 + 8 * j) = q8; }
            else if (p == 3) *(u32x4*)((bf16_t*)(F.ws + WS_VGN) + (size_t)row * 512 + hs * 128 + 8 * j) = q;
        }
    }
#undef PP_LOAD
#undef PP_RC
}

__device__ __forceinline__ void p_vblocks(Frame& F) {
    LAS unsigned char* T = F.lds;
    const bf16_t* PX = (const bf16_t*)(F.ws + WS_PX);
    const int key = F.tid >> 3, pc = F.tid & 7, w = key & 31, pos = 32 * ((w >> 2) & 1) + 16 * (key >> 5) + (w & 3) + 4 * (w >> 3);
#define VB_LOAD(u_, A, C) do { const int t_ = (u_) % 132, kvh_ = ((u_) / 132) & 1, b_ = (u_) / 264; \
        const size_t row_ = t_ < 128 ? (size_t)b_ * SEQ + 64 * t_ + key : (size_t)NXR + b_ * CTX + 64 * (t_ - 128) + key; \
        const u32x4* src_ = (const u32x4*)(PX + row_ * PXW + V_OFF + kvh_ * 128 + 16 * pc); A = src_[0]; C = src_[1]; } while (0)
    u32x4 na = {}, nc = {};
    if (F.vcu < NB * 2 * 132) VB_LOAD(F.vcu, na, nc);
    for (int u = F.vcu; u < NB * 2 * 132; u += F.G) {
        const u32x4 a = na, c = nc;
        const unsigned q0 = pk4_fp8(bf_lo(a.x), bf_hi(a.x), bf_lo(a.y), bf_hi(a.y)), q1 = pk4_fp8(bf_lo(a.z), bf_hi(a.z), bf_lo(a.w), bf_hi(a.w));
        const unsigned q2 = pk4_fp8(bf_lo(c.x), bf_hi(c.x), bf_lo(c.y), bf_hi(c.y)), q3 = pk4_fp8(bf_lo(c.z), bf_hi(c.z), bf_lo(c.w), bf_hi(c.w));
        __syncthreads();
#pragma unroll
        for (int i = 0; i < 4; ++i) { T[(16 * pc + i) * 64 + pos] = (unsigned char)(q0 >> (8 * i)); T[(16 * pc + 4 + i) * 64 + pos] = (unsigned char)(q1 >> (8 * i));
            T[(16 * pc + 8 + i) * 64 + pos] = (unsigned char)(q2 >> (8 * i)); T[(16 * pc + 12 + i) * 64 + pos] = (unsigned char)(q3 >> (8 * i)); }
        __syncthreads();
        if (u + F.G < NB * 2 * 132) VB_LOAD(u + F.G, na, nc);
        *(u32x4*)((unsigned char*)(F.ws + WS_VN) + (size_t)u * 8192 + F.tid * 16) = *(const LAS u32x4*)(T + F.tid * 16);
    }
#undef VB_LOAD
    __syncthreads();
}

template <int M, int K, class Epi>
__device__ __forceinline__ void lm_unit(Frame& F, const bf16_t* __restrict__ Wm, const bf16_t* __restrict__ in, size_t in_stride, const Epi& E) {
    constexpr int NTL = K / 64;
    constexpr bool HOIST = (M / 32 == 8) && NTL <= 2;
    const int r32 = F.lane & 31, hi = F.lane >> 5;
    bf16x8 pw[NTL][4];
    __syncthreads();
    {
        const int sr = F.tid >> 4, sc = (F.tid & 15) * 8, vst0 = att::v_st(sr, sc), vst1 = att::v_st(32 + sr, sc);
        bf16x8 t0[NTL], t1[NTL];
#pragma unroll
        for (int t = 0; t < NTL; ++t) { t0[t] = *(const bf16x8*)(in + (size_t)(t * 64 + sr) * in_stride + sc); t1[t] = *(const bf16x8*)(in + (size_t)(t * 64 + 32 + sr) * in_stride + sc); }
        if constexpr (HOIST) { const bf16_t* wrow = Wm + (size_t)(F.wave * 32 + r32) * K + hi * 8;
#pragma unroll
            for (int t = 0; t < NTL; ++t)
#pragma unroll
                for (int i = 0; i < 4; ++i) pw[t][i] = *(const bf16x8*)(wrow + t * 64 + 16 * i); }
#pragma unroll
        for (int t = 0; t < NTL; ++t) { *(LAS bf16x8*)(F.lds + t * 16384 + vst0) = t0[t]; *(LAS bf16x8*)(F.lds + t * 16384 + vst1) = t1[t]; }
    }
    __syncthreads();
    const int vb0 = (int)(unsigned)(uintptr_t)F.lds + att::v_rd_base(F.lane);
    for (int rb = F.wave; rb < M / 32; rb += 8) {
        f32x16 o[4] = {};
        const bf16_t* wrow = Wm + (size_t)(rb * 32 + r32) * K + hi * 8;
#pragma unroll
        for (int t = 0; t < NTL; ++t) {
            if constexpr (HOIST) att::pv_d0(o, vb0 + t * 16384, pw[t][0], pw[t][1], pw[t][2], pw[t][3]);
            else { const bf16x8 pa0 = *(const bf16x8*)(wrow + t * 64), pa1 = *(const bf16x8*)(wrow + t * 64 + 16), pa2 = *(const bf16x8*)(wrow + t * 64 + 32), pa3 = *(const bf16x8*)(wrow + t * 64 + 48);
                att::pv_d0(o, vb0 + t * 16384, pa0, pa1, pa2, pa3); }
        }
        if constexpr (HOIST) { const float one[16] = {};
            att::wave_rows_out<false>(F.lds + 65536 + F.wave * 8192, o, one, F.lane, [&](int row, int col8, u32x4 v) { E.rows(rb * 32 + row, col8, v); }); }
        else {
        const bool odd = (F.lane & 1) != 0;
#pragma unroll
        for (int r = 0; r < 16; ++r) { const int row = rb * 32 + att::crow(r, hi);
#pragma unroll
            for (int dp = 0; dp < 4; dp += 2) {
                const float recv = sx<1>(odd ? o[dp][r] : o[dp + 1][r]);
                E(row, odd ? (dp + 1) * 32 + r32 - 1 : dp * 32 + r32, odd ? recv : o[dp][r], odd ? o[dp + 1][r] : recv); } }
        }
    }
}
template <class EpiA, class EpiB>
__device__ __forceinline__ void lm_unit_pair(Frame& F, const bf16_t* __restrict__ WmA, const bf16_t* __restrict__ inA, const EpiA& EA, const bf16_t* __restrict__ WmB, const bf16_t* __restrict__ inB, const EpiB& EB, size_t in_stride, bool hasB) {
    const int r32 = F.lane & 31, hi = F.lane >> 5;
    bf16x8 pw[2][4];
    __syncthreads();
    {
        const int sr = F.tid >> 4, sc = (F.tid & 15) * 8, vst0 = att::v_st(sr, sc), vst1 = att::v_st(32 + sr, sc);
        bf16x8 t0[4], t1[4];
#pragma unroll
        for (int t = 0; t < 4; ++t) { const bf16_t* in = (t < 2 || !hasB) ? inA : inB; const int tt = t & 1;
            t0[t] = *(const bf16x8*)(in + (size_t)(tt * 64 + sr) * in_stride + sc); t1[t] = *(const bf16x8*)(in + (size_t)(tt * 64 + 32 + sr) * in_stride + sc); }
        { const bf16_t* wrow = ((F.wave >> 2) ? WmB : WmA) + (size_t)((F.wave & 3) * 32 + r32) * 128 + hi * 8;
#pragma unroll
            for (int t = 0; t < 2; ++t)
#pragma unroll
                for (int i = 0; i < 4; ++i) pw[t][i] = *(const bf16x8*)(wrow + t * 64 + 16 * i); }
#pragma unroll
        for (int t = 0; t < 4; ++t) { *(LAS bf16x8*)(F.lds + t * 16384 + vst0) = t0[t]; *(LAS bf16x8*)(F.lds + t * 16384 + vst1) = t1[t]; }
    }
    __syncthreads();
    const int pb = F.wave >> 2, rb = F.wave & 3;
    if (pb == 0 || hasB) {
        const int vb0 = (int)(unsigned)(uintptr_t)F.lds + att::v_rd_base(F.lane) + pb * 32768;
        f32x16 o[4] = {};
#pragma unroll
        for (int t = 0; t < 2; ++t) att::pv_d0(o, vb0 + t * 16384, pw[t][0], pw[t][1], pw[t][2], pw[t][3]);
        const bool odd = (F.lane & 1) != 0;
#pragma unroll
        for (int r = 0; r < 16; ++r) { const int row = rb * 32 + att::crow(r, hi);
#pragma unroll
            for (int dp = 0; dp < 4; dp += 2) {
                const float recv = sx<1>(odd ? o[dp][r] : o[dp + 1][r]);
                const int col = odd ? (dp + 1) * 32 + r32 - 1 : dp * 32 + r32; const float v0 = odd ? recv : o[dp][r], v1 = odd ? o[dp + 1][r] : recv;
                if (pb == 0) EA(row, col, v0, v1); else EB(row, col, v0, v1); } }
    }
}
__device__ __forceinline__ unsigned lm_dma_lane_off(int wave, int lane, int i, unsigned in_stride) {
    const int g = wave * 128 + i * 64 + lane, blk = g >> 5, within = g & 31, kk = (blk >> 2) * 8 + (within >> 2), c = (blk & 3) * 32 + (within & 3) * 8;
    const int k = (kk & ~0xC) | ((kk & 4) << 1) | ((kk & 8) >> 1);
    return ((unsigned)k * in_stride + (unsigned)c) * 2u;
}
__device__ __forceinline__ void lm_dma_pair(Frame& F, const bf16_t* inA, const bf16_t* inB, unsigned in_stride, int bufoff, unsigned lo0, unsigned lo1) {
#pragma unroll
    for (int t = 0; t < 4; ++t) { const char* base = (const char*)((t < 2 ? inA : inB) + (size_t)((t & 1) * 64) * in_stride);
        unsigned a0 = lo0, a1 = lo1; asm volatile("" : "+v"(a0), "+v"(a1));
        __builtin_amdgcn_global_load_lds((const unsigned*)(base + a0), (LAS unsigned*)(F.lds + bufoff + t * 16384 + F.wave * 2048), 16, 0, 0);
        __builtin_amdgcn_global_load_lds((const unsigned*)(base + a1), (LAS unsigned*)(F.lds + bufoff + t * 16384 + F.wave * 2048 + 1024), 16, 0, 0); }
}
template <class Epi>
__device__ __forceinline__ void lm_pair_compute(Frame& F, const bf16x8 (&pw)[2][4], int bufoff, const Epi& E) {
    const int r32 = F.lane & 31, hi = F.lane >> 5, pb = F.wave >> 2, rb = F.wave & 3;
    const int vb0 = (int)(unsigned)(uintptr_t)F.lds + bufoff + att::v_rd_base(F.lane) + pb * 32768;
    f32x16 o[4] = {};
#pragma unroll
    for (int t = 0; t < 2; ++t) att::pv_d0(o, vb0 + t * 16384, pw[t][0], pw[t][1], pw[t][2], pw[t][3]);
    __syncthreads();
    const float one[16] = {};
    att::wave_rows_out<false>(F.lds + bufoff + F.wave * 8192, o, one, F.lane, [&](int row, int col8, u32x4 v) { E.rows(rb * 32 + row, col8, v); });
    (void)r32; (void)hi;
}
__device__ __forceinline__ void lm_load_w(Frame& F, bf16x8 (&pw)[2][4], const bf16_t* Wm) {
    const bf16_t* wrow = Wm + (size_t)((F.wave & 3) * 32 + (F.lane & 31)) * 128 + (F.lane >> 5) * 8;
#pragma unroll
    for (int t = 0; t < 2; ++t)
#pragma unroll
        for (int i = 0; i < 4; ++i) pw[t][i] = *(const bf16x8*)(wrow + t * 64 + 16 * i);
}
struct EpiStore2 {
    bf16_t* base; int Mh; size_t s1, s2;
    __device__ __forceinline__ void operator()(int m, int col, float v0, float v1) const {
        const int hi = m >= Mh ? 1 : 0, lo = m - hi * Mh;
        *(unsigned*)(base + (size_t)lo * s1 + (size_t)hi * s2 + col) = cvt_pk_bf16(v0, v1);
    }
    __device__ __forceinline__ void rows(int m, int col8, u32x4 v) const {
        const int hi = m >= Mh ? 1 : 0, lo = m - hi * Mh; *(u32x4*)(base + (size_t)lo * s1 + (size_t)hi * s2 + col8) = v;
    }
};
struct EpiSgu {
    bf16_t* sg; const bf16_t* u; const float* bs;
    __device__ __forceinline__ void operator()(int m, int col, float v0, float v1) const {
        const unsigned w = *(const unsigned*)(u + (size_t)m * PXW + col); const float b = bs[m];
        *(unsigned*)(sg + (size_t)m * DM + col) = cvt_pk_bf16((v0 + b) * gelu_tanh(bf_lo(w)), (v1 + b) * gelu_tanh(bf_hi(w)));
    }
    __device__ __forceinline__ void pre(int rbase, int lane, u32x4 (&uw)[8], float (&ub)[8]) const {
#pragma unroll
        for (int i = 0; i < 8; ++i) { const int m = rbase + 4 * i + (lane >> 4); uw[i] = *(const u32x4*)(u + (size_t)m * PXW + (lane & 15) * 8); ub[i] = bs[m]; }
    }
    __device__ __forceinline__ void rows2(int m, int col8, u32x4 v, u32x4 w, float b) const {
        u32x4 r;
        r.x = cvt_pk_bf16((bf_lo(v.x) + b) * gelu_tanh(bf_lo(w.x)), (bf_hi(v.x) + b) * gelu_tanh(bf_hi(w.x))); r.y = cvt_pk_bf16((bf_lo(v.y) + b) * gelu_tanh(bf_lo(w.y)), (bf_hi(v.y) + b) * gelu_tanh(bf_hi(w.y)));
        r.z = cvt_pk_bf16((bf_lo(v.z) + b) * gelu_tanh(bf_lo(w.z)), (bf_hi(v.z) + b) * gelu_tanh(bf_hi(w.z))); r.w = cvt_pk_bf16((bf_lo(v.w) + b) * gelu_tanh(bf_lo(w.w)), (bf_hi(v.w) + b) * gelu_tanh(bf_hi(w.w)));
        *(u32x4*)(sg + (size_t)m * DM + col8) = r;
    }
    __device__ __forceinline__ void rows(int m, int col8, u32x4 v) const {
        const u32x4 w = *(const u32x4*)(u + (size_t)m * PXW + col8); const float b = bs[m]; u32x4 r;
        r.x = cvt_pk_bf16((bf_lo(v.x) + b) * gelu_tanh(bf_lo(w.x)), (bf_hi(v.x) + b) * gelu_tanh(bf_hi(w.x))); r.y = cvt_pk_bf16((bf_lo(v.y) + b) * gelu_tanh(bf_lo(w.y)), (bf_hi(v.y) + b) * gelu_tanh(bf_hi(w.y)));
        r.z = cvt_pk_bf16((bf_lo(v.z) + b) * gelu_tanh(bf_lo(w.z)), (bf_hi(v.z) + b) * gelu_tanh(bf_hi(w.z))); r.w = cvt_pk_bf16((bf_lo(v.w) + b) * gelu_tanh(bf_lo(w.w)), (bf_hi(v.w) + b) * gelu_tanh(bf_hi(w.w)));
        *(u32x4*)(sg + (size_t)m * DM + col8) = r;
    }
};

constexpr int RT_R = 22, RT_P = 23;
__device__ __forceinline__ void p_route(Frame& F, int l, int nrows, int cbank = 0) {
    LAS float* hsT = (LAS float*)F.lds;
    LAS float* part = (LAS float*)(F.lds + 98304);
    LAS float* lgs = (LAS float*)(F.lds + 122880);
    LAS float* tval = (LAS float*)(F.lds + 122880 + 3072);
    LAS int* tk_e = (LAS int*)(F.lds + LDS_X_OFF);
    LAS float* tk_w = (LAS float*)(F.lds + LDS_X_OFF + 2048);
    LAS int* wcnt = (LAS int*)(F.lds + LDS_X_OFF + 4096);
    LAS int* ebase = (LAS int*)(F.lds + LDS_X_OFF + 4096 + 1024);
    const int chunk = (nrows + F.G - 1) / F.G;
    const int rA = F.vcu * chunk, rB = (rA + chunk < nrows) ? rA + chunk : nrows;
    const int e = F.lane & 31, kh = F.lane >> 5;
    float wreg[64];
    { const float* wr = INP(I_WROUTER) + (size_t)l * DM * NEXP + e;
#pragma unroll
      for (int m = 0; m < 64; ++m) { const int sidx = 128 * F.wave + 2 * m + kh; wreg[m] = wr[(size_t)(4 * (sidx & 255) + (sidx >> 8)) * NEXP]; } }
    const float* MOD = (const float*)(F.ws + WS_MOD) + (size_t)l * 3 * 6144;
    const float* XW = (const float*)(F.ws + WS_XW);
    __syncthreads();
    f32x4 v[3][4] = {};
#define RT_ROWS(r0_) do { const int nr_ = ((r0_) + RT_R < rB) ? RT_R : rB - (r0_); _Pragma("unroll") for (int t = 0; t < 3; ++t) { const int rr = F.wave + 8 * t; if (rr < nr_) { \
        const f32x4* xr = (const f32x4*)(XW + (size_t)((r0_) + rr) * DM) + F.lane; _Pragma("unroll") for (int j = 0; j < 4; ++j) v[t][j] = xr[64 * j]; } } } while (0)
    if (rA < rB) RT_ROWS(rA);
    for (int r0 = rA; r0 < rB; r0 += RT_R) {
        const int nr = (r0 + RT_R < rB) ? RT_R : rB - r0;
        {
#pragma unroll
            for (int t = 0; t < 3; ++t) { const int rr = F.wave + 8 * t;
              if (rr < nr) { const int row = r0 + rr; float ss = 0.f;
                const float* md = MOD + (size_t)modrow_of(row) * 6144;
                f32x4 sh[4], sc[4];
#pragma unroll
                for (int j = 0; j < 4; ++j) { const int c = 4 * F.lane + 256 * j; sh[j] = *(const f32x4*)(md + 3072 + c); sc[j] = *(const f32x4*)(md + 4096 + c); }
#pragma unroll
                for (int j = 0; j < 4; ++j) ss += (v[t][j].x * v[t][j].x + v[t][j].y * v[t][j].y) + (v[t][j].z * v[t][j].z + v[t][j].w * v[t][j].w);
                const float rstd = rsqrtf(wave_sum(ss) * (1.f / DM) + EPS);
                unsigned* o = (unsigned*)((unsigned char*)(F.ws + WS_HX) + (size_t)row * DM) + F.lane;
#pragma unroll
                for (int j = 0; j < 4; ++j) {
                    const f32x4 h = v[t][j] * rstd * (sc[j] + 1.0f) + sh[j]; o[64 * j] = pk4_fp8(h.x, h.y, h.z, h.w);
                    LAS float* d = hsT + (F.lane + 64 * j) * RT_P + rr;
                    d[0] = h.x; d[256 * RT_P] = h.y; d[512 * RT_P] = h.z; d[768 * RT_P] = h.w; } } }
            if (r0 + RT_R < rB) RT_ROWS(r0 + RT_R);
        }
        __syncthreads();
        {
            f32x16 D = {};
            const LAS float* hp = hsT + (128 * F.wave + kh) * RT_P + e;
#pragma unroll
            for (int m0 = 0; m0 < 64; m0 += 8) { float av[8];
#pragma unroll
                for (int q = 0; q < 8; ++q) av[q] = hp[(2 * (m0 + q)) * RT_P];
#pragma unroll
                for (int q = 0; q < 8; ++q) D = __builtin_amdgcn_mfma_f32_32x32x2f32(av[q], wreg[m0 + q], D, 0, 0, 0); }
#pragma unroll
            for (int r = 0; r < 16; ++r) { const int row = (r & 3) + 8 * (r >> 2) + 4 * kh; if (row < nr) part[(row * 8 + F.wave) * 32 + e] = D[r]; }
        }
        __syncthreads();
        for (int i = F.tid; i < nr * 32; i += 512) { const int r = i >> 5, ee = i & 31; float sacc = INP(I_BROUTER)[l * NEXP + ee];
#pragma unroll
            for (int w = 0; w < 8; ++w) sacc += part[(r * 8 + w) * 32 + ee];
            lgs[i] = sacc; }
        __syncthreads();
        for (int i = F.tid; i < nr * 32; i += 512) { const int r = i >> 5, ee = i & 31; const float mine = lgs[i]; int rank = 0;
#pragma unroll
            for (int q = 0; q < 8; ++q) { const f32x4 o4 = *(const LAS f32x4*)(lgs + r * 32 + 4 * q);
                rank += (o4.x > mine || (o4.x == mine && 4 * q + 0 < ee)) ? 1 : 0; rank += (o4.y > mine || (o4.y == mine && 4 * q + 1 < ee)) ? 1 : 0;
                rank += (o4.z > mine || (o4.z == mine && 4 * q + 2 < ee)) ? 1 : 0; rank += (o4.w > mine || (o4.w == mine && 4 * q + 3 < ee)) ? 1 : 0; }
            if (rank < 4) { tk_e[(r0 - rA + r) * 4 + rank] = ee; tval[r * 4 + rank] = mine; } }
        __syncthreads();
        for (int i = F.tid; i < nr * 4; i += 512) { const int r = i >> 2; const f32x4 t4 = *(const LAS f32x4*)(tval + r * 4);
            const float e1 = __expf(t4.y - t4.x), e2 = __expf(t4.z - t4.x), e3 = __expf(t4.w - t4.x), inv = __builtin_amdgcn_rcpf(1.0f + e1 + e2 + e3); const int k = i & 3;
            tk_w[(r0 - rA) * 4 + i] = (k == 0 ? 1.0f : k == 1 ? e1 : k == 2 ? e2 : e3) * inv; }
        __syncthreads();
    }
#undef RT_ROWS
    const int nent = (rB > rA ? rB - rA : 0) * 4;
    const int myent = F.tid < nent ? tk_e[F.tid] : -1; int rank_w = 0;
#pragma unroll 4
    for (int ee = 0; ee < 32; ++ee) { const unsigned long long m = __ballot(myent == ee); if (myent == ee) rank_w = __popcll(m & ((1ull << F.lane) - 1ull)); if (F.lane == 0) wcnt[F.wave * 32 + ee] = __popcll(m); }
    __syncthreads();
    if (F.tid < 32) { int c = 0;
#pragma unroll
        for (int w = 0; w < 8; ++w) { const int t = wcnt[w * 32 + F.tid]; wcnt[w * 32 + F.tid] = c; c += t; }
        unsigned* cnt = (unsigned*)(F.ws + WS_CTL) + CW_CNT + cbank * 4096 + l * 64 + F.tid;
        ebase[F.tid] = c ? (int)__hip_atomic_fetch_add(cnt, (unsigned)c, __ATOMIC_RELAXED, __HIP_MEMORY_SCOPE_AGENT) : 0; }
    __syncthreads();
    LAS int* tk_pos = (LAS int*)(F.lds + LDS_X_OFF + 5632);
    if (F.tid < nent) { const int pos = ebase[myent] + wcnt[F.wave * 32 + myent] + rank_w; const size_t gi = (size_t)rA * 4 + F.tid;
        ((unsigned*)(F.ws + WS_TSLOT))[gi] = ((unsigned)myent << 16) | (unsigned)pos; ((float*)(F.ws + WS_TW))[gi] = tk_w[F.tid]; tk_pos[F.tid] = pos; }
    asm volatile("s_waitcnt vmcnt(0)" ::: "memory");
    __syncthreads();
    {
        u32x4 v[4] = {}; size_t dst[4] = {};
#define RC_LOAD(i0_) _Pragma("unroll") for (int q = 0; q < 4; ++q) { const int i = (i0_) + 8 * q; const bool ok = i < nent; const int ii = ok ? i : (i0_); \
            dst[q] = (size_t)tk_e[ii] * CAPR + tk_pos[ii]; v[q] = ((const u32x4*)((const unsigned char*)(F.ws + WS_HX) + (size_t)(rA + (ii >> 2)) * DM))[F.lane]; }
        if (F.wave < nent) { RC_LOAD(F.wave) }
        for (int i0 = F.wave; i0 < nent; i0 += 32) {
            u32x4 cv[4]; size_t cd[4];
#pragma unroll
            for (int q = 0; q < 4; ++q) { cv[q] = v[q]; cd[q] = dst[q]; }
            if (i0 + 32 < nent) { RC_LOAD(i0 + 32) }
#pragma unroll
            for (int q = 0; q < 4; ++q) { const int i = i0 + 8 * q; if (i < nent) {
                ((u32x4*)((unsigned char*)(F.ws + WS_HXS) + cd[q] * DM))[F.lane] = cv[q];
                if (F.lane == 0) ((float*)(F.ws + WS_WSLOT))[cd[q]] = tk_w[i]; } }
        }
#undef RC_LOAD
    }
    __syncthreads();
}

__device__ __forceinline__ void moe_tables(Frame& F, int l) {
    LAS int* cum = (LAS int*)(F.lds + LDS_X_OFF + 8192); LAS int* texp = (LAS int*)(F.lds + LDS_X_OFF + 8192 + 256); LAS int* ntl = (LAS int*)(F.lds + LDS_X_OFF + 8192 + 256 + 1280);
    __syncthreads();
    if (F.tid < NEXP) { const unsigned* cnt = (const unsigned*)(F.ws + WS_CTL) + CW_CNT + l * 64;
        ntl[F.tid] = ((int)__hip_atomic_load(cnt + F.tid, __ATOMIC_RELAXED, __HIP_MEMORY_SCOPE_AGENT) + 255) >> 8; }
    __syncthreads();
    if (F.tid < NEXP) { int t = 0; for (int e = 0; e < F.tid; ++e) t += ntl[e]; const int n = ntl[F.tid];
        cum[F.tid] = t; if (F.tid == NEXP - 1) cum[NEXP] = t + n;
        for (int i = 0; i < n; ++i) texp[t + i] = F.tid; }
    __syncthreads();
}
__device__ __forceinline__ void p_scatter(Frame& F, int nrows) {
    const LAS int* cum = (const LAS int*)(F.lds + LDS_X_OFF + 8192);
    const int gw = F.vcu * 8 + F.wave, NGW = F.G * 8, nent = nrows * 4;
    for (int i0 = gw * 4; i0 < nent; i0 += NGW * 4) {
        const int row = i0 >> 2;
        const u32x4 ts = *(const u32x4*)((const unsigned*)(F.ws + WS_TSLOT) + i0);
        const f32x4 tw = *(const f32x4*)((const float*)(F.ws + WS_TW) + i0);
        const u32x4 o = ((const u32x4*)((const unsigned char*)(F.ws + WS_HX) + (size_t)row * DM))[F.lane];
#pragma unroll
        for (int k = 0; k < 4; ++k) { const unsigned t = ts[k]; const int slot = cum[t >> 16] * 256 + (int)(t & 0xffff);
            ((u32x4*)((unsigned char*)(F.ws + WS_HXS) + (size_t)slot * DM))[F.lane] = o;
            if (F.lane == 0) ((float*)(F.ws + WS_WSLOT))[slot] = tw[k]; }
    }
}
struct SchedMoe {
    const char* A; const char* B; size_t bstride; int G, c, ncol, total; const LAS int* texp; const LAS int* cum; size_t acap;
    __device__ __forceinline__ bool next(int i, g8::Unit& u) const {
        const int L = i * G + c; if (L >= total) return false;
        const int gt = L / ncol, pn = L % ncol; const int e = __builtin_amdgcn_readfirstlane(texp[gt]);
        const size_t arow = acap ? (size_t)e * acap + (size_t)(gt - __builtin_amdgcn_readfirstlane(cum[e])) * 256 : (size_t)gt * 256;
        u.A = A + arow * 1024; u.B = B + (size_t)e * bstride + (size_t)pn * 256 * 1024; u.nt = 8; u.pm = gt; u.pn = pn; u.aux = e; return true;
    }
};
struct EpiUp {
    static constexpr bool PERM = true; static constexpr int NAUX = 4;
    unsigned char* HID; const float* bgu;
    __device__ __forceinline__ const float* aux_src(const g8::Unit& u, int piece) const { return bgu + (size_t)u.aux * 2048 + (piece >> 1) * 1024 + u.pn * 128 + (piece & 1) * 64; }
    __device__ __forceinline__ bool operator()(f32x4 (&acc)[2][2][4][2], const g8::Unit& u, int wr, int wc, int fr, int fq, const LAS float* aux) const {
        const int row0 = u.pm * 256 + wr * 64 + fr, hl = wc * 32 + 8 * fq, hc0 = u.pn * 128 + hl;
        f32x4 bgt[2], bup[2];
#pragma unroll
        for (int n = 0; n < 2; ++n) { bgt[n] = *(const LAS f32x4*)(aux + hl + 4 * n); bup[n] = *(const LAS f32x4*)(aux + 128 + hl + 4 * n); }
#pragma unroll
        for (int ai = 0; ai < 2; ++ai)
#pragma unroll
            for (int m = 0; m < 4; ++m) { float h[8];
#pragma unroll
                for (int n = 0; n < 2; ++n) {
#pragma unroll
                    for (int jp = 0; jp < 2; ++jp) {
                        const f32x2 ga = {acc[ai][0][m][n][2 * jp], acc[ai][0][m][n][2 * jp + 1]}, ua = {acc[ai][1][m][n][2 * jp], acc[ai][1][m][n][2 * jp + 1]};
                        const f32x2 gb = {bgt[n][2 * jp], bgt[n][2 * jp + 1]}, ub = {bup[n][2 * jp], bup[n][2 * jp + 1]};
                        f32x2 g = ga * 0.015625f + gb, u = ua * 0.015625f + ub;
                        g.x = fminf(g.x, 7.0f); g.y = fminf(g.y, 7.0f); u.x = fminf(fmaxf(u.x, -7.0f), 7.0f); u.y = fminf(fmaxf(u.y, -7.0f), 7.0f);
                        const f32x2 t = g * -2.4554669595930157f;
                        f32x2 d; d.x = __builtin_amdgcn_exp2f(t.x); d.y = __builtin_amdgcn_exp2f(t.y); d = d + 1.0f;
                        f32x2 r; r.x = __builtin_amdgcn_rcpf(d.x); r.y = __builtin_amdgcn_rcpf(d.y);
                        const f32x2 hh = (u * g + g) * r;
                        h[4 * n + 2 * jp] = hh.x; h[4 * n + 2 * jp + 1] = hh.y; } }
                u32x2 w; w.x = pk4_fp8(h[0], h[1], h[2], h[3]); w.y = pk4_fp8(h[4], h[5], h[6], h[7]);
                *(u32x2*)(HID + (size_t)(row0 + ai * 128 + m * 16) * DM + hc0) = w; }
        return false;
    }
};
struct EpiDown {
    static constexpr bool PERM = true; static constexpr int NAUX = 8;
    bf16_t* Y; const float* bdn; const float* wslot; const LAS int* cum;
    __device__ __forceinline__ const float* aux_src(const g8::Unit& u, int piece) const { return piece < 4 ? bdn + (size_t)u.aux * DM + u.pn * 256 + piece * 64 : wslot + (size_t)u.aux * CAPR + (size_t)(u.pm - __builtin_amdgcn_readfirstlane(cum[u.aux])) * 256 + (piece - 4) * 64; }
    __device__ __forceinline__ bool operator()(f32x4 (&acc)[2][2][4][2], const g8::Unit& u, int wr, int wc, int fr, int fq, const LAS float* aux) const {
        const int row0 = u.pm * 256 + wr * 64 + fr, cl = wc * 32 + 8 * fq, col0 = u.pn * 256 + cl;
        f32x4 bv[2][2];
#pragma unroll
        for (int bj = 0; bj < 2; ++bj)
#pragma unroll
            for (int n = 0; n < 2; ++n) bv[bj][n] = *(const LAS f32x4*)(aux + bj * 128 + cl + 4 * n);
#pragma unroll
        for (int ai = 0; ai < 2; ++ai)
#pragma unroll
            for (int m = 0; m < 4; ++m) { const int rl = ai * 128 + wr * 64 + m * 16 + fr; const float wv = aux[256 + rl]; bf16_t* rowp = Y + (size_t)(u.pm * 256 + rl) * DM + col0;
#pragma unroll
                for (int bj = 0; bj < 2; ++bj) { const f32x4 v0 = (acc[ai][bj][m][0] * 0.015625f + bv[bj][0]) * wv, v1 = (acc[ai][bj][m][1] * 0.015625f + bv[bj][1]) * wv;
                    u32x4 w; w.x = cvt_pk_bf16(v0[0], v0[1]); w.y = cvt_pk_bf16(v0[2], v0[3]); w.z = cvt_pk_bf16(v1[0], v1[1]); w.w = cvt_pk_bf16(v1[2], v1[3]);
                    *(u32x4*)(rowp + bj * 128) = w; } }
        (void)row0;
        return false;
    }
};

struct SchedMerge {
    const char* ws; size_t woff; int G, c, nM, total;
    __device__ __forceinline__ bool next(int i, g8::Unit& u) const {
        const int br = i % 3, T = (i / 3) * G + c; if (T >= total) return false;
        int pm, pn; g8::tile_order(T, nM, 4, pm, pn);
        const size_t aoff = WS_ATT + (br > 0 ? (WS_FX - WS_ATT) : 0) + (br > 1 ? (WS_SG - WS_FX) : 0);
        const size_t boff = WS_WA + (br > 0 ? (WS_WFP - WS_WA) : 0) + (br > 1 ? (WS_WS - WS_WFP) : 0);
        u.A = ws + aoff + (size_t)pm * 256 * 2048; u.B = ws + boff + woff + (size_t)pn * 256 * 2048; u.nt = br == 2 ? 8 : 16; u.pm = pm; u.pn = pn; u.aux = br; return true;
    }
};
struct EpiMerge {
    static constexpr bool PERM = true; static constexpr int NAUX = 0;
    const bf16_t* GT; bf16_t* MRG;
    __device__ __forceinline__ bool operator()(f32x4 (&acc)[2][2][4][2], const g8::Unit& u, int wr, int wc, int fr, int fq, const LAS float* aux) const {
        const int row0 = u.pm * 256 + wr * 64 + fr, col0 = u.pn * 256 + wc * 32 + 8 * fq, br = u.aux;
        const bf16_t* gp = GT + (size_t)row0 * 3072 + br * 1024 + col0;
        if (br < 2) {
#pragma unroll
            for (int ai = 0; ai < 2; ++ai) { u32x4 gw[4][2], hw[4][2];
#pragma unroll
                for (int m = 0; m < 4; ++m)
#pragma unroll
                    for (int bj = 0; bj < 2; ++bj) { const bf16_t* p = gp + (size_t)(ai * 128 + m * 16) * 3072 + bj * 128; gw[m][bj] = *(const u32x4*)p; hw[m][bj] = *(const u32x4*)(p + 1024); }
#pragma unroll
                for (int m = 0; m < 4; ++m)
#pragma unroll
                    for (int bj = 0; bj < 2; ++bj) { const u32x4 g4 = gw[m][bj], h4 = hw[m][bj];
                        const float g[8] = {bf_lo(g4.x), bf_hi(g4.x), bf_lo(g4.y), bf_hi(g4.y), bf_lo(g4.z), bf_hi(g4.z), bf_lo(g4.w), bf_hi(g4.w)};
                        const float h[8] = {bf_lo(h4.x), bf_hi(h4.x), bf_lo(h4.y), bf_hi(h4.y), bf_lo(h4.z), bf_hi(h4.z), bf_lo(h4.w), bf_hi(h4.w)};
#pragma unroll
                        for (int j = 0; j < 8; ++j) { const float gg = br > 0 ? fmaxf(g[j], 1e-20f) : g[j]; acc[ai][bj][m][j >> 2][j & 3] *= gg * __builtin_amdgcn_rcpf(fmaxf(h[j], 1e-20f)); } } }
        } else {
            u32x4 gw[2][4][2];
#pragma unroll
            for (int ai = 0; ai < 2; ++ai)
#pragma unroll
                for (int m = 0; m < 4; ++m)
#pragma unroll
                    for (int bj = 0; bj < 2; ++bj) gw[ai][m][bj] = *(const u32x4*)(gp + (size_t)(ai * 128 + m * 16) * 3072 + bj * 128);
#pragma unroll
            for (int ai = 0; ai < 2; ++ai)
#pragma unroll
                for (int m = 0; m < 4; ++m)
#pragma unroll
                    for (int bj = 0; bj < 2; ++bj) { const u32x4 g4 = gw[ai][m][bj];
                        const float g[8] = {bf_lo(g4.x), bf_hi(g4.x), bf_lo(g4.y), bf_hi(g4.y), bf_lo(g4.z), bf_hi(g4.z), bf_lo(g4.w), bf_hi(g4.w)};
                        float v[8];
#pragma unroll
                        for (int j = 0; j < 8; ++j) v[j] = fmaxf(g[j], 1e-20f) * acc[ai][bj][m][j >> 2][j & 3];
                        u32x4 w; w.x = cvt_pk_bf16(v[0], v[1]); w.y = cvt_pk_bf16(v[2], v[3]); w.z = cvt_pk_bf16(v[4], v[5]); w.w = cvt_pk_bf16(v[6], v[7]);
                        *(u32x4*)(MRG + (size_t)(row0 + ai * 128 + m * 16) * DM + col0 + bj * 128) = w; }
        }
        return br < 2;
    }
};
struct SchedPlain {
    const char* A; const char* B; int G, c, nM, nN, nt;
    __device__ __forceinline__ bool next(int i, g8::Unit& u) const {
        const int L = i * G + c; if (L >= nM * nN) return false;
        int pm, pn; g8::tile_order(L, nM, nN, pm, pn);
        u.A = A + (size_t)pm * 256 * 2048; u.B = B + (size_t)pn * 256 * 2048; u.nt = nt; u.pm = pm; u.pn = pn; u.aux = 0; return true;
    }
};
struct EpiOut {
    static constexpr bool PERM = false; static constexpr int NAUX = 0;
    const float* rx; const float* rc; float* XW; const float* mod;
    __device__ __forceinline__ bool operator()(f32x4 (&acc)[2][2][4][2], const g8::Unit& u, int wr, int wc, int fr, int fq, const LAS float* aux) const {
        const int row0 = u.pm * 256 + wr * 64 + fr, col0 = u.pn * 256 + wc * 32 + 4 * fq;
        const float* res = u.pm < 64 ? rx : rc; const float* g1 = mod + (size_t)(u.pm < 32 ? 0 : (u.pm < 64 ? 1 : 2)) * 6144 + 2048;
        f32x4 gv[2][2];
#pragma unroll
        for (int bj = 0; bj < 2; ++bj)
#pragma unroll
            for (int n = 0; n < 2; ++n) gv[bj][n] = *(const f32x4*)(g1 + col0 + bj * 128 + n * 16);
        f32x4 r0[8], r1[8];
#define EO_OFF(gi, mm) ((size_t)(row0 + ((gi) >> 1) * 128 + ((((gi) & 1) << 1) + (mm)) * 16) * DM + col0)
#define EO_LD(r, gi) _Pragma("unroll") for (int mm = 0; mm < 2; ++mm) _Pragma("unroll") for (int bj = 0; bj < 2; ++bj) _Pragma("unroll") for (int n = 0; n < 2; ++n) \
            r[mm * 4 + bj * 2 + n] = *(const f32x4*)(res + EO_OFF(gi, mm) + bj * 128 + n * 16);
#define EO_ST(r, gi) _Pragma("unroll") for (int mm = 0; mm < 2; ++mm) _Pragma("unroll") for (int bj = 0; bj < 2; ++bj) _Pragma("unroll") for (int n = 0; n < 2; ++n) \
            *(f32x4*)(XW + EO_OFF(gi, mm) + bj * 128 + n * 16) = r[mm * 4 + bj * 2 + n] + gv[bj][n] * acc[(gi) >> 1][bj][(((gi) & 1) << 1) + mm][n];
        EO_LD(r0, 0) EO_LD(r1, 1)
        EO_ST(r0, 0) EO_LD(r0, 2)
        EO_ST(r1, 1) EO_LD(r1, 3)
        EO_ST(r0, 2) EO_ST(r1, 3)
#undef EO_OFF
#undef EO_LD
#undef EO_ST
        return false;
    }
};

__device__ __forceinline__ void p_combine(Frame& F, int l, int nrows, bool last) {
    const LAS int* cum = (const LAS int*)(F.lds + LDS_X_OFF + 8192);
    const int gw = F.vcu * 8 + F.wave, NGW = F.G * 8;
    const float* MOD = (const float*)(F.ws + WS_MOD) + (size_t)l * 3 * 6144;
    const bool poison = last && __hip_atomic_load((const unsigned*)(F.ws + WS_CTL) + CW_BAR + XB_TMO, __ATOMIC_RELAXED, __HIP_MEMORY_SCOPE_AGENT) != 0u;
    const float qn = __builtin_nanf("");
    float* outp = last ? OUTP() : (float*)(F.ws + WS_XW);
    const bf16_t* Y = (const bf16_t*)(F.ws + WS_Y);
    const float* MODN = MOD + 3 * 6144;
    u32x4 w[4][2] = {}; f32x4 xv[2][2] = {}, gv[2][2] = {}, shv[2][2] = {}, scv[2][2] = {};
#define CB_ISSUE(r_, ts_, W, XV, GV, SHV, SCV) do { \
        const u32x4* y0 = (const u32x4*)(Y + (size_t)(cum[(ts_).x >> 16] * 256 + (int)((ts_).x & 0xffff)) * DM) + F.lane; \
        const u32x4* y1 = (const u32x4*)(Y + (size_t)(cum[(ts_).y >> 16] * 256 + (int)((ts_).y & 0xffff)) * DM) + F.lane; \
        const u32x4* y2 = (const u32x4*)(Y + (size_t)(cum[(ts_).z >> 16] * 256 + (int)((ts_).z & 0xffff)) * DM) + F.lane; \
        const u32x4* y3 = (const u32x4*)(Y + (size_t)(cum[(ts_).w >> 16] * 256 + (int)((ts_).w & 0xffff)) * DM) + F.lane; \
        _Pragma("unroll") for (int j = 0; j < 2; ++j) { W[0][j] = y0[64 * j]; W[1][j] = y1[64 * j]; W[2][j] = y2[64 * j]; W[3][j] = y3[64 * j]; } \
        const float* xr_ = (const float*)(F.ws + WS_XW) + (size_t)(r_) * DM; const int mr_ = modrow_of(r_); const float* g2_ = MOD + (size_t)mr_ * 6144 + 5120; const float* md_ = MODN + (size_t)mr_ * 6144; \
        _Pragma("unroll") for (int j = 0; j < 2; ++j) { const int c = 8 * F.lane + 512 * j; XV[j][0] = *(const f32x4*)(xr_ + c); XV[j][1] = *(const f32x4*)(xr_ + c + 4); GV[j][0] = *(const f32x4*)(g2_ + c); GV[j][1] = *(const f32x4*)(g2_ + c + 4); \
            if (!last) { SHV[j][0] = *(const f32x4*)(md_ + c); SHV[j][1] = *(const f32x4*)(md_ + c + 4); SCV[j][0] = *(const f32x4*)(md_ + 1024 + c); SCV[j][1] = *(const f32x4*)(md_ + 1024 + c + 4); } } } while (0)
    if (gw < nrows) { const u32x4 ts0 = *(const u32x4*)((const unsigned*)(F.ws + WS_TSLOT) + (size_t)gw * 4); CB_ISSUE(gw, ts0, w, xv, gv, shv, scv); }
    for (int row = gw; row < nrows; row += NGW) {
        const int nrow = row + NGW; const bool hn = nrow < nrows;
        u32x4 tsn = {}; if (hn) tsn = *(const u32x4*)((const unsigned*)(F.ws + WS_TSLOT) + (size_t)nrow * 4);
        f32x4 xn[2][2];
#pragma unroll
        for (int j = 0; j < 2; ++j) {
            f32x4 a0 = (f32x4){0.f, 0.f, 0.f, 0.f}, a1 = a0;
#pragma unroll
            for (int k = 0; k < 4; ++k) { const u32x4 q = w[k][j]; a0 += (f32x4){bf_lo(q.x), bf_hi(q.x), bf_lo(q.y), bf_hi(q.y)}; a1 += (f32x4){bf_lo(q.z), bf_hi(q.z), bf_lo(q.w), bf_hi(q.w)}; }
            f32x4 r0 = xv[j][0] + gv[j][0] * a0, r1 = xv[j][1] + gv[j][1] * a1;
            if (poison) { r0 = (f32x4){qn, qn, qn, qn}; r1 = r0; }
            xn[j][0] = r0; xn[j][1] = r1;
        }
        f32x4 sh[2][2], sc[2][2];
#pragma unroll
        for (int j = 0; j < 2; ++j)
#pragma unroll
            for (int q = 0; q < 2; ++q) { sh[j][q] = shv[j][q]; sc[j][q] = scv[j][q]; }
        if (hn) CB_ISSUE(nrow, tsn, w, xv, gv, shv, scv);
#pragma unroll
        for (int j = 0; j < 2; ++j) { const int c = 8 * F.lane + 512 * j; *(f32x4*)(outp + (size_t)row * DM + c) = xn[j][0]; *(f32x4*)(outp + (size_t)row * DM + c + 4) = xn[j][1]; }
        if (!last) {
            float ss = 0.f;
#pragma unroll
            for (int j = 0; j < 2; ++j)
#pragma unroll
                for (int q = 0; q < 2; ++q) ss += (xn[j][q].x * xn[j][q].x + xn[j][q].y * xn[j][q].y) + (xn[j][q].z * xn[j][q].z + xn[j][q].w * xn[j][q].w);
            const float rstd = rsqrtf(wave_sum(ss) * (1.f / DM) + EPS);
#pragma unroll
            for (int j = 0; j < 2; ++j) { const int c = 8 * F.lane + 512 * j;
                const f32x4 h0 = xn[j][0] * rstd * (sc[j][0] + 1.0f) + sh[j][0], h1 = xn[j][1] * rstd * (sc[j][1] + 1.0f) + sh[j][1];
                u32x2 w2; w2.x = pk4_fp8(h0.x, h0.y, h0.z, h0.w); w2.y = pk4_fp8(h1.x, h1.y, h1.z, h1.w);
                *(u32x2*)((unsigned char*)(F.ws + WS_HX8) + (size_t)row * DM + c) = w2; }
        }
    }
#undef CB_ISSUE
}

#ifndef EPI_ALIGN
#define EPI_ALIGN true
#endif
#ifndef BF_SP2
#define BF_SP2 true
#endif
#ifndef MOE_SP2
#define MOE_SP2 true
#endif
#ifndef DUP
#define DUP 0
#endif
#define REPB(bit, stmt) do { stmt; if (DUP & (bit)) { GRID_BAR(); refresh(F); stmt; } } while (0)
#define REP(bit) for (int rep_ = 0; rep_ < ((DUP & (bit)) ? 2 : 1); ++rep_)
#ifndef PHM
#define PHM 0xffff
#endif
__global__ void __launch_bounds__(512, 2) mk_fwd(KArgs args) {
    extern __shared__ __attribute__((aligned(16))) unsigned char lds_raw[];
    Frame F;
    F.lds = (LAS unsigned char*)lds_raw; F.ws = args.ws;
    F.tid = threadIdx.x; F.lane = F.tid & 63; F.wave = __builtin_amdgcn_readfirstlane(F.tid >> 6);
    F.G = gridDim.x; { const int bx = blockIdx.x; F.vcu = (F.G % 8 == 0) ? (bx % 8) * (F.G / 8) + bx / 8 : bx; }
    volatile LAS unsigned* MISC = (volatile LAS unsigned*)(F.lds + LDS_MISC_OFF);
    for (int u = F.tid; u < (LDS_BYTES - LDS_MISC_OFF) / 4; u += 512) MISC[u] = 0u;
    __syncthreads();
    XcdBarrier bar = xcd_barrier_post((unsigned*)(F.ws + WS_CTL) + CW_BAR, MISC + 8);
    const int bid = (int)blockIdx.x;
#define GRID_BAR() do { XcdBarrier b_ = bar; b_.seam = (unsigned)(__LINE__); asm volatile("" : "+s"(b_.x)); asm volatile("" : "+s"(b_.bar)); asm volatile("" : "+s"(b_.wave)); xcd_barrier(b_); if (DUP & 16384) xcd_barrier(b_); } while (0)

    refresh(F);
    REP(1) if (PHM & 1) p0_prologue(F);
    GRID_BAR();

    FillCur FC; FC.c0 = 0; FC.c1 = 0;
    for (int l_ = 0; l_ < DEPTH; ++l_) {
        const int l = launder_s(l_);
        const bool last = (l == DEPTH - 1);
        const int nrows = last ? NXR : NROW;
        const bf16_t* HX = (const bf16_t*)(F.ws + WS_HX);
        refresh(F);
        if (l == 0) { p_norm1(F, l, NROW); GRID_BAR(); }
        refresh(F);
        REP(4) if (PHM & 4) {
            SchedIn S{(const char*)(F.ws + WS_HX8), (const char*)(F.ws + WS_WIN) + (size_t)l * IN_DIM * DM, F.G, bid, 64 * 24 + (last ? 4 : 48), last ? 1 : 0};
            EpiIn E{(bf16_t*)(F.ws + WS_PX), (bf16_t*)(F.ws + WS_GT), INP(I_BGATE) + (size_t)l * 3072};
            g8::gemm_phase<EpiIn, SchedIn, true, BF_SP2, EPI_ALIGN>(F.lds, S, E, F.tid);
            fill_after(F, FC, l, 64 * 24 + (last ? 4 : 48), bid, 4);
        }
        GRID_BAR();
        refresh(F);
        if (PHM & 8) p_postproj(F, l, NROW);
        refresh(F);
        p_vblocks(F);
        refresh(F);
        if (PHM & 16) {
            const bf16_t* PX = (const bf16_t*)(F.ws + WS_PX);
            for (int u = F.vcu; u < 512; u += F.G) {
                const int n1 = u >> 3, b = (u >> 2) & 1, cb = u & 3;
                EpiStore2 E{(bf16_t*)(F.ws + WS_Y1) + ((size_t)b * 128 * 2 * 64 + n1) * 512 + cb * 128, 128, (size_t)2 * 64 * 512, (size_t)64 * 512};
                lm_unit<256, 128>(F, (const bf16_t*)(F.ws + WS_T1) + (size_t)n1 * 256 * 128, PX + ((size_t)b * SEQ + n1) * PXW + F_OFF + cb * 128, (size_t)64 * PXW, E);
            }
            if (!last) for (int u = (F.G >= 16 ? F.vcu - (F.G - 8) : F.vcu); u < 8; u += F.G) {
                if (u < 0) continue;
                const int b = u >> 2, cb = u & 3;
                EpiStore2 E{(bf16_t*)(F.ws + WS_FX) + (size_t)(NXR + b * CTX) * DM + cb * 128, 256, (size_t)DM, (size_t)512};
                lm_unit<512, 256>(F, (const bf16_t*)(F.ws + WS_TC), PX + (size_t)(NXR + b * CTX) * PXW + F_OFF + cb * 128, (size_t)PXW, E);
            }
        }
        GRID_BAR();
        refresh(F);
        REP(32) if (PHM & 32) {
            const unsigned char* QN = (const unsigned char*)(F.ws + WS_QN); const unsigned char* KN = (const unsigned char*)(F.ws + WS_KN); const unsigned char* VT = (const unsigned char*)(F.ws + WS_VN); bf16_t* ATT = (bf16_t*)(F.ws + WS_ATT);
            REP(8192) for (int u = bid; u < 512; u += F.G) {
                const int b = u >> 8, kvh = (u >> 7) & 1, hq = (u >> 5) & 3, qb = u & 31, h = kvh * 4 + hq;
                const size_t q0 = ((size_t)b * SEQ + qb * 256) * DM + h * 128, k0 = (size_t)b * LK * 256 + kvh * 128;
                att::attn_dense_body(QN + q0, KN + k0, VT + (size_t)((b * 2 + kvh) * 132) * 8192, ATT + q0, LK, (char*)lds_raw, F.tid);
            }
            if (!last) for (int u = bid; u < 16; u += F.G) {
                const int b = u >> 3, h = u & 7, kvh = h >> 2;
                const size_t q0 = (size_t)(NXR + b * CTX) * DM + h * 128, k0 = ((size_t)b * LK + SEQ) * 256 + kvh * 128;
                att::attn_dense_body(QN + q0, KN + k0, VT + (size_t)((b * 2 + kvh) * 132 + 128) * 8192, ATT + q0, CTX, (char*)lds_raw, F.tid);
            }
            refresh(F);
            const unsigned lo0 = lm_dma_lane_off(F.wave, F.lane, 0, 512u), lo1 = lm_dma_lane_off(F.wave, F.lane, 1, 512u);
            {
                const bf16_t* T2 = (const bf16_t*)(F.ws + WS_T2);
#define P2_IN(uu) ((const bf16_t*)(F.ws + WS_Y1) + ((size_t)((uu) >> 9) * 128 + (((uu) >> 2) & 127)) * 2 * 64 * 512 + ((uu) & 3) * 128)
                int p = F.vcu, buf = 0;
                __syncthreads();
                if (p < 512) lm_dma_pair(F, P2_IN(2 * p), P2_IN(2 * p + 1), 512u, 0, lo0, lo1);
                for (; p < 512; p += F.G) {
                    asm volatile("s_waitcnt vmcnt(0)" ::: "memory"); __syncthreads();
                    bf16x8 pw[2][4]; lm_load_w(F, pw, T2);
                    if (p + F.G < 512) lm_dma_pair(F, P2_IN(2 * (p + F.G)), P2_IN(2 * (p + F.G) + 1), 512u, (buf ^ 1) * 65536, lo0, lo1);
                    const int u = 2 * p + (F.wave >> 2), b = u >> 9, k2 = (u >> 2) & 127, cb = u & 3;
                    EpiStore2 E{(bf16_t*)(F.ws + WS_FX) + ((size_t)b * SEQ + k2) * DM + cb * 128, 64, (size_t)128 * DM, (size_t)512};
                    lm_pair_compute(F, pw, buf * 65536, E);
                    buf ^= 1;
                }
#undef P2_IN
            }
            {
                const int np = (nrows / 128) * 2;
                const bf16_t* WSPl = (const bf16_t*)(F.ws + WS_WSP) + (size_t)l * 4 * 128 * 128;
#define SG_IN(uu) ((const bf16_t*)(F.ws + WS_VGN) + (size_t)((uu) >> 2) * 128 * 512 + ((uu) & 3) * 128)
                int p = F.vcu, buf = 0;
                __syncthreads();
                if (p < np) lm_dma_pair(F, SG_IN(2 * p), SG_IN(2 * p + 1), 512u, 0, lo0, lo1);
                for (; p < np; p += F.G) {
                    asm volatile("s_waitcnt vmcnt(0)" ::: "memory"); __syncthreads();
                    const int u = 2 * p + (F.wave >> 2), ch = u >> 2, g = u & 3; const size_t row0 = (size_t)ch * 128;
                    bf16x8 pw[2][4]; lm_load_w(F, pw, WSPl + (size_t)g * 128 * 128);
                    EpiSgu E{(bf16_t*)(F.ws + WS_SG) + row0 * DM + g * 128, (const bf16_t*)(F.ws + WS_PX) + row0 * PXW + U_OFF + g * 128, INP(I_BSPAT) + (size_t)l * 512 + g * 128};
                    u32x4 uw[8]; float ub[8]; E.pre((F.wave & 3) * 32, F.lane, uw, ub);
                    if (p + F.G < np) lm_dma_pair(F, SG_IN(2 * (p + F.G)), SG_IN(2 * (p + F.G) + 1), 512u, (buf ^ 1) * 65536, lo0, lo1);
                    {
                        const int pb = F.wave >> 2, rb = F.wave & 3;
                        const int vb0 = (int)(unsigned)(uintptr_t)F.lds + buf * 65536 + att::v_rd_base(F.lane) + pb * 32768;
                        f32x16 o[4] = {};
#pragma unroll
                        for (int t = 0; t < 2; ++t) att::pv_d0(o, vb0 + t * 16384, pw[t][0], pw[t][1], pw[t][2], pw[t][3]);
                        __syncthreads();
                        att::wave_rows_out_i(F.lds + buf * 65536 + F.wave * 8192, o, F.lane, [&](int i, int row, int col8, u32x4 v) { E.rows2(rb * 32 + row, col8, v, uw[i], ub[i]); });
                    }
                    buf ^= 1;
                }
#undef SG_IN
            }
            __syncthreads();
        }
        GRID_BAR();
        refresh(F);
        REP(64) if (PHM & 64) {
            const int nM = nrows / 256;
            SchedMerge S{(const char*)F.ws, (size_t)l * DM * DM * 2, F.G, bid, nM, nM * 4};
            EpiMerge E{(const bf16_t*)(F.ws + WS_GT), (bf16_t*)(F.ws + WS_MRG)};
            g8::gemm_phase<EpiMerge, SchedMerge, false, BF_SP2, true>(F.lds, S, E, F.tid);
            fill_after(F, FC, l, nM * 4, bid, 12);
        }
        GRID_BAR();
        refresh(F);
        for (int rep_ = 0; rep_ < (((DUP & 128) && l == 0) ? 2 : 1); ++rep_) {
            SchedPlain S{(const char*)(F.ws + WS_MRG), (const char*)((const bf16_t*)(F.ws + WS_WO) + (size_t)l * DM * DM), F.G, bid, nrows / 256, 4, 16};
            const float* XWc = (const float*)(F.ws + WS_XW);
            EpiOut E{l == 0 ? INP(I_X) : XWc, l == 0 ? INP(I_CTX) - (size_t)NXR * DM : XWc, (float*)(F.ws + WS_XW), (const float*)(F.ws + WS_MOD) + (size_t)l * 3 * 6144};
            g8::gemm_phase<EpiOut, SchedPlain, false, BF_SP2, true>(F.lds, S, E, F.tid);
            fill_after(F, FC, l, (nrows / 256) * 4, bid, 5);
        }
        GRID_BAR();
        refresh(F);
        if (DUP & 256) { p_route(F, l, nrows, 1); GRID_BAR(); refresh(F); }
        if (PHM & 256) p_route(F, l, nrows);
        refresh(F);
        fill_cleanup(F, FC, l);
        GRID_BAR();
        moe_tables(F, l);
        refresh(F);
        const LAS int* cum = (const LAS int*)(F.lds + LDS_X_OFF + 8192); const LAS int* texp = (const LAS int*)(F.lds + LDS_X_OFF + 8192 + 256);
        const int ntile = __builtin_amdgcn_readfirstlane(cum[NEXP]);
        int vup = bid, vdn = bid;
        if (F.G == 256) { const int x = bid & 7, r = bid >> 3; vup = (8 * (x >> 1) + (r >> 2)) * 8 + 4 * (x & 1) + (r & 3); vdn = (8 * x + (r >> 2)) * 4 + (r & 3); }
        refresh(F);
        REP(1024) if (PHM & 1024) {
            SchedMoe S{(const char*)(F.ws + WS_HXS), (const char*)(F.ws + WS_WGU) + (size_t)l * NEXP * 2048 * DM, (size_t)2048 * DM, F.G, vup, 8, ntile * 8, texp, cum, (size_t)CAPR};
            EpiUp E{(unsigned char*)(F.ws + WS_HID), INP(I_BGU) + (size_t)l * NEXP * 2048};
            g8::gemm_phase<EpiUp, SchedMoe, true, MOE_SP2, EPI_ALIGN>(F.lds, S, E, F.tid);
            if (!last) fill_after(F, FC, l + 1, ntile * 8, vup, 4);
        }
        GRID_BAR();
        refresh(F);
        REP(2048) if (PHM & 2048) {
            SchedMoe S{(const char*)(F.ws + WS_HID), (const char*)(F.ws + WS_WDN) + (size_t)l * NEXP * DM * DM, (size_t)DM * DM, F.G, vdn, 4, ntile * 4, texp, cum, (size_t)0};
            EpiDown E{(bf16_t*)(F.ws + WS_Y), INP(I_BDN) + (size_t)l * NEXP * DM, (const float*)(F.ws + WS_WSLOT), cum};
            g8::gemm_phase<EpiDown, SchedMoe, true, MOE_SP2, EPI_ALIGN>(F.lds, S, E, F.tid);
            if (!last) fill_after(F, FC, l + 1, ntile * 4, vdn, 2);
        }
        GRID_BAR();
        refresh(F);
        if (last) { REPB(4096, p_combine(F, l, nrows, last)); } else p_combine(F, l, nrows, last);
        GRID_BAR();
    }
}

extern "C" void kernel_launch(void* const* d_in, const int* in_sizes, int n_in, void* d_out, int out_size, void* d_ws, size_t ws_size, hipStream_t stream) {
    static int grid = 0;
    if (grid == 0) {
        if (n_in != 23 || out_size != NXR * DM || ws_size < WS_END) { fprintf(stderr, "kernel_launch: unexpected shapes: n_in %d out %d ws %zu (need %zu)\n", n_in, out_size, ws_size, (size_t)WS_END); grid = -1; return; }
        int dev = 0, cus = 0, per_cu = 0;
        if (hipGetDevice(&dev) != hipSuccess || hipDeviceGetAttribute(&cus, hipDeviceAttributeMultiprocessorCount, dev) != hipSuccess) { grid = -1; return; }
        if (hipFuncSetAttribute((const void*)mk_fwd, hipFuncAttributeMaxDynamicSharedMemorySize, LDS_BYTES) != hipSuccess) { fprintf(stderr, "kernel_launch: hipFuncSetAttribute failed\n"); grid = -1; return; }
        if (hipOccupancyMaxActiveBlocksPerMultiprocessor(&per_cu, (const void*)mk_fwd, 512, LDS_BYTES) != hipSuccess || per_cu < 1) { fprintf(stderr, "kernel_launch: occupancy query says %d\n", per_cu); (void)hipGetLastError(); }
        grid = cus;
    }
    if (grid < 0) return;
    if (hipMemsetAsync((char*)d_ws + WS_CTL, 0, CTL_ZERO_BYTES, stream) != hipSuccess) return;
    KArgs a{};
    for (int i = 0; i < 23; ++i) a.in[i] = (const float*)d_in[i];
    a.out = (float*)d_out; a.ws = (unsigned char*)d_ws;
    hipLaunchKernelGGL(mk_fwd, dim3(grid), dim3(512), LDS_BYTES, stream, a);
}
```

```cpp
#include <hip/hip_runtime.h>
#include <cstdio>
#include <cstdint>

#define LAS __attribute__((address_space(3)))
#define GAS __attribute__((address_space(1)))
typedef unsigned short bf16_t;
typedef short bf16x8 __attribute__((ext_vector_type(8)));
typedef int v8i __attribute__((ext_vector_type(8)));
typedef int v4i __attribute__((ext_vector_type(4)));
typedef short s16x4 __attribute__((ext_vector_type(4)));
typedef float f32x2 __attribute__((ext_vector_type(2)));
typedef float f32x4 __attribute__((ext_vector_type(4)));
typedef float f32x16 __attribute__((ext_vector_type(16)));
typedef unsigned u32x2 __attribute__((ext_vector_type(2)));
typedef unsigned u32x4 __attribute__((ext_vector_type(4)));

constexpr int DM = 1024, NB = 2, SEQ = 8192, CTX = 256, DEPTH = 2;
constexpr int NXR = NB * SEQ;
constexpr int NCR = NB * CTX;
constexpr int NROW = NXR + NCR;
constexpr int LK = SEQ + CTX;
constexpr int IN_DIM = 6144, Q_OFF = 0, K_OFF = 1024, V_OFF = 1280, F_OFF = 1536, U_OFF = 2048, VG_OFF = 2560, G_OFF = 3072;
constexpr int PXW = 3072;
constexpr int NEXP = 32, TOPK = 4;
constexpr int MAXT = 296;
constexpr int SROWS = MAXT * 256;
constexpr float EPS = 1e-6f;

constexpr size_t al256(size_t x) { return (x + 255) / 256 * 256; }
constexpr size_t WS_CTL = 0, CTL_BYTES = 1u << 20, CTL_ZERO_BYTES = 128u << 10;
constexpr size_t WS_MOD = WS_CTL + CTL_BYTES;
constexpr size_t WS_T1 = al256(WS_MOD + (size_t)DEPTH * 3 * 6144 * 4);
constexpr size_t WS_T2 = al256(WS_T1 + (size_t)64 * 256 * 128 * 4);
constexpr size_t WS_WSP = WS_T1 + (size_t)6 * 1024 * 1024;
constexpr size_t WS_ROPE = WS_T1 + (size_t)7 * 1024 * 1024;
constexpr size_t WS_TC = al256(WS_T2 + (size_t)128 * 128 * 4);
constexpr size_t WS_WIN = al256(WS_TC + (size_t)512 * 256 * 4);
constexpr size_t WS_WA = al256(WS_WIN + (size_t)DEPTH * IN_DIM * DM * 2);
constexpr size_t WS_WFP = al256(WS_WA + (size_t)DEPTH * DM * DM * 2);
constexpr size_t WS_WS = al256(WS_WFP + (size_t)DEPTH * DM * DM * 2);
constexpr size_t WS_WO = al256(WS_WS + (size_t)DEPTH * DM * DM * 2);
constexpr size_t WS_WGU = al256(WS_WO + (size_t)DEPTH * DM * DM * 2);
constexpr size_t WS_WDN = al256(WS_WGU + (size_t)DEPTH * NEXP * 2048 * DM);
constexpr size_t WS_XW = al256(WS_WDN + (size_t)DEPTH * NEXP * DM * DM);
constexpr size_t WS_HX = al256(WS_XW + (size_t)NROW * DM * 4);
constexpr size_t WS_PX = al256(WS_HX + (size_t)NROW * DM * 2);
constexpr size_t WS_GT = al256(WS_PX + (size_t)NROW * PXW * 2);
constexpr size_t WS_QN = al256(WS_GT + (size_t)NROW * 3072 * 2);
constexpr size_t WS_KN = al256(WS_QN + (size_t)NROW * DM * 2);
constexpr size_t WS_VN = al256(WS_KN + (size_t)NB * LK * 256 * 2);
constexpr size_t WS_VGN = al256(WS_VN + (size_t)NB * LK * 256 * 2);
constexpr size_t WS_Y1 = al256(WS_VGN + (size_t)NROW * 512 * 2);
constexpr size_t WS_FX = al256(WS_Y1 + (size_t)NB * 128 * 2 * 64 * 512 * 2);
constexpr size_t WS_ATT = al256(WS_FX + (size_t)NROW * DM * 2);
constexpr size_t WS_SG = al256(WS_ATT + (size_t)NROW * DM * 2);
constexpr size_t WS_PART = al256(WS_SG + (size_t)NROW * DM * 2);
constexpr size_t WS_MRG = al256(WS_PART + (size_t)NROW * DM * 4);
constexpr size_t WS_TSLOT = al256(WS_MRG + (size_t)NROW * DM * 2);
constexpr size_t WS_TW = al256(WS_TSLOT + (size_t)NROW * 4 * 4);
constexpr int CAPR = NROW;
constexpr size_t WS_WSLOT = al256(WS_TW + (size_t)NROW * 4 * 4);
constexpr size_t WS_HXS = al256(WS_WSLOT + (size_t)NEXP * CAPR * 4);
constexpr size_t WS_HID = al256(WS_HXS + (size_t)NEXP * CAPR * DM);
constexpr size_t WS_Y = al256(WS_HID + (size_t)SROWS * DM * 2);
constexpr size_t WS_HX8 = al256(WS_Y + (size_t)SROWS * DM * 2);
constexpr size_t WS_END = al256(WS_HX8 + (size_t)NROW * DM);
static_assert(WS_END < (size_t)2000 * 1024 * 1024, "workspace map beyond the guaranteed 4 x largest-input size");
constexpr int CW_BAR = 4096;
constexpr int CW_CNT = 8192;

constexpr int LDS_X_OFF = 131072;
constexpr int LDS_MISC_OFF = 143360;
constexpr int LDS_BYTES = 147456;

__device__ __forceinline__ unsigned cvt_pk_bf16(float lo, float hi) { unsigned r; asm volatile("v_cvt_pk_bf16_f32 %0, %1, %2" : "=v"(r) : "v"(lo), "v"(hi)); return r; }
__device__ __forceinline__ unsigned pk4_fp8(float a, float b, float c, float d) { int p = __builtin_amdgcn_cvt_pk_fp8_f32(a, b, 0, false); return (unsigned)__builtin_amdgcn_cvt_pk_fp8_f32(c, d, p, true); }
__device__ __forceinline__ unsigned pk4_fp8u(float a, float b, float c, float d) { int u; asm("" : "=v"(u) : "v"(a)); int p = __builtin_amdgcn_cvt_pk_fp8_f32(a, b, u, false); return (unsigned)__builtin_amdgcn_cvt_pk_fp8_f32(c, d, p, true); }
__device__ __forceinline__ float bf_lo(unsigned w) { return __uint_as_float(w << 16); }
__device__ __forceinline__ float bf_hi(unsigned w) { return __uint_as_float(w & 0xffff0000u); }
__device__ __forceinline__ float bf2f(bf16_t h) { return __uint_as_float(((unsigned)h) << 16); }
__device__ __forceinline__ int lane_id() { int l; asm volatile("v_mbcnt_lo_u32_b32 %0, -1, 0\n\tv_mbcnt_hi_u32_b32 %0, -1, %0" : "=v"(l)); return l; }
template <int M> __device__ __forceinline__ float sx(float v) {
    if constexpr (M < 32) return __int_as_float(__builtin_amdgcn_ds_swizzle(__float_as_int(v), (M << 10) | 0x1f));
    else { const auto rr = __builtin_amdgcn_permlane32_swap(__float_as_uint(v), __float_as_uint(v), false, false); return (lane_id() & 32) ? __uint_as_float(rr[0]) : __uint_as_float(rr[1]); }
}
__device__ __forceinline__ float wave_sum(float v) {
    v += sx<1>(v); v += sx<2>(v); v += sx<4>(v); v += sx<8>(v); v += sx<16>(v);
    const auto rr = __builtin_amdgcn_permlane32_swap(__float_as_uint(v), __float_as_uint(v), false, false); return __uint_as_float(rr[0]) + __uint_as_float(rr[1]);
}
__device__ __forceinline__ float sigmoidf_(float x) { return __builtin_amdgcn_rcpf(1.0f + __expf(-x)); }
__device__ __forceinline__ float gelu_tanh(float x) { const float z = 0.7978845608028654f * (x + 0.044715f * x * x * x); const float t = 1.0f - 2.0f * __builtin_amdgcn_rcpf(1.0f + __expf(2.0f * z)); return 0.5f * x * (1.0f + t); }

#define XB_TMO      128
#define XB_XCNT(j)  (256  + 64 * (j))
#define XB_XSUB(j)  (1280 + 64 * (j))
#define XB_XGEN(j)  (2304 + 64 * (j))
#define XB_TOP      3328
#define XB_TOPGEN   3392
#define XCD_BAR_WORDS 3456
#define XB_SPIN_CAP (1u << 20)
__device__ __forceinline__ unsigned xb_ld(unsigned* p)              { return __hip_atomic_load(p, __ATOMIC_RELAXED, __HIP_MEMORY_SCOPE_AGENT); }
__device__ __forceinline__ unsigned xb_add(unsigned* p, unsigned v) { return __hip_atomic_fetch_add(p, v, __ATOMIC_RELAXED, __HIP_MEMORY_SCOPE_AGENT); }
__device__ __forceinline__ unsigned xb_xcc_id() { return (unsigned)__builtin_amdgcn_s_getreg((3 << 11) | 20) & 0xFu; }
#define XB_SPIN(cond, bar) do { unsigned _sp = 0; while (cond) { __builtin_amdgcn_s_sleep(1); \
    if ((++_sp & 255u) == 0u) { if (xb_ld(&(bar)[XB_TMO])) break; if (_sp > XB_SPIN_CAP) { __hip_atomic_fetch_max(&(bar)[XB_TMO + 1], 100000u - b.seam, __ATOMIC_RELAXED, __HIP_MEMORY_SCOPE_AGENT); atomicAdd(&(bar)[XB_TMO], 1u); break; } } } } while (0)
struct XcdBarrier { unsigned* bar; unsigned x; volatile LAS unsigned* st; unsigned seam; int wave; };
__device__ __forceinline__ XcdBarrier xcd_barrier_post(unsigned* bar, volatile LAS unsigned* st) {
    XcdBarrier b; b.bar = bar; b.x = xb_xcc_id(); b.st = st; b.seam = 1u; b.wave = __builtin_amdgcn_readfirstlane((int)(threadIdx.x >> 6));
    if (threadIdx.x == 0) (void)xb_add(&bar[XB_XCNT(b.x)], 1u);
    return b;
}
__device__ __forceinline__ void xcd_barrier_complete(unsigned* bar, unsigned x, unsigned& nloc, unsigned& nx) {
    const unsigned G = gridDim.x * gridDim.y * gridDim.z;
    unsigned sum, cnt, mine, sp = 0u;
    for (;;) {
        sum = 0u; cnt = 0u;
#pragma nounroll
        for (unsigned j = 0; j < 16; ++j) { const unsigned c = xb_ld(&bar[XB_XCNT(j)]); sum += c; cnt += (c > 0u) ? 1u : 0u; }
        mine = xb_ld(&bar[XB_XCNT(x)]);
        if (sum == G) break;
        __builtin_amdgcn_s_sleep(1);
        if ((++sp & 255u) == 0u) { if (xb_ld(&bar[XB_TMO])) break; if (sp > XB_SPIN_CAP) { atomicAdd(&bar[XB_TMO], 1u); break; } }
    }
    nloc = mine > 0u ? mine : 1u; nx = cnt > 0u ? cnt : 1u;
}
__device__ __forceinline__ void xcd_barrier(const XcdBarrier& b) {
    asm volatile("s_waitcnt vmcnt(0)" ::: "memory");
    __syncthreads();
    if (b.wave == 0 && lane_id() == 0) {
        unsigned* bar = b.bar;
        __builtin_amdgcn_s_waitcnt(0);
        unsigned nloc = b.st[0], nx = b.st[1];
        if (nloc == 0u) { xcd_barrier_complete(bar, b.x, nloc, nx); b.st[0] = nloc; b.st[1] = nx; }
        const unsigned old = xb_add(&bar[XB_XSUB(b.x)], 1u);
        const unsigned gen = old / nloc;
        if (old + 1u == (gen + 1u) * nloc) {
            __builtin_amdgcn_fence(__ATOMIC_RELEASE, "agent");
            asm volatile("s_waitcnt vmcnt(0)" ::: "memory");
            const unsigned og = xb_add(&bar[XB_TOP], 1u);
            const unsigned tg = og / nx;
            if (og + 1u == (tg + 1u) * nx) xb_add(&bar[XB_TOPGEN], 1u);
            else XB_SPIN(xb_ld(&bar[XB_TOPGEN]) == tg, bar);
            __builtin_amdgcn_fence(__ATOMIC_ACQUIRE, "agent");
            xb_add(&bar[XB_XGEN(b.x)], 1u);
            asm volatile("s_waitcnt vmcnt(0)" ::: "memory");
        } else {
            XB_SPIN(xb_ld(&bar[XB_XGEN(b.x)]) == gen, bar);
            __builtin_amdgcn_fence(__ATOMIC_ACQUIRE, "agent");
            asm volatile("s_waitcnt vmcnt(0)" ::: "memory");
        }
    }
    __syncthreads();
}

namespace g8 {
constexpr int BM = 256, BK = 64, HALF = 128, HTB = HALF * BK * 2, STAGE_BYTES = 8 * HTB, NXCD = 8, WGM = 8;
__host__ __device__ __forceinline__ int lds_byte(int r, int c) { const int st = (r >> 4) * 2 + (c >> 5), rr = r & 15, cc = c & 31, ob = rr * 64 + cc * 2; return st * 1024 + (ob ^ (((ob >> 9) & 1) << 5)); }
__host__ __device__ __forceinline__ void stage_rc(int b, int& R, int& C) { const int st = b / 1024, sb = b % 1024, swz = sb ^ (((sb >> 9) & 1) << 5); R = (st >> 1) * 16 + swz / 64; C = (st & 1) * 32 + (swz % 64) / 2; }
__host__ __device__ __forceinline__ int perm32(int rho) { const int n = rho >> 4, i = rho & 15; return 8 * (i >> 2) + 4 * n + (i & 3); }

struct Unit { const char* A; const char* B; int nt; int pm, pn, aux; };
__host__ __device__ __forceinline__ int lds_byte8(int r, int cb) { const int st = (r >> 4) * 2 + (cb >> 6), ob = (r & 15) * 64 + (cb & 63); return st * 1024 + (ob ^ (((ob >> 9) & 1) << 5)); }

__device__ __forceinline__ void tile_order(int L, int nM, int nN, int& pm, int& pn) {
    const int nwg = nM * nN; int wgid = L; { const int q = nwg / NXCD, r = nwg % NXCD, xcd = wgid % NXCD, off = wgid / NXCD; wgid = (xcd < r ? xcd * (q + 1) : r * (q + 1) + (xcd - r) * q) + off; }
    const int nig = WGM * nN, gid = wgid / nig, fm = gid * WGM, gsz = (nM - fm) < WGM ? (nM - fm) : WGM;
    pm = fm + ((wgid % nig) % gsz); pn = (wgid % nig) / gsz;
}

template <class Epi, class Sched, bool FP8 = false, bool SP2 = false, bool ALIGN_EPI = false>
__device__ __forceinline__ void gemm_phase(LAS unsigned char* lds, const Sched& S, const Epi& E, int tid_in) {
    constexpr unsigned LD = FP8 ? 1024u : 2048u;
    int tid_ = tid_in; asm volatile("" : "+v"(tid_));
    const int tid = tid_, wid = __builtin_amdgcn_readfirstlane(tid >> 6), lane = tid & 63, wr = wid >> 2, wc = wid & 3, fr = lane & 15, fq = lane >> 4;
    int R0, C0; stage_rc(tid * 16, R0, C0);
    const int Rb0 = Epi::PERM ? ((R0 & ~31) + perm32(R0 & 31)) : R0;
    const unsigned c2 = (unsigned)C0 * 2u;
    const unsigned ldsw = (unsigned)wid * 1024u;
    const int aoff = FP8 ? lds_byte8(wr * 64 + fr, fq * 32) : lds_byte(wr * 64 + fr, fq * 8), boff = FP8 ? lds_byte8(wc * 32 + fr, fq * 32) : lds_byte(wc * 32 + fr, fq * 8);
#define G8_SA(b, h) (((b) * 2 + (h)) * HTB)
#define G8_SB(b, h) ((4 + (b) * 2 + (h)) * HTB)
#define G8_DMA(gp, off) __builtin_amdgcn_global_load_lds((const unsigned*)(gp), (LAS unsigned*)(lds + (off)), 16, 0, 0)
#define G8_STAGE(bufoff, base, v) do { const char* _p = (base); G8_DMA(_p + (v), (bufoff) + ldsw); G8_DMA(_p + (size_t)64 * LD + (v), (bufoff) + ldsw + 8192); } while (0)
#define G8_LDA(dst, b, h) do { if constexpr (FP8) { _Pragma("unroll") for (int m = 0; m < 4; ++m) { const v4i lo_ = *(const LAS v4i*)(lds + G8_SA(b, h) + aoff + m * 2048), hi_ = *(const LAS v4i*)(lds + G8_SA(b, h) + aoff + m * 2048 + 16); dst##8[m] = __builtin_shufflevector(lo_, hi_, 0, 1, 2, 3, 4, 5, 6, 7); } } \
        else { _Pragma("unroll") for (int m = 0; m < 4; ++m) _Pragma("unroll") for (int k = 0; k < 2; ++k) dst[m][k] = *(const LAS bf16x8*)(lds + G8_SA(b, h) + aoff + m * 2048 + k * 1024); } } while (0)
#define G8_LDB(dst, b, h) do { if constexpr (FP8) { _Pragma("unroll") for (int n = 0; n < 2; ++n) { const v4i lo_ = *(const LAS v4i*)(lds + G8_SB(b, h) + boff + n * 2048), hi_ = *(const LAS v4i*)(lds + G8_SB(b, h) + boff + n * 2048 + 16); dst##8[n] = __builtin_shufflevector(lo_, hi_, 0, 1, 2, 3, 4, 5, 6, 7); } } \
        else { _Pragma("unroll") for (int n = 0; n < 2; ++n) _Pragma("unroll") for (int k = 0; k < 2; ++k) dst[n][k] = *(const LAS bf16x8*)(lds + G8_SB(b, h) + boff + n * 2048 + k * 1024); } } while (0)
#define G8_MMA(ai, bj, At, Bt) do { __builtin_amdgcn_s_setprio(1); _Pragma("unroll") for (int m = 0; m < 4; ++m) _Pragma("unroll") for (int n = 0; n < 2; ++n) { \
        if constexpr (FP8) asm volatile("v_mfma_f32_16x16x128_f8f6f4 %0, %1, %2, %0" : "+v"(acc[ai][bj][m][n]) : "v"(Bt##8[n]), "v"(At##8[m]));   \
        else { _Pragma("unroll") for (int k = 0; k < 2; ++k) acc[ai][bj][m][n] = __builtin_amdgcn_mfma_f32_16x16x32_bf16(Bt[n][k], At[m][k], acc[ai][bj][m][n], 0, 0, 0); } } \
        __builtin_amdgcn_s_setprio(0); } while (0)
#define G8_WAIT_V(n) asm volatile("s_waitcnt vmcnt(" #n ")" ::: "memory")
#define G8_WAIT_L(n) asm volatile("s_waitcnt lgkmcnt(" #n ")" ::: "memory")
#define G8_BAR __builtin_amdgcn_s_barrier()
#define G8_SCHED __builtin_amdgcn_sched_barrier(0)
    Unit cur, nxt; int ui = 0;
    if (!S.next(0, cur)) return;
    f32x4 acc[2][2][4][2];
#pragma unroll
    for (int a = 0; a < 2; ++a)
#pragma unroll
        for (int b = 0; b < 2; ++b)
#pragma unroll
            for (int m = 0; m < 4; ++m)
#pragma unroll
                for (int n = 0; n < 2; ++n) acc[a][b][m][n] = (f32x4){0.f, 0.f, 0.f, 0.f};
    bf16x8 At[4][2], B0[2][2], B1[2][2]; v8i At8[4], B08[2], B18[2];
    const unsigned vA = (unsigned)R0 * LD + c2, vB = (unsigned)Rb0 * LD + c2;
    constexpr size_t hS = (size_t)HALF * LD;
    {
        if constexpr (SP2) {
            G8_STAGE(G8_SB(0, 0), cur.B, vB); G8_STAGE(G8_SB(0, 1), cur.B + hS, vB); G8_STAGE(G8_SA(0, 0), cur.A, vA); G8_STAGE(G8_SA(0, 1), cur.A + hS, vA);
            if (wr == 1) G8_BAR;
            G8_WAIT_V(2); G8_BAR;
        } else {
            G8_STAGE(G8_SB(0, 0), cur.B, vB); G8_STAGE(G8_SA(0, 0), cur.A, vA); G8_STAGE(G8_SB(0, 1), cur.B + hS, vB); G8_STAGE(G8_SA(0, 1), cur.A + hS, vA);
            if (wr == 1) G8_BAR;
            G8_WAIT_V(4); G8_BAR;
        }
        G8_STAGE(G8_SB(1, 0), cur.B + 128, vB); G8_STAGE(G8_SA(1, 0), cur.A + 128, vA); G8_STAGE(G8_SB(1, 1), cur.B + hS + 128, vB);
        G8_WAIT_V(6); G8_BAR;
    }
    for (;;) {
        const bool has_next = S.next(ui + 1, nxt);
        if (!has_next) nxt = cur;
        const int nt = cur.nt;
        for (int t = 0; t < nt; t += 2) {
            const bool last = (t == nt - 2);
            const char* a1 = cur.A + (size_t)(t + 1) * 128 + hS;
            const char* a2 = last ? nxt.A : cur.A + (size_t)(t + 2) * 128; const char* b2 = last ? nxt.B : cur.B + (size_t)(t + 2) * 128;
            if constexpr (Epi::NAUX > 0) { if (t == 0 && wid < Epi::NAUX) __builtin_amdgcn_global_load_lds((const unsigned*)(E.aux_src(cur, wid) + lane), (LAS unsigned*)(lds + STAGE_BYTES + (ui & 1) * 2048 + wid * 256), 4, 0, 0); }
            if constexpr (SP2) {
            G8_LDB(B0, 0, 0); G8_LDB(B1, 0, 1); G8_SCHED; G8_LDA(At, 0, 0); G8_STAGE(G8_SA(1, 1), a1, vA);
            G8_WAIT_V(8); G8_WAIT_L(0); G8_BAR; G8_MMA(0, 0, At, B0); G8_MMA(0, 1, At, B1); G8_BAR; G8_SCHED;
            G8_LDA(At, 0, 1); G8_STAGE(G8_SB(0, 0), b2, vB); G8_STAGE(G8_SB(0, 1), b2 + hS, vB); G8_STAGE(G8_SA(0, 0), a2, vA);
            G8_WAIT_V(8); G8_WAIT_L(0); G8_BAR; G8_MMA(1, 0, At, B0); G8_MMA(1, 1, At, B1); G8_BAR; G8_SCHED;
            G8_LDB(B0, 1, 0); G8_LDB(B1, 1, 1); G8_SCHED; G8_LDA(At, 1, 0); G8_STAGE(G8_SA(0, 1), a2 + hS, vA);
            G8_WAIT_V(8); G8_WAIT_L(0); G8_BAR; G8_MMA(0, 0, At, B0); G8_MMA(0, 1, At, B1); G8_BAR; G8_SCHED;
            G8_LDA(At, 1, 1); G8_STAGE(G8_SB(1, 0), b2 + 128, vB); G8_STAGE(G8_SB(1, 1), b2 + hS + 128, vB); G8_STAGE(G8_SA(1, 0), a2 + 128, vA);
            G8_WAIT_V(8); G8_WAIT_L(0); G8_BAR; G8_MMA(1, 0, At, B0); G8_MMA(1, 1, At, B1); G8_BAR; G8_SCHED;
            } else {
            G8_LDB(B0, 0, 0); G8_SCHED; G8_LDA(At, 0, 0); G8_STAGE(G8_SA(1, 1), a1, vA);
            G8_WAIT_L(8); G8_BAR; G8_WAIT_L(0); G8_MMA(0, 0, At, B0); G8_BAR; G8_SCHED;
            G8_LDB(B1, 0, 1); G8_STAGE(G8_SB(0, 0), b2, vB);
            G8_BAR; G8_WAIT_L(0); G8_MMA(0, 1, At, B1); G8_BAR;
            G8_LDA(At, 0, 1); G8_STAGE(G8_SA(0, 0), a2, vA);
            G8_BAR; G8_WAIT_L(0); G8_MMA(1, 0, At, B0); G8_BAR; G8_SCHED;
            G8_STAGE(G8_SB(0, 1), b2 + hS, vB);
            G8_WAIT_V(6); G8_BAR; G8_MMA(1, 1, At, B1); G8_BAR;
            G8_LDB(B0, 1, 0); G8_SCHED; G8_LDA(At, 1, 0); G8_STAGE(G8_SA(0, 1), a2 + hS, vA);
            G8_WAIT_L(8); G8_BAR; G8_WAIT_L(0); G8_MMA(0, 0, At, B0); G8_BAR; G8_SCHED;
            G8_LDB(B1, 1, 1); G8_STAGE(G8_SB(1, 0), b2 + 128, vB);
            G8_BAR; G8_WAIT_L(0); G8_MMA(0, 1, At, B1); G8_BAR;
            G8_LDA(At, 1, 1); G8_STAGE(G8_SA(1, 0), a2 + 128, vA);
            G8_BAR; G8_WAIT_L(0); G8_MMA(1, 0, At, B0); G8_BAR; G8_SCHED;
            G8_STAGE(G8_SB(1, 1), b2 + hS + 128, vB);
            G8_WAIT_V(6); G8_BAR; G8_MMA(1, 1, At, B1); G8_BAR;
            }
        }
        if constexpr (ALIGN_EPI) { if (wr == 0) G8_BAR; }
        if constexpr (FP8) asm volatile("s_nop 7\n\ts_nop 7\n\ts_nop 7" ::: "memory");
        const bool keep = E(acc, cur, wr, wc, fr, fq, (const LAS float*)(lds + STAGE_BYTES + (ui & 1) * 2048));
        if (!has_next) break;
        if (!keep)
#pragma unroll
        for (int a = 0; a < 2; ++a)
#pragma unroll
            for (int b = 0; b < 2; ++b)
#pragma unroll
                for (int m = 0; m < 4; ++m)
#pragma unroll
                    for (int n = 0; n < 2; ++n) acc[a][b][m][n] = (f32x4){0.f, 0.f, 0.f, 0.f};
        cur = nxt; ++ui;
        if constexpr (ALIGN_EPI) { if (wr == 1) G8_BAR; }
    }
    G8_WAIT_V(0);
    if constexpr (!ALIGN_EPI) { if (wr == 0) G8_BAR; }
    G8_BAR;
#undef G8_SA
#undef G8_SB
#undef G8_DMA
#undef G8_STAGE
#undef G8_LDA
#undef G8_LDB
#undef G8_MMA
#undef G8_WAIT_V
#undef G8_WAIT_L
#undef G8_BAR
#undef G8_SCHED
}
}

namespace att {
constexpr int D = 128, NW = 8, QBLK = 32, KVBLK = 64;
constexpr float SCALE = 0.088388347648318440f;
constexpr float THR = 5.f;
constexpr int LDQ = 1024, LDK = 256, LDO = 1024;
constexpr size_t SHM_V = KVBLK * D  , SHM_K = KVBLK * D  , NBUF = 3, SHM_ATTN = NBUF * SHM_V + NBUF * SHM_K + NW * 64 * 4 + 48;
#define KSWZ(row, colB) ((row) * 256 + ((colB) ^ (((row) & 7) << 4)))
#define SBAR() __builtin_amdgcn_sched_barrier(0)
#define PIN(a, b) asm volatile("" : "+v"(a), "+v"(b))
__device__ __forceinline__ int crow(int r, int hi) { return (r & 3) + 8 * (r >> 2) + 4 * hi; }
template <bool SC, class RowFn>
__device__ __forceinline__ void wave_rows_out(LAS unsigned char* st, const f32x16* o, const float (&sc)[16], int lane, RowFn fn) {
  const int r32 = lane & 31, hi = lane >> 5; const bool odd = (lane & 1) != 0;
  LAS unsigned char* wp = st + (odd ? (32 + r32 - 1) * 2 : r32 * 2);
#pragma unroll
  for (int r = 0; r < 16; ++r) {
#pragma unroll
    for (int dp = 0; dp < 4; dp += 2) {
      const float s = SC ? sc[r] : 1.f; const float a = o[dp][r] * s, b = o[dp + 1][r] * s; const float recv = sx<1>(odd ? a : b);
      *(LAS unsigned*)(wp + crow(r, hi) * 256 + dp * 64) = cvt_pk_bf16(odd ? recv : a, odd ? b : recv); } }
  asm volatile("s_waitcnt lgkmcnt(0)" ::: "memory");
  const LAS unsigned char* rp = st + (lane >> 4) * 256 + (lane & 15) * 16;
#pragma unroll
  for (int i = 0; i < 8; ++i) fn(4 * i + (lane >> 4), (lane & 15) * 8, *(const LAS u32x4*)(rp + i * 1024));
}
template <class RowFn>
__device__ __forceinline__ void wave_rows_out_i(LAS unsigned char* st, const f32x16* o, int lane, RowFn fn) {
  const int r32 = lane & 31, hi = lane >> 5; const bool odd = (lane & 1) != 0;
  LAS unsigned char* wp = st + (odd ? (32 + r32 - 1) * 2 : r32 * 2);
#pragma unroll
  for (int r = 0; r < 16; ++r) {
#pragma unroll
    for (int dp = 0; dp < 4; dp += 2) {
      const float a = o[dp][r], b = o[dp + 1][r]; const float recv = sx<1>(odd ? a : b);
      *(LAS unsigned*)(wp + crow(r, hi) * 256 + dp * 64) = cvt_pk_bf16(odd ? recv : a, odd ? b : recv); } }
  asm volatile("s_waitcnt lgkmcnt(0)" ::: "memory");
  const LAS unsigned char* rp = st + (lane >> 4) * 256 + (lane & 15) * 16;
#pragma unroll
  for (int i = 0; i < 8; ++i) fn(i, 4 * i + (lane >> 4), (lane & 15) * 8, *(const LAS u32x4*)(rp + i * 1024));
}
__device__ __forceinline__ void partial0(f32x16& p0, f32x16& p1, float& M) {
  float pmax = p0[0]; for (int r = 1; r < 16; ++r) pmax = fmaxf(pmax, p0[r]); for (int r = 0; r < 16; ++r) pmax = fmaxf(pmax, p1[r]);
  { auto rr = __builtin_amdgcn_permlane32_swap(__float_as_uint(pmax), __float_as_uint(pmax), false, false);
    pmax = fmaxf(__uint_as_float(rr[0]), __uint_as_float(rr[1])); }
  M = pmax;
  for (int r = 0; r < 16; ++r) { p0[r] -= M; p1[r] -= M; }
}
template <bool EXP0 = true>
__device__ __forceinline__ void partialSM(f32x16& p0, f32x16& p1, float& m_reg, float& mn, float& alpha) {
  constexpr float C = SCALE * 1.4426950408889634f;
  float pmax = p0[0]; for (int r = 1; r < 16; ++r) pmax = fmaxf(pmax, p0[r]); for (int r = 0; r < 16; ++r) pmax = fmaxf(pmax, p1[r]);
  { auto rr = __builtin_amdgcn_permlane32_swap(__float_as_uint(pmax), __float_as_uint(pmax), false, false);
    pmax = fmaxf(__uint_as_float(rr[0]), __uint_as_float(rr[1])); }
  if (__builtin_expect(__all(pmax - m_reg <= THR / SCALE), 1)) { mn = m_reg; alpha = 1.f; }
  else { mn = fmaxf(m_reg, pmax); alpha = __builtin_amdgcn_exp2f((m_reg - mn) * C); m_reg = mn; }
  float mnC = -mn * C;
  for (int r = 0; r < 16; ++r) p0[r] = fmaf(p0[r], C, mnC); for (int r = 0; r < 16; ++r) p1[r] = fmaf(p1[r], C, mnC);
  if (EXP0) { for (int r = 0; r < 16; ++r) p0[r] = __builtin_amdgcn_exp2f(p0[r]); }
}
__device__ __forceinline__ void finishSM(f32x16& p0, f32x16& p1, float alpha, float& l_reg, bf16x8& pa0, bf16x8& pa1, bf16x8& pa2, bf16x8& pa3) {
  for (int r = 0; r < 16; ++r) p1[r] = __builtin_amdgcn_exp2f(p1[r]);
  float ps = 0; for (int r = 0; r < 16; ++r) ps += p0[r]; for (int r = 0; r < 16; ++r) ps += p1[r];
  { auto rr = __builtin_amdgcn_permlane32_swap(__float_as_uint(ps), __float_as_uint(ps), false, false);
    ps = __uint_as_float(rr[0]) + __uint_as_float(rr[1]); }
  l_reg = l_reg * alpha + ps;
#define PK4(P, BASE, OUT) do { unsigned a0 = cvt_pk_bf16(P[BASE + 0], P[BASE + 1]), a1 = cvt_pk_bf16(P[BASE + 2], P[BASE + 3]);   \
    unsigned b0 = cvt_pk_bf16(P[BASE + 4], P[BASE + 5]), b1 = cvt_pk_bf16(P[BASE + 6], P[BASE + 7]);                              \
    auto r0 = __builtin_amdgcn_permlane32_swap(a0, b0, false, false); auto r1 = __builtin_amdgcn_permlane32_swap(a1, b1, false, false); \
    u32x4 w = {r0[0], r1[0], r0[1], r1[1]}; OUT = *reinterpret_cast<bf16x8*>(&w); } while (0)
  PK4(p0, 0, pa0); PK4(p0, 8, pa1); PK4(p1, 0, pa2); PK4(p1, 8, pa3);
#undef PK4
}
#define KSWZ8(row, cb) ((row) * 128 + ((cb) ^ ((((row) >> 1) & 7) << 4)))
__device__ __forceinline__ void qkt8(f32x16& p0, f32x16& p1, const char* Ks, const v8i (&qr)[2], int r32, int hi) {
  v8i kf[2][2];
#pragma unroll
  for (int kb = 0; kb < 2; ++kb)
#pragma unroll
    for (int t = 0; t < 2; ++t) { const int row = 32 * kb + r32, cb = 64 * t + 32 * hi;
      const v4i lo = *reinterpret_cast<const v4i*>(Ks + KSWZ8(row, cb)), hh = *reinterpret_cast<const v4i*>(Ks + KSWZ8(row, cb + 16));
      kf[kb][t] = __builtin_shufflevector(lo, hh, 0, 1, 2, 3, 4, 5, 6, 7); }
  asm volatile("v_mfma_f32_32x32x64_f8f6f4 %0, %1, %2, 0" : "=&v"(p0) : "v"(kf[0][0]), "v"(qr[0]));
  asm volatile("v_mfma_f32_32x32x64_f8f6f4 %0, %1, %2, 0" : "=&v"(p1) : "v"(kf[1][0]), "v"(qr[0]));
  asm volatile("v_mfma_f32_32x32x64_f8f6f4 %0, %1, %2, %0" : "+v"(p0) : "v"(kf[0][1]), "v"(qr[1]));
  asm volatile("v_mfma_f32_32x32x64_f8f6f4 %0, %1, %2, %0" : "+v"(p1) : "v"(kf[1][1]), "v"(qr[1]));
  asm volatile("s_nop 7\n\ts_nop 7\n\ts_nop 7" ::: "memory");
}
__device__ __forceinline__ int v_st(int k, int c) { const int kk = (k & ~0xC) | ((k & 4) << 1) | ((k & 8) >> 1); return ((kk >> 3) * 4 + (c >> 5)) * 512 + ((kk & 7) * 32 + (c & 31)) * 2; }
__device__ __forceinline__ int v_rd_base(int lane) { return ((lane & 3) << 3) | (((lane >> 2) & 3) << 6) | (((lane >> 4) & 1) << 5) | (((lane >> 5) & 1) << 8); }
constexpr int v_rd_off(int d0, int ks, int half) { return d0 * 512 + ks * 4096 + half * 2048; }
template <int OFF> __device__ __forceinline__ s16x4 tr_read(int vb) {
  s16x4 r; asm volatile("ds_read_b64_tr_b16 %0, %1 offset:%2" : "=&v"(r) : "v"(vb), "i"(OFF) : "memory"); return r;
}
template <int D0> __device__ __forceinline__ void pv_one(f32x16& od, int vb, bf16x8 pa0, bf16x8 pa1, bf16x8 pa2, bf16x8 pa3) {
  const s16x4 l0 = tr_read<v_rd_off(D0, 0, 0)>(vb), h0 = tr_read<v_rd_off(D0, 0, 1)>(vb), l1 = tr_read<v_rd_off(D0, 1, 0)>(vb), h1 = tr_read<v_rd_off(D0, 1, 1)>(vb);
  const s16x4 l2 = tr_read<v_rd_off(D0, 2, 0)>(vb), h2 = tr_read<v_rd_off(D0, 2, 1)>(vb), l3 = tr_read<v_rd_off(D0, 3, 0)>(vb), h3 = tr_read<v_rd_off(D0, 3, 1)>(vb);
  asm volatile("s_waitcnt lgkmcnt(0)" ::: "memory"); SBAR();
#define PK(L, H) (bf16x8){L[0], L[1], L[2], L[3], H[0], H[1], H[2], H[3]}
  od = __builtin_amdgcn_mfma_f32_32x32x16_bf16(pa0, PK(l0, h0), od, 0, 0, 0);
  od = __builtin_amdgcn_mfma_f32_32x32x16_bf16(pa1, PK(l1, h1), od, 0, 0, 0);
  od = __builtin_amdgcn_mfma_f32_32x32x16_bf16(pa2, PK(l2, h2), od, 0, 0, 0);
  od = __builtin_amdgcn_mfma_f32_32x32x16_bf16(pa3, PK(l3, h3), od, 0, 0, 0);
#undef PK
}
__device__ __forceinline__ void pv_d0(f32x16* o, int vb, bf16x8 pa0, bf16x8 pa1, bf16x8 pa2, bf16x8 pa3) {
  pv_one<0>(o[0], vb, pa0, pa1, pa2, pa3); pv_one<1>(o[1], vb, pa0, pa1, pa2, pa3); pv_one<2>(o[2], vb, pa0, pa1, pa2, pa3); pv_one<3>(o[3], vb, pa0, pa1, pa2, pa3);
}
__device__ __forceinline__ void finish8(f32x16& p0, f32x16& p1, v8i& P8) {
  for (int r = 0; r < 16; ++r) p0[r] = __builtin_amdgcn_exp2f(p0[r]); for (int r = 0; r < 16; ++r) p1[r] = __builtin_amdgcn_exp2f(p1[r]);
#pragma unroll
  for (int w = 0; w < 4; ++w) { P8[w] = (int)pk4_fp8(p0[4 * w], p0[4 * w + 1], p0[4 * w + 2], p0[4 * w + 3]); P8[4 + w] = (int)pk4_fp8(p1[4 * w], p1[4 * w + 1], p1[4 * w + 2], p1[4 * w + 3]); }
}
__device__ __forceinline__ void pv8(f32x16* o, const char* Vs, int off0, int off1, const v8i& P8, const char* ones_lds) {
  v8i vf[4];
#pragma unroll
  for (int d0 = 0; d0 < 4; ++d0) { const v4i lo = *reinterpret_cast<const v4i*>(Vs + d0 * 2048 + off0), hh = *reinterpret_cast<const v4i*>(Vs + d0 * 2048 + off1);
    vf[d0] = __builtin_shufflevector(lo, hh, 0, 1, 2, 3, 4, 5, 6, 7); }
  asm volatile("s_nop 4\n\tv_mfma_f32_32x32x64_f8f6f4 %0, %1, %2, %0" : "+v"(o[0]) : "v"(P8), "v"(vf[0]));
  asm volatile("v_mfma_f32_32x32x64_f8f6f4 %0, %1, %2, %0" : "+v"(o[1]) : "v"(P8), "v"(vf[1]));
  asm volatile("v_mfma_f32_32x32x64_f8f6f4 %0, %1, %2, %0" : "+v"(o[2]) : "v"(P8), "v"(vf[2]));
  asm volatile("v_mfma_f32_32x32x64_f8f6f4 %0, %1, %2, %0" : "+v"(o[3]) : "v"(P8), "v"(vf[3]));
  { const v8i ones = *reinterpret_cast<const v8i*>(ones_lds);
  asm volatile("v_mfma_f32_32x32x64_f8f6f4 %0, %1, %2, %0" : "+v"(o[4]) : "v"(P8), "v"(ones)); }
}
#define MFMA8(ACC, A, B) asm volatile("v_mfma_f32_32x32x64_f8f6f4 %0, %1, %2, %0" : "+v"(ACC) : "v"(A), "v"(B))
#define KEEP(x) asm volatile("" :: "v"(x))
#define MFMA8Z(ACC, A, B) asm volatile("v_mfma_f32_32x32x64_f8f6f4 %0, %1, %2, 0" : "=&v"(ACC) : "v"(A), "v"(B))
__device__ __forceinline__ float amax3(float a, float b, float c) { float d; asm("v_max3_f32 %0, %1, %2, %3" : "=v"(d) : "v"(a), "v"(b), "v"(c)); return d; }
constexpr float THR2 = THR * 1.4426950408889634f;
typedef short s16x8 __attribute__((ext_vector_type(8)));
#define MFMA16Z(ACC, A, B) asm volatile("v_mfma_f32_32x32x16_bf16 %0, %1, %2, 0" : "=&v"(ACC) : "v"(A), "v"(B))
__device__ __forceinline__ void set_mf(u32x4& mf, float M, int hi) {
  const float n = -M; const unsigned b0 = __float_as_uint(n) & 0xFFFF0000u; const float r1 = n - __uint_as_float(b0);
  const unsigned b1 = __float_as_uint(r1) & 0xFFFF0000u; const float r2 = r1 - __uint_as_float(b1); const unsigned b2 = __float_as_uint(r2) & 0xFFFF0000u;
  mf.x = hi ? 0u : ((b0 >> 16) | b1); mf.y = hi ? 0u : (b2 >> 16); mf.z = 0u; mf.w = 0u;
}
__device__ __forceinline__ void qk_fin8(f32x16& q0, f32x16& q1, const char* Ks, const v8i (&qr)[2], int r32, int hi, f32x16& p0, f32x16& p1, v8i& P8, const u32x4& mf, const char* one16_lds) {
  v8i kf[2][2];
  const u32x4 one16 = *reinterpret_cast<const u32x4*>(one16_lds);
#pragma unroll
  for (int kb = 0; kb < 2; ++kb)
#pragma unroll
    for (int t = 0; t < 2; ++t) { const int row = 32 * kb + r32, cb = 64 * t + 32 * hi;
      const v4i lo = *reinterpret_cast<const v4i*>(Ks + KSWZ8(row, cb)), hh = *reinterpret_cast<const v4i*>(Ks + KSWZ8(row, cb + 16));
      kf[kb][t] = __builtin_shufflevector(lo, hh, 0, 1, 2, 3, 4, 5, 6, 7); }
  SBAR(); MFMA16Z(q0, one16, mf); MFMA16Z(q1, one16, mf); SBAR();
#pragma unroll
  for (int r = 0; r < 8; ++r) p0[r] = __builtin_amdgcn_exp2f(p0[r]);
  SBAR(); MFMA8(q0, kf[0][0], qr[0]); KEEP(one16); SBAR();
#pragma unroll
  for (int r = 8; r < 16; ++r) p0[r] = __builtin_amdgcn_exp2f(p0[r]);
  SBAR(); MFMA8(q1, kf[1][0], qr[0]); KEEP(kf[0][0]); SBAR();
#pragma unroll
  for (int r = 0; r < 8; ++r) p1[r] = __builtin_amdgcn_exp2f(p1[r]);
  SBAR(); MFMA8(q0, kf[0][1], qr[1]); KEEP(kf[1][0]); SBAR();
#pragma unroll
  for (int r = 8; r < 16; ++r) p1[r] = __builtin_amdgcn_exp2f(p1[r]);
  SBAR(); MFMA8(q1, kf[1][1], qr[1]); KEEP(kf[0][1]); SBAR();
#pragma unroll
  for (int w = 0; w < 4; ++w) { P8[w] = (int)pk4_fp8u(p0[4 * w], p0[4 * w + 1], p0[4 * w + 2], p0[4 * w + 3]); P8[4 + w] = (int)pk4_fp8u(p1[4 * w], p1[4 * w + 1], p1[4 * w + 2], p1[4 * w + 3]); }
  KEEP(kf[1][1]);
  SBAR();
}
__device__ __forceinline__ void pv_sm8(f32x16* o, const char* Vs, int off0, int off1, const v8i& P8, const char* ones_lds, f32x16& p0, f32x16& p1, float& M, u32x4& mf, float* al_l, int r32, int hi) {
  v8i vf[4];
  const v8i ones = *reinterpret_cast<const v8i*>(ones_lds);
#pragma unroll
  for (int d0 = 0; d0 < 4; ++d0) { const v4i lo = *reinterpret_cast<const v4i*>(Vs + d0 * 2048 + off0), hh = *reinterpret_cast<const v4i*>(Vs + d0 * 2048 + off1);
    vf[d0] = __builtin_shufflevector(lo, hh, 0, 1, 2, 3, 4, 5, 6, 7); }
  SBAR(); MFMA8(o[0], P8, vf[0]); SBAR();
  const float t0 = amax3(p0[0], p0[1], p0[2]), t1 = amax3(p0[3], p0[4], p0[5]), t2 = amax3(p0[6], p0[7], p0[8]), t3 = amax3(p0[9], p0[10], p0[11]), t4 = amax3(p0[12], p0[13], p0[14]);
  SBAR(); MFMA8(o[1], P8, vf[1]); KEEP(vf[0]); SBAR();
  const float u0 = amax3(p1[0], p1[1], p1[2]), u1 = amax3(p1[3], p1[4], p1[5]), u2 = amax3(p1[6], p1[7], p1[8]), u3 = amax3(p1[9], p1[10], p1[11]), u4 = amax3(p1[12], p1[13], p1[14]);
  SBAR(); MFMA8(o[2], P8, vf[2]); KEEP(vf[1]); SBAR();
  float pm = amax3(amax3(amax3(t0, t1, t2), amax3(t3, t4, p0[15]), amax3(u0, u1, u2)), amax3(u3, u4, p1[15]), 0.f);
  { auto rr = __builtin_amdgcn_permlane32_swap(__float_as_uint(pm), __float_as_uint(pm), false, false);
    pm = amax3(__uint_as_float(rr[0]), __uint_as_float(rr[1]), 0.f); }
  SBAR(); MFMA8(o[3], P8, vf[3]); KEEP(vf[2]); SBAR();
  MFMA8(o[4], P8, ones); KEEP(vf[3]); SBAR();
  const bool moved = !__all(pm <= THR2);
  KEEP(ones);
  if (__builtin_expect(moved, 0)) {
    const float d = pm, alpha = __builtin_amdgcn_exp2f(-d);
    M += d; set_mf(mf, M, hi);
#pragma unroll
    for (int r = 0; r < 16; ++r) { p0[r] -= d; p1[r] -= d; }
    asm volatile("s_nop 7\n\ts_nop 7\n\ts_nop 7" ::: "memory");
    if (hi == 0) al_l[r32] = alpha; asm volatile("s_waitcnt lgkmcnt(0)" ::: "memory");
    for (int dd = 0; dd < 5; ++dd) for (int r = 0; r < 16; ++r) o[dd][r] *= al_l[crow(r, hi)];
  }
}
__device__ __forceinline__ void attn_dense_body(const unsigned char* __restrict__ Qb, const unsigned char* __restrict__ Kh, const unsigned char* __restrict__ Vt,
                                                bf16_t* __restrict__ Ob, int seq, char* lds, int tid_in) {
  int tid_ = tid_in; asm volatile("" : "+v"(tid_));
  const int tid = tid_, wid = tid >> 6, lane = tid & 63, r32 = lane & 31, hi = lane >> 5;
  char* V_lds = lds; char* K_lds = lds + NBUF * SHM_V;
  float* ws = (float*)(lds + NBUF * SHM_V + NBUF * SHM_K) + wid * 64; float* al_l = ws + 32;
  float M; u32x4 mf; f32x16 o[5] = {}; v8i qr[2];
  const char* ones = lds + NBUF * SHM_V + NBUF * SHM_K + NW * 64 * 4;
  const char* one16 = ones + 32;
  if (tid < 12) ((int*)ones)[tid] = tid < 8 ? 0x38383838 : 0x3F803F80;
  const unsigned char* Qw = Qb + (long)(wid * QBLK + r32) * LDQ + hi * 32;
#pragma unroll
  for (int t = 0; t < 2; ++t) qr[t] = *reinterpret_cast<const v8i*>(Qw + t * 64);
  const int kkey = tid >> 3, kpc = (tid & 7) * 16, kst = KSWZ8(kkey, kpc);
  const int vd = tid >> 2, vst = vd * 64 + (((tid & 3) ^ ((vd >> 2) & 3)) << 4);
  const int vsw = (r32 >> 2) & 3, voff0 = r32 * 64 + (((2 * hi) ^ vsw) << 4), voff1 = r32 * 64 + (((2 * hi + 1) ^ vsw) << 4);
  struct { u32x4 vs0, ks0; } sr_;
  const __amdgpu_buffer_rsrc_t rV = __builtin_amdgcn_make_buffer_rsrc((void*)Vt, (short)0, 0x7fffffff, 0x00020000), rK = __builtin_amdgcn_make_buffer_rsrc((void*)Kh, (short)0, 0x7fffffff, 0x00020000);
  const unsigned vlo = (unsigned)tid * 16u, klo = (unsigned)(kkey * LDK + kpc);
#define SLOAD(k0) do { sr_.vs0 = __builtin_bit_cast(u32x4, __builtin_amdgcn_raw_buffer_load_b128(rV, vlo, (unsigned)(((k0) / KVBLK) * 8192), 0)); \
    sr_.ks0 = __builtin_bit_cast(u32x4, __builtin_amdgcn_raw_buffer_load_b128(rK, klo, (unsigned)((k0) * LDK), 0)); } while (0)
#define SWRITE(b) do { *(u32x4*)(V_lds + (b) * SHM_V + vst) = sr_.vs0; *(u32x4*)(K_lds + (b) * SHM_K + kst) = sr_.ks0; } while (0)
#define SWAIT() asm volatile("s_waitcnt vmcnt(0)" ::: "memory")
  f32x16 pA0, pA1, pB0, pB1; v8i P8; const int NT = seq / KVBLK;
  SLOAD(0); SWAIT(); SWRITE(0); SLOAD(KVBLK); __syncthreads();
  qkt8(pA0, pA1, (const char*)K_lds, qr, r32, hi); partial0(pA0, pA1, M); set_mf(mf, M, hi);
  SWAIT(); SWRITE(1); if (2 < NT) SLOAD(2 * KVBLK); __syncthreads();
  int bt = 1;
#define NXB(b) ((b) == 2 ? 0 : (b) + 1)
  int j = 1;
#define ABLK(Q0, Q1, P0, P1, KB, WB, VB, LT) do { SBAR(); qk_fin8(Q0, Q1, (const char*)K_lds + (KB) * SHM_K, qr, r32, hi, P0, P1, P8, mf, one16); \
    SWAIT(); SWRITE(WB); SLOAD((LT) * KVBLK); SBAR(); pv_sm8(o, V_lds + (VB) * SHM_V, voff0, voff1, P8, ones, Q0, Q1, M, mf, al_l, r32, hi); __syncthreads(); } while (0)
  for (; j + 7 < NT; j += 6) {
    ABLK(pB0, pB1, pA0, pA1, 1, 2, 0, j + 2); ABLK(pA0, pA1, pB0, pB1, 2, 0, 1, j + 3);
    ABLK(pB0, pB1, pA0, pA1, 0, 1, 2, j + 4); ABLK(pA0, pA1, pB0, pB1, 1, 2, 0, j + 5);
    ABLK(pB0, pB1, pA0, pA1, 2, 0, 1, j + 6); ABLK(pA0, pA1, pB0, pB1, 0, 1, 2, j + 7);
  }
#undef ABLK
  for (; j + 1 < NT; j += 2) {
    const int bp = NXB(NXB(bt)), bn = NXB(bt);
    SBAR(); qk_fin8(pB0, pB1, (const char*)K_lds + bt * SHM_K, qr, r32, hi, pA0, pA1, P8, mf, one16);
    SWAIT(); SWRITE(bn); SLOAD((j + 2) * KVBLK); SBAR();
    pv_sm8(o, V_lds + bp * SHM_V, voff0, voff1, P8, ones, pB0, pB1, M, mf, al_l, r32, hi);
    __syncthreads();
    SBAR(); qk_fin8(pA0, pA1, (const char*)K_lds + bn * SHM_K, qr, r32, hi, pB0, pB1, P8, mf, one16);
    SWAIT(); SWRITE(bp); if (j + 3 < NT) SLOAD((j + 3) * KVBLK); SBAR();
    pv_sm8(o, V_lds + bt * SHM_V, voff0, voff1, P8, ones, pA0, pA1, M, mf, al_l, r32, hi);
    __syncthreads();
    bt = bp;
  }
  { const int bp = NXB(NXB(bt));
  SBAR(); qk_fin8(pB0, pB1, (const char*)K_lds + bt * SHM_K, qr, r32, hi, pA0, pA1, P8, mf, one16);
  pv_sm8(o, V_lds + bp * SHM_V, voff0, voff1, P8, ones, pB0, pB1, M, mf, al_l, r32, hi);
  finish8(pB0, pB1, P8); SBAR();
  pv8(o, V_lds + bt * SHM_V, voff0, voff1, P8, ones);
  asm volatile("s_nop 7\n\ts_nop 7\n\ts_nop 7" : "+v"(o[0]), "+v"(o[1]), "+v"(o[2]), "+v"(o[3]), "+v"(o[4]) :: "memory"); }
#undef NXB
  float rli[16];
#pragma unroll
  for (int r = 0; r < 16; ++r) rli[r] = __builtin_amdgcn_rcpf(o[4][r]);
  bf16_t* Ow = Ob + (long)(wid * QBLK) * LDO;
  wave_rows_out<true>((LAS unsigned char*)lds + 65536 + wid * 8192, o, rli, lane, [&](int row, int col8, u32x4 v) { *(u32x4*)(Ow + (long)row * LDO + col8) = v; });
  __syncthreads();
#undef SLOAD
#undef SWRITE
#undef SWAIT
}
#undef KSWZ
#undef KSWZ8
#undef SBAR
}

struct KArgs { const float* in[23]; float* out; unsigned char* ws; };
enum { I_X = 0, I_C, I_CTX, I_CCTX, I_WMOD, I_BMOD, I_WIN, I_BGATE, I_QGAIN, I_KGAIN, I_WAO, I_WFOUR, I_SGUGAIN, I_WSPAT, I_BSPAT, I_WSGUO, I_WOUT, I_WROUTER, I_BROUTER, I_WGU, I_BGU, I_WDN, I_BDN };

typedef __attribute__((address_space(4))) const char* kaptr_t;
__device__ __forceinline__ const float* INP(int i) {
    kaptr_t ka = (kaptr_t)__builtin_amdgcn_kernarg_segment_ptr();
    return (const float*)(const GAS float*)*(const unsigned long long volatile __attribute__((address_space(4)))*)(ka + i * 8);
}
__device__ __forceinline__ float* OUTP() {
    kaptr_t ka = (kaptr_t)__builtin_amdgcn_kernarg_segment_ptr();
    return (float*)(GAS float*)*(const unsigned long long volatile __attribute__((address_space(4)))*)(ka + 23 * 8);
}
struct Frame {
    LAS unsigned char* lds; unsigned char* ws;
    int tid, lane, wave, vcu, G;
};
__device__ __forceinline__ void refresh(Frame& F) {
    int w0 = F.wave; asm volatile("" : "+s"(w0)); int t = (w0 << 6) | lane_id(); asm volatile("" : "+v"(t)); F.tid = t; F.lane = t & 63; F.wave = w0;
    GAS unsigned char* w = (GAS unsigned char*)F.ws; asm volatile("" : "+s"(w)); F.ws = (unsigned char*)w;
    int v = F.vcu; asm volatile("" : "+s"(v)); F.vcu = v;
}
__device__ __forceinline__ int launder_v(int x) { asm volatile("" : "+v"(x)); return x; }
__device__ __forceinline__ int launder_s(int x) { asm volatile("" : "+s"(x)); return x; }
__device__ __forceinline__ int modrow_of(int row) { return row < SEQ ? 0 : (row < NXR ? 1 : 2); }

__device__ __forceinline__ void cvt_item(const float* src, int ldS, bf16_t* dst, int K, int k0, int srccol0, int dstrow0, LAS float* scr, int lane) {
    f32x4 v[16];
#pragma unroll
    for (int it = 0; it < 16; ++it) { const int kk = it * 4 + (lane >> 4), nn = (lane & 15) * 4; v[it] = *(const f32x4*)(src + (size_t)(k0 + kk) * ldS + srccol0 + nn); }
#pragma unroll
    for (int it = 0; it < 16; ++it) { const int kk = it * 4 + (lane >> 4), nn = (lane & 15) * 4; LAS float* s = scr + kk * 65 + nn; s[0] = v[it].x; s[1] = v[it].y; s[2] = v[it].z; s[3] = v[it].w; }
    asm volatile("s_waitcnt lgkmcnt(0)" ::: "memory");
    const int kb = lane & 7;
#pragma unroll
    for (int j = 0; j < 8; ++j) {
        const int n = (lane >> 3) + 8 * j; const LAS float* s = scr + (8 * kb) * 65 + n;
        u32x4 o; o.x = cvt_pk_bf16(s[0], s[65]); o.y = cvt_pk_bf16(s[2 * 65], s[3 * 65]); o.z = cvt_pk_bf16(s[4 * 65], s[5 * 65]); o.w = cvt_pk_bf16(s[6 * 65], s[7 * 65]);
        *(u32x4*)(dst + (size_t)(dstrow0 + n) * K + k0 + 8 * kb) = o;
    }
    asm volatile("s_waitcnt lgkmcnt(0)" ::: "memory");
}

struct CvtDesc { const float* src; unsigned char* dst; int ldS, k0, srccol0, dstrow0; };
__device__ __forceinline__ void cvt_load(const CvtDesc& d, f32x4 (&v)[16], int lane) {
#pragma unroll
    for (int it = 0; it < 16; ++it) { const int kk = it * 4 + (lane >> 4), nn = (lane & 15) * 4; v[it] = *(const f32x4*)(d.src + (size_t)(d.k0 + kk) * d.ldS + d.srccol0 + nn); }
}
__device__ __forceinline__ void cvt_finish(const CvtDesc& d, const f32x4 (&v)[16], LAS float* scr, int lane) {
#pragma unroll
    for (int it = 0; it < 16; ++it) { const int kk = it * 4 + (lane >> 4), nn = (lane & 15) * 4; LAS float* s = scr + kk * 65 + nn; s[0] = v[it].x; s[1] = v[it].y; s[2] = v[it].z; s[3] = v[it].w; }
    asm volatile("s_waitcnt lgkmcnt(0)" ::: "memory");
    const int kb = lane & 7;
#pragma unroll
    for (int j = 0; j < 8; ++j) {
        const int n = (lane >> 3) + 8 * j; const LAS float* s = scr + (8 * kb) * 65 + n;
        u32x2 o; o.x = pk4_fp8(s[0] * 64.f, s[65] * 64.f, s[2 * 65] * 64.f, s[3 * 65] * 64.f); o.y = pk4_fp8(s[4 * 65] * 64.f, s[5 * 65] * 64.f, s[6 * 65] * 64.f, s[7 * 65] * 64.f);
        *(u32x2*)(d.dst + (size_t)(d.dstrow0 + n) * DM + d.k0 + 8 * kb) = o;
    }
    asm volatile("s_waitcnt lgkmcnt(0)" ::: "memory");
}
__device__ __forceinline__ void p0_prologue(Frame& F) {
    const int gw = F.vcu * 8 + F.wave, NGW = F.G * 8;
    LAS float* scr = (LAS float*)(F.lds + F.wave * 16640);
    {
        constexpr int I_IN = 16 * 96, I_SQ = 256, I_S = 128;
        constexpr int PER_L = I_IN + 2 * I_SQ + I_S;
        for (int it = gw; it < DEPTH * PER_L; it += NGW) {
            const int l = it / PER_L; int r = it % PER_L;
            if (r < I_IN) { const int kb = r / 96, nb = r % 96; CvtDesc d; d.src = INP(I_WIN) + (size_t)l * DM * IN_DIM; d.dst = (unsigned char*)(F.ws + WS_WIN) + (size_t)l * IN_DIM * DM; d.ldS = IN_DIM; d.k0 = kb * 64; d.srccol0 = nb * 64; d.dstrow0 = nb * 64;
                f32x4 vv[16]; cvt_load(d, vv, F.lane); cvt_finish(d, vv, scr, F.lane); continue; } r -= I_IN;
            if (r < I_SQ) { const int kb = r / 16, nb = r % 16; cvt_item(INP(I_WAO) + (size_t)l * DM * DM, DM, (bf16_t*)(F.ws + WS_WA) + (size_t)l * DM * DM, DM, kb * 64, nb * 64, nb * 64, scr, F.lane); continue; } r -= I_SQ;
            if (r < I_SQ) { const int kb = r / 16, nb = r % 16; cvt_item(INP(I_WOUT) + (size_t)l * DM * DM, DM, (bf16_t*)(F.ws + WS_WO) + (size_t)l * DM * DM, DM, kb * 64, nb * 64, nb * 64, scr, F.lane); continue; } r -= I_SQ;
            { const int kb = r / 16, nb = r % 16; cvt_item(INP(I_WSGUO) + (size_t)l * 512 * DM, DM, (bf16_t*)(F.ws + WS_WS) + (size_t)l * DM * DM, DM, kb * 64, nb * 64, nb * 64, scr, F.lane); }
        }
    }
    __syncthreads();
    {
        LAS float* red = (LAS float*)F.lds;
        LAS float* sil = (LAS float*)(F.lds + 8192);
        float* MOD = (float*)(F.ws + WS_MOD);
        for (int i = F.tid; i < 3 * DM; i += 512) { const int r = i >> 10, k = i & 1023; const float c = r < 2 ? INP(I_C)[r * DM + k] : INP(I_CCTX)[k]; sil[i] = c * sigmoidf_(c); }
        __syncthreads();
        for (int u = (F.G >= 256 ? (F.vcu < 128 ? F.vcu : DEPTH * 96) : F.vcu); u < DEPTH * 96; u += (F.G >= 256 ? 128 : F.G)) {
            const int l = u / 96, j0 = (u % 96) * 64;
            const float* wm = INP(I_WMOD) + (size_t)l * DM * 6144 + (size_t)(F.wave * 128) * 6144 + j0 + F.lane;
            float a0 = 0.f, a1 = 0.f, a2 = 0.f;
#pragma unroll 32
            for (int kk = 0; kk < 128; ++kk) {
                const float w = wm[(size_t)kk * 6144]; const int k = F.wave * 128 + kk;
                a0 += sil[k] * w; a1 += sil[1024 + k] * w; a2 += sil[2048 + k] * w;
            }
            red[(F.wave * 3 + 0) * 64 + F.lane] = a0; red[(F.wave * 3 + 1) * 64 + F.lane] = a1; red[(F.wave * 3 + 2) * 64 + F.lane] = a2;
            __syncthreads();
            if (F.tid < 192) { const int r = F.tid >> 6, j = F.tid & 63; float sacc = 0.f;
#pragma unroll
                for (int w = 0; w < 8; ++w) sacc += red[(w * 3 + r) * 64 + j];
                MOD[((size_t)l * 3 + r) * 6144 + j0 + j] = sacc + INP(I_BMOD)[(size_t)l * 6144 + j0 + j]; }
            __syncthreads();
        }
    }
    {
        bf16_t* T1 = (bf16_t*)(F.ws + WS_T1); bf16_t* T2 = (bf16_t*)(F.ws + WS_T2); bf16_t* TC = (bf16_t*)(F.ws + WS_TC); bf16_t* WSP = (bf16_t*)(F.ws + WS_WSP);
        const int gt = F.vcu * 512 + F.tid, NGT = F.G * 512;
        for (int i = gt; i < 64 * 256 * 128 / 2; i += NGT) {
            const int n2 = (2 * i) & 127, m = ((2 * i) >> 7) & 255, n1 = (2 * i) >> 15, k2 = m & 127, reim = m >> 7; float v[2];
#pragma unroll
            for (int q = 0; q < 2; ++q) { const int r = (k2 * (n1 + 64 * (n2 + q))) & 8191; float sn, cs; sincospif((float)r * (1.0f / 4096.0f), &sn, &cs); v[q] = (reim ? -sn : cs) * 0.08838834764831845f; }
            ((unsigned*)T1)[i] = cvt_pk_bf16(v[0], v[1]);
        }
        for (int i = gt; i < 128 * 128 / 2; i += NGT) {
            const int j0 = (2 * i) & 127, m = (2 * i) >> 7, ri = j0 >> 6, k1 = m & 63, ro = m >> 6; float v[2];
#pragma unroll
            for (int q = 0; q < 2; ++q) { const int n1 = (j0 + q) & 63; const int r = (k1 * n1) & 63; float sn, cs; sincospif((float)r * (1.0f / 32.0f), &sn, &cs); v[q] = ((ro == ri) ? cs : (ro == 0 ? sn : -sn)) * 0.125f; }
            ((unsigned*)T2)[i] = cvt_pk_bf16(v[0], v[1]);
        }
        for (int i = gt; i < 512 * 256 / 2; i += NGT) {
            const int n = (2 * i) & 255, m = (2 * i) >> 8, k = m & 255, reim = m >> 8; float v[2];
#pragma unroll
            for (int q = 0; q < 2; ++q) { const int r = (k * (n + q)) & 255; float sn, cs; sincospif((float)r * (1.0f / 128.0f), &sn, &cs); v[q] = (reim ? -sn : cs) * 0.0625f; }
            ((unsigned*)TC)[i] = cvt_pk_bf16(v[0], v[1]);
        }
        for (int i = gt; i < 128 * 32; i += NGT) { const int pos = i >> 5, f = i & 31; float sn, cs; sincosf((float)pos * exp2f(-(float)f * (13.287712379549449f / 32.0f)), &sn, &cs);
            ((float*)(F.ws + WS_ROPE))[i] = cs; ((float*)(F.ws + WS_ROPE))[4096 + i] = sn; }
        const float* wsp = INP(I_WSPAT);
        for (int i = gt; i < DEPTH * 4 * 128 * 128 / 2; i += NGT) { const f32x2 v = ((const f32x2*)wsp)[i]; ((unsigned*)WSP)[i] = cvt_pk_bf16(v.x, v.y); }
    }
    {
        LAS float* wt = (LAS float*)F.lds;
        LAS float* tb = (LAS float*)(F.lds + 32768);
        if (F.tid < 128) { float s, c; sincospif((float)F.tid * (1.0f / 64.0f), &s, &c); tb[F.tid] = c; tb[128 + F.tid] = s; }
        for (int u = (F.G >= 256 ? F.vcu - 128 : F.vcu); u < DEPTH * 4 * 16; u += F.G) {
            if (u < 0) continue;
            const int l = u / 64, g = (u / 16) & 3, d0 = (u & 15) * 64;
            __syncthreads();
            for (int i = F.tid; i < 128 * 64; i += 512) { const int m = i >> 6, d = i & 63; wt[i] = INP(I_WFOUR)[((size_t)l * 512 + g * 128 + m) * DM + d0 + d]; }
            __syncthreads();
            const int c = F.tid & 127, dq = F.tid >> 7;
            float ar[16], ai[16];
#pragma unroll
            for (int i = 0; i < 16; ++i) { ar[i] = 0.f; ai[i] = 0.f; }
            for (int m = 0; m < 128; ++m) {
                const int r = (m * c) & 127; const float cs = tb[r], sn = tb[128 + r];
#pragma unroll
                for (int i = 0; i < 16; ++i) { const float w = wt[m * 64 + dq * 16 + i]; ar[i] += cs * w; ai[i] += sn * w; }
            }
            bf16_t* W = (bf16_t*)(F.ws + WS_WFP) + (size_t)l * DM * DM;
            const bool oddc = (c & 1) != 0;
#pragma unroll
            for (int i = 0; i < 16; ++i) { const size_t rowo = (size_t)(d0 + dq * 16 + i) * DM;
                const float a = ar[i] * 0.08838834764831845f, b = ai[i] * 0.08838834764831845f; const float recv = sx<1>(oddc ? a : b);
                *(unsigned*)(W + rowo + (oddc ? 512 : 0) + g * 128 + (c & ~1)) = cvt_pk_bf16(oddc ? recv : a, oddc ? b : recv); }
        }
    }
}

constexpr int MOE_ITEMS = NEXP * (512 + 256);
__device__ __forceinline__ CvtDesc moe_cvt_desc(Frame& F, int l, int it) {
    CvtDesc d; const int e = it / 768; int r = it % 768;
    if (r < 512) { const int kb = r / 32, nb = r % 32;
        const int T = nb >> 2, half = (nb >> 1) & 1, i0 = (nb & 1) * 64;
        d.src = INP(I_WGU) + ((size_t)l * NEXP + e) * DM * 2048; d.ldS = 2048; d.dst = (unsigned char*)(F.ws + WS_WGU) + ((size_t)l * NEXP + e) * 2048 * DM; d.k0 = kb * 64; d.srccol0 = half * 1024 + T * 128 + i0; d.dstrow0 = nb * 64; }
    else { r -= 512; const int kb = r / 16, nb = r % 16;
        d.src = INP(I_WDN) + ((size_t)l * NEXP + e) * DM * DM; d.ldS = DM; d.dst = (unsigned char*)(F.ws + WS_WDN) + ((size_t)l * NEXP + e) * DM * DM; d.k0 = kb * 64; d.srccol0 = nb * 64; d.dstrow0 = nb * 64; }
    return d;
}
struct FillCur { int c0, c1;
    __device__ __forceinline__ int get(int l) const { return l == 0 ? c0 : c1; }
    __device__ __forceinline__ void add(int l, int n) { if (l == 0) c0 += n; else c1 += n; } };
__device__ __forceinline__ void fill_range(Frame& F, int lay, int lo, int hi, int widx, int nw) {
    LAS float* scr = (LAS float*)(F.lds + F.wave * 16640);
    int it = lo + widx; if (it >= hi) return;
    f32x4 va[16], vb[16]; CvtDesc da = moe_cvt_desc(F, lay, it), db = da;
    cvt_load(da, va, F.lane);
    for (;;) {
        const bool hb = it + nw < hi; if (hb) { db = moe_cvt_desc(F, lay, it + nw); cvt_load(db, vb, F.lane); }
        cvt_finish(da, va, scr, F.lane); if (!hb) break;
        const bool ha = it + 2 * nw < hi; if (ha) { da = moe_cvt_desc(F, lay, it + 2 * nw); cvt_load(da, va, F.lane); }
        cvt_finish(db, vb, scr, F.lane); if (!ha) break;
        it += 2 * nw;
    }
}
__device__ __forceinline__ void fill_after(Frame& F, FillCur& C, int lmin, int total, int c, int per_wave) {
    const int rem = total % F.G; if (rem == 0) return;
    const int n_idle = F.G - rem, nw = n_idle * 8; int budget = nw * per_wave;
    const bool idle = c >= rem; const int widx = (c - rem) * 8 + F.wave;
#pragma unroll
    for (int lay = 0; lay < DEPTH; ++lay) { if (lay < lmin) continue;
        const int cu = C.get(lay), take = (MOE_ITEMS - cu < budget) ? MOE_ITEMS - cu : budget;
        if (take > 0) { if (idle) fill_range(F, lay, cu, cu + take, widx, nw); C.add(lay, take); budget -= take; } }
}
__device__ __forceinline__ void fill_cleanup(Frame& F, FillCur& C, int lay) {
    const int cu = C.get(lay); if (cu < MOE_ITEMS) { fill_range(F, lay, cu, MOE_ITEMS, F.vcu * 8 + F.wave, F.G * 8); C.add(lay, MOE_ITEMS - cu); }
}

__device__ __forceinline__ void p_norm1(Frame& F, int l, int nrows) {
    const int gw = F.vcu * 8 + F.wave, NGW = F.G * 8;
    const float* MOD = (const float*)(F.ws + WS_MOD) + (size_t)l * 3 * 6144;
#define N1_SRC(r_) ((const f32x4*)((l == 0) ? ((r_) < NXR ? INP(I_X) + (size_t)(r_) * DM : INP(I_CTX) + (size_t)((r_) - NXR) * DM) : (const float*)(F.ws + WS_XW) + (size_t)(r_) * DM) + F.lane)
    f32x4 nv[4] = {};
    if (gw < nrows) { const f32x4* xr = N1_SRC(gw);
#pragma unroll
        for (int j = 0; j < 4; ++j) nv[j] = xr[64 * j]; }
    for (int row = gw; row < nrows; row += NGW) {
        f32x4 v[4]; float ss = 0.f;
#pragma unroll
        for (int j = 0; j < 4; ++j) v[j] = nv[j];
        const float* md = MOD + (size_t)modrow_of(row) * 6144;
        f32x4 sh[4], sc[4];
#pragma unroll
        for (int j = 0; j < 4; ++j) { const int c = 4 * F.lane + 256 * j; sh[j] = *(const f32x4*)(md + c); sc[j] = *(const f32x4*)(md + 1024 + c); }
        __builtin_amdgcn_sched_barrier(0);
        if (row + NGW < nrows) { const f32x4* xr = N1_SRC(row + NGW);
#pragma unroll
            for (int j = 0; j < 4; ++j) nv[j] = xr[64 * j]; }
        __builtin_amdgcn_sched_barrier(0);
#pragma unroll
        for (int j = 0; j < 4; ++j) ss += (v[j].x * v[j].x + v[j].y * v[j].y) + (v[j].z * v[j].z + v[j].w * v[j].w);
        const float rstd = rsqrtf(wave_sum(ss) * (1.f / DM) + EPS);
        unsigned* o = (unsigned*)((unsigned char*)(F.ws + WS_HX8) + (size_t)row * DM) + F.lane;
#pragma unroll
        for (int j = 0; j < 4; ++j) { const f32x4 h = v[j] * rstd * (sc[j] + 1.0f) + sh[j]; o[64 * j] = pk4_fp8(h.x, h.y, h.z, h.w); }
    }
#undef N1_SRC
}

struct SchedIn {
    const char* A; const char* B; int G, c, nxt_total, last;
    __device__ __forceinline__ bool next(int i, g8::Unit& u) const {
        const int L = i * G + c; if (L >= nxt_total) return false;
        int pm, pn;
        if (L < 64 * 24) g8::tile_order(L, 64, 24, pm, pn);
        else { const int r = L - 64 * 24; if (last) { pm = 64 + (r >> 1); pn = 4 + (r & 1); } else { pm = 64 + r / 24; pn = r % 24; } }
        u.A = A + (size_t)pm * 256 * 1024; u.B = B + (size_t)pn * 256 * 1024; u.nt = 8; u.pm = pm; u.pn = pn; u.aux = 0; return true;
    }
};
struct EpiIn {
    static constexpr bool PERM = true; static constexpr int NAUX = 0;
    bf16_t* PX; bf16_t* GT; const float* bgate;
    __device__ __forceinline__ bool operator()(f32x4 (&acc)[2][2][4][2], const g8::Unit& u, int wr, int wc, int fr, int fq, const LAS float* aux) const {
        const int row0 = u.pm * 256 + wr * 64 + fr; const bool gates = u.pn >= 12;
        bf16_t* base = gates ? GT : PX; const int colt = (gates ? u.pn - 12 : u.pn) * 256, col0 = colt + wc * 32 + 8 * fq;
        f32x4 bv[2][2];
#pragma unroll
        for (int bj = 0; bj < 2; ++bj)
#pragma unroll
            for (int n = 0; n < 2; ++n) bv[bj][n] = gates ? *(const f32x4*)(bgate + col0 + bj * 128 + 4 * n) : (f32x4){0.f, 0.f, 0.f, 0.f};
#pragma unroll
        for (int ai = 0; ai < 2; ++ai)
#pragma unroll
            for (int m = 0; m < 4; ++m) { bf16_t* rowp = base + (size_t)(row0 + ai * 128 + m * 16) * 3072 + col0;
#pragma unroll
                for (int bj = 0; bj < 2; ++bj) { f32x4 v0 = acc[ai][bj][m][0] * 0.015625f + bv[bj][0], v1 = acc[ai][bj][m][1] * 0.015625f + bv[bj][1];
                    if (gates) {
#pragma unroll
                        for (int j = 0; j < 4; ++j) { v0[j] = sigmoidf_(v0[j]); v1[j] = sigmoidf_(v1[j]); } }
                    u32x4 w; w.x = cvt_pk_bf16(v0[0], v0[1]); w.y = cvt_pk_bf16(v0[2], v0[3]); w.z = cvt_pk_bf16(v1[0], v1[1]); w.w = cvt_pk_bf16(v1[2], v1[3]);
                    *(u32x4*)(rowp + bj * 128) = w; } }
        return false;
    }
};

__device__ __forceinline__ void p_postproj(Frame& F, int l, int nrows) {
    const int gw = F.vcu * 8 + F.wave, NGW = F.G * 8, L = F.lane, hs = L >> 4, j = L & 15;
    const bf16_t* PX = (const bf16_t*)(F.ws + WS_PX);
    const float* qg = INP(I_QGAIN) + l * 128 + 8 * j; const float* kg = INP(I_KGAIN) + l * 128 + 8 * j; const float* sg = INP(I_SGUGAIN) + l * 512 + hs * 128 + 8 * j;
    float qgv[8], kgv[8], sgv[8];
#pragma unroll
    for (int i = 0; i < 8; ++i) { qgv[i] = qg[i]; kgv[i] = kg[i]; sgv[i] = sg[i]; }
    const int ax = j >> 3, half = (j >> 2) & 1, f0 = 8 * (j & 3);
    const float* RC = (const float*)(F.ws + WS_ROPE);
#define PP_LOAD(r_, a0, a1, a2, a3) do { const bf16_t* p_ = PX + (size_t)(r_) * PXW; a0 = *(const u32x4*)(p_ + hs * 128 + 8 * j); a1 = *(const u32x4*)(p_ + (4 + hs) * 128 + 8 * j); \
        if (hs < 2) a2 = *(const u32x4*)(p_ + K_OFF + hs * 128 + 8 * j);   a3 = *(const u32x4*)(p_ + VG_OFF + hs * 128 + 8 * j); } while (0)
#define PP_RC(r_) do { const bool isx_ = (r_) < NXR; const int s_ = isx_ ? ((r_) & 8191) : (((r_) - NXR) & 255); const int pos_ = isx_ ? (ax ? (s_ & 63) : (s_ >> 6)) : 0; \
        nc0 = *(const f32x4*)(RC + pos_ * 32 + f0); nc1 = *(const f32x4*)(RC + pos_ * 32 + f0 + 4); ns0 = *(const f32x4*)(RC + 4096 + pos_ * 32 + f0); ns1 = *(const f32x4*)(RC + 4096 + pos_ * 32 + f0 + 4); } while (0)
    u32x4 nq0 = {}, nq1 = {}, nkv = {}, nvg = {}; f32x4 nc0 = {}, nc1 = {}, ns0 = {}, ns1 = {};
    if (gw < nrows) { PP_LOAD(gw, nq0, nq1, nkv, nvg); PP_RC(gw); }
    for (int row = gw; row < nrows; row += NGW) {
        const bool isx = row < NXR; const int b = isx ? (row >> 13) : ((row - NXR) >> 8), s = isx ? (row & 8191) : ((row - NXR) & 255);
        const int pos = isx ? (ax ? (s & 63) : (s >> 6)) : 0;
        float cs[8], sn[8];
        { const f32x4 c0 = nc0, c1 = nc1, s0 = ns0, s1 = ns1; (void)pos;
#pragma unroll
          for (int i = 0; i < 4; ++i) { cs[i] = c0[i]; cs[4 + i] = c1[i]; sn[i] = half ? s0[i] : -s0[i]; sn[4 + i] = half ? s1[i] : -s1[i]; } }
        const bf16_t* pr = PX + (size_t)row * PXW;
        const size_t krow = (size_t)b * LK + (isx ? s : SEQ + s);
        const u32x4 wq0 = nq0, wq1 = nq1, wkv = nkv, wvg = nvg; (void)pr;
        if (row + NGW < nrows) { PP_LOAD(row + NGW, nq0, nq1, nkv, nvg); PP_RC(row + NGW); }
#pragma unroll
        for (int p = 0; p < 4; ++p) {
            const u32x4 w = p == 0 ? wq0 : p == 1 ? wq1 : p == 2 ? wkv : wvg;
            float v[8] = {bf_lo(w.x), bf_hi(w.x), bf_lo(w.y), bf_hi(w.y), bf_lo(w.z), bf_hi(w.z), bf_lo(w.w), bf_hi(w.w)};
            if (p == 3) {
#pragma unroll
                for (int i = 0; i < 8; ++i) v[i] = gelu_tanh(v[i]); }
            float ss = 0.f;
#pragma unroll
            for (int i = 0; i < 8; ++i) ss += v[i] * v[i];
            ss += sx<1>(ss); ss += sx<2>(ss); ss += sx<4>(ss); ss += sx<8>(ss);
            const float rstd = rsqrtf(ss * (1.f / 128.f) + EPS);
            const bool plain = (p == 2 && hs >= 2);
            const bool rope = isx && (p < 2 || (p == 2 && hs < 2));
            float o[8];
#pragma unroll
            for (int i = 0; i < 8; ++i) { const float gn = p < 2 ? qgv[i] : p == 2 ? kgv[i] : sgv[i]; o[i] = v[i] * rstd * gn; }
            if (p < 3) {
#pragma unroll
                for (int i = 0; i < 8; ++i) { const float pa = sx<4>(o[i]); if (rope) o[i] = o[i] * cs[i] + pa * sn[i]; } }
            const bool f8 = p < 2 || (p == 2 && hs < 2);
            const float qs = p < 2 ? att::SCALE * 1.4426950408889634f : 1.f;
            u32x2 q8; q8.x = pk4_fp8(o[0] * qs, o[1] * qs, o[2] * qs, o[3] * qs); q8.y = pk4_fp8(o[4] * qs, o[5] * qs, o[6] * qs, o[7] * qs);
            u32x4 q; q.x = plain ? w.x : cvt_pk_bf16(o[0], o[1]); q.y = plain ? w.y : cvt_pk_bf16(o[2], o[3]); q.z = plain ? w.z : cvt_pk_bf16(o[4], o[5]); q.w = plain ? w.w : cvt_pk_bf16(o[6], o[7]);
            if (f8) { unsigned char* d8 = p == 0 ? (unsigned char*)(F.ws + WS_QN) + (size_t)row * DM + hs * 128 : p == 1 ? (unsigned char*)(F.ws + WS_QN) + (size_t)row * DM + (4 + hs) * 128
                                         : (unsigned char*)(F.ws + WS_KN) + krow * 256 + hs * 128;
                *(u32x2*)(d8 + 8 * j) = q8; }
            else if (p == 3) *(u32x4*)((bf16_t*)(F.ws + WS_VGN) + (size_t)row * 512 + hs * 128 + 8 * j) = q;
        }
    }
#undef PP_LOAD
#undef PP_RC
}

__device__ __forceinline__ void p_vblocks(Frame& F) {
    LAS unsigned char* T = F.lds;
    const bf16_t* PX = (const bf16_t*)(F.ws + WS_PX);
    const int key = F.tid >> 3, pc = F.tid & 7, w = key & 31, pos = 32 * ((w >> 2) & 1) + 16 * (key >> 5) + (w & 3) + 4 * (w >> 3);
#define VB_LOAD(u_, A, C) do { const int t_ = (u_) % 132, kvh_ = ((u_) / 132) & 1, b_ = (u_) / 264; \
        const size_t row_ = t_ < 128 ? (size_t)b_ * SEQ + 64 * t_ + key : (size_t)NXR + b_ * CTX + 64 * (t_ - 128) + key; \
        const u32x4* src_ = (const u32x4*)(PX + row_ * PXW + V_OFF + kvh_ * 128 + 16 * pc); A = src_[0]; C = src_[1]; } while (0)
    u32x4 na = {}, nc = {};
    if (F.vcu < NB * 2 * 132) VB_LOAD(F.vcu, na, nc);
    for (int u = F.vcu; u < NB * 2 * 132; u += F.G) {
        const u32x4 a = na, c = nc;
        const unsigned q0 = pk4_fp8(bf_lo(a.x), bf_hi(a.x), bf_lo(a.y), bf_hi(a.y)), q1 = pk4_fp8(bf_lo(a.z), bf_hi(a.z), bf_lo(a.w), bf_hi(a.w));
        const unsigned q2 = pk4_fp8(bf_lo(c.x), bf_hi(c.x), bf_lo(c.y), bf_hi(c.y)), q3 = pk4_fp8(bf_lo(c.z), bf_hi(c.z), bf_lo(c.w), bf_hi(c.w));
        __syncthreads();
#pragma unroll
        for (int i = 0; i < 4; ++i) { T[(16 * pc + i) * 64 + pos] = (unsigned char)(q0 >> (8 * i)); T[(16 * pc + 4 + i) * 64 + pos] = (unsigned char)(q1 >> (8 * i));
            T[(16 * pc + 8 + i) * 64 + pos] = (unsigned char)(q2 >> (8 * i)); T[(16 * pc + 12 + i) * 64 + pos] = (unsigned char)(q3 >> (8 * i)); }
        __syncthreads();
        if (u + F.G < NB * 2 * 132) VB_LOAD(u + F.G, na, nc);
        *(u32x4*)((unsigned char*)(F.ws + WS_VN) + (size_t)u * 8192 + F.tid * 16) = *(const LAS u32x4*)(T + F.tid * 16);
    }
#undef VB_LOAD
    __syncthreads();
}

template <int M, int K, class Epi>
__device__ __forceinline__ void lm_unit(Frame& F, const bf16_t* __restrict__ Wm, const bf16_t* __restrict__ in, size_t in_stride, const Epi& E) {
    constexpr int NTL = K / 64;
    constexpr bool HOIST = (M / 32 == 8) && NTL <= 2;
    const int r32 = F.lane & 31, hi = F.lane >> 5;
    bf16x8 pw[NTL][4];
    __syncthreads();
    {
        const int sr = F.tid >> 4, sc = (F.tid & 15) * 8, vst0 = att::v_st(sr, sc), vst1 = att::v_st(32 + sr, sc);
        bf16x8 t0[NTL], t1[NTL];
#pragma unroll
        for (int t = 0; t < NTL; ++t) { t0[t] = *(const bf16x8*)(in + (size_t)(t * 64 + sr) * in_stride + sc); t1[t] = *(const bf16x8*)(in + (size_t)(t * 64 + 32 + sr) * in_stride + sc); }
        if constexpr (HOIST) { const bf16_t* wrow = Wm + (size_t)(F.wave * 32 + r32) * K + hi * 8;
#pragma unroll
            for (int t = 0; t < NTL; ++t)
#pragma unroll
                for (int i = 0; i < 4; ++i) pw[t][i] = *(const bf16x8*)(wrow + t * 64 + 16 * i); }
#pragma unroll
        for (int t = 0; t < NTL; ++t) { *(LAS bf16x8*)(F.lds + t * 16384 + vst0) = t0[t]; *(LAS bf16x8*)(F.lds + t * 16384 + vst1) = t1[t]; }
    }
    __syncthreads();
    const int vb0 = (int)(unsigned)(uintptr_t)F.lds + att::v_rd_base(F.lane);
    for (int rb = F.wave; rb < M / 32; rb += 8) {
        f32x16 o[4] = {};
        const bf16_t* wrow = Wm + (size_t)(rb * 32 + r32) * K + hi * 8;
#pragma unroll
        for (int t = 0; t < NTL; ++t) {
            if constexpr (HOIST) att::pv_d0(o, vb0 + t * 16384, pw[t][0], pw[t][1], pw[t][2], pw[t][3]);
            else { const bf16x8 pa0 = *(const bf16x8*)(wrow + t * 64), pa1 = *(const bf16x8*)(wrow + t * 64 + 16), pa2 = *(const bf16x8*)(wrow + t * 64 + 32), pa3 = *(const bf16x8*)(wrow + t * 64 + 48);
                att::pv_d0(o, vb0 + t * 16384, pa0, pa1, pa2, pa3); }
        }
        if constexpr (HOIST) { const float one[16] = {};
            att::wave_rows_out<false>(F.lds + 65536 + F.wave * 8192, o, one, F.lane, [&](int row, int col8, u32x4 v) { E.rows(rb * 32 + row, col8, v); }); }
        else {
        const bool odd = (F.lane & 1) != 0;
#pragma unroll
        for (int r = 0; r < 16; ++r) { const int row = rb * 32 + att::crow(r, hi);
#pragma unroll
            for (int dp = 0; dp < 4; dp += 2) {
                const float recv = sx<1>(odd ? o[dp][r] : o[dp + 1][r]);
                E(row, odd ? (dp + 1) * 32 + r32 - 1 : dp * 32 + r32, odd ? recv : o[dp][r], odd ? o[dp + 1][r] : recv); } }
        }
    }
}
template <class EpiA, class EpiB>
__device__ __forceinline__ void lm_unit_pair(Frame& F, const bf16_t* __restrict__ WmA, const bf16_t* __restrict__ inA, const EpiA& EA, const bf16_t* __restrict__ WmB, const bf16_t* __restrict__ inB, const EpiB& EB, size_t in_stride, bool hasB) {
    const int r32 = F.lane & 31, hi = F.lane >> 5;
    bf16x8 pw[2][4];
    __syncthreads();
    {
        const int sr = F.tid >> 4, sc = (F.tid & 15) * 8, vst0 = att::v_st(sr, sc), vst1 = att::v_st(32 + sr, sc);
        bf16x8 t0[4], t1[4];
#pragma unroll
        for (int t = 0; t < 4; ++t) { const bf16_t* in = (t < 2 || !hasB) ? inA : inB; const int tt = t & 1;
            t0[t] = *(const bf16x8*)(in + (size_t)(tt * 64 + sr) * in_stride + sc); t1[t] = *(const bf16x8*)(in + (size_t)(tt * 64 + 32 + sr) * in_stride + sc); }
        { const bf16_t* wrow = ((F.wave >> 2) ? WmB : WmA) + (size_t)((F.wave & 3) * 32 + r32) * 128 + hi * 8;
#pragma unroll
            for (int t = 0; t < 2; ++t)
#pragma unroll
                for (int i = 0; i < 4; ++i) pw[t][i] = *(const bf16x8*)(wrow + t * 64 + 16 * i); }
#pragma unroll
        for (int t = 0; t < 4; ++t) { *(LAS bf16x8*)(F.lds + t * 16384 + vst0) = t0[t]; *(LAS bf16x8*)(F.lds + t * 16384 + vst1) = t1[t]; }
    }
    __syncthreads();
    const int pb = F.wave >> 2, rb = F.wave & 3;
    if (pb == 0 || hasB) {
        const int vb0 = (int)(unsigned)(uintptr_t)F.lds + att::v_rd_base(F.lane) + pb * 32768;
        f32x16 o[4] = {};
#pragma unroll
        for (int t = 0; t < 2; ++t) att::pv_d0(o, vb0 + t * 16384, pw[t][0], pw[t][1], pw[t][2], pw[t][3]);
        const bool odd = (F.lane & 1) != 0;
#pragma unroll
        for (int r = 0; r < 16; ++r) { const int row = rb * 32 + att::crow(r, hi);
#pragma unroll
            for (int dp = 0; dp < 4; dp += 2) {
                const float recv = sx<1>(odd ? o[dp][r] : o[dp + 1][r]);
                const int col = odd ? (dp + 1) * 32 + r32 - 1 : dp * 32 + r32; const float v0 = odd ? recv : o[dp][r], v1 = odd ? o[dp + 1][r] : recv;
                if (pb == 0) EA(row, col, v0, v1); else EB(row, col, v0, v1); } }
    }
}
__device__ __forceinline__ unsigned lm_dma_lane_off(int wave, int lane, int i, unsigned in_stride) {
    const int g = wave * 128 + i * 64 + lane, blk = g >> 5, within = g & 31, kk = (blk >> 2) * 8 + (within >> 2), c = (blk & 3) * 32 + (within & 3) * 8;
    const int k = (kk & ~0xC) | ((kk & 4) << 1) | ((kk & 8) >> 1);
    return ((unsigned)k * in_stride + (unsigned)c) * 2u;
}
__device__ __forceinline__ void lm_dma_pair(Frame& F, const bf16_t* inA, const bf16_t* inB, unsigned in_stride, int bufoff, unsigned lo0, unsigned lo1) {
#pragma unroll
    for (int t = 0; t < 4; ++t) { const char* base = (const char*)((t < 2 ? inA : inB) + (size_t)((t & 1) * 64) * in_stride);
        unsigned a0 = lo0, a1 = lo1; asm volatile("" : "+v"(a0), "+v"(a1));
        __builtin_amdgcn_global_load_lds((const unsigned*)(base + a0), (LAS unsigned*)(F.lds + bufoff + t * 16384 + F.wave * 2048), 16, 0, 0);
        __builtin_amdgcn_global_load_lds((const unsigned*)(base + a1), (LAS unsigned*)(F.lds + bufoff + t * 16384 + F.wave * 2048 + 1024), 16, 0, 0); }
}
template <class Epi>
__device__ __forceinline__ void lm_pair_compute(Frame& F, const bf16x8 (&pw)[2][4], int bufoff, const Epi& E) {
    const int r32 = F.lane & 31, hi = F.lane >> 5, pb = F.wave >> 2, rb = F.wave & 3;
    const int vb0 = (int)(unsigned)(uintptr_t)F.lds + bufoff + att::v_rd_base(F.lane) + pb * 32768;
    f32x16 o[4] = {};
#pragma unroll
    for (int t = 0; t < 2; ++t) att::pv_d0(o, vb0 + t * 16384, pw[t][0], pw[t][1], pw[t][2], pw[t][3]);
    __syncthreads();
    const float one[16] = {};
    att::wave_rows_out<false>(F.lds + bufoff + F.wave * 8192, o, one, F.lane, [&](int row, int col8, u32x4 v) { E.rows(rb * 32 + row, col8, v); });
    (void)r32; (void)hi;
}
__device__ __forceinline__ void lm_load_w(Frame& F, bf16x8 (&pw)[2][4], const bf16_t* Wm) {
    const bf16_t* wrow = Wm + (size_t)((F.wave & 3) * 32 + (F.lane & 31)) * 128 + (F.lane >> 5) * 8;
#pragma unroll
    for (int t = 0; t < 2; ++t)
#pragma unroll
        for (int i = 0; i < 4; ++i) pw[t][i] = *(const bf16x8*)(wrow + t * 64 + 16 * i);
}
struct EpiStore2 {
    bf16_t* base; int Mh; size_t s1, s2;
    __device__ __forceinline__ void operator()(int m, int col, float v0, float v1) const {
        const int hi = m >= Mh ? 1 : 0, lo = m - hi * Mh;
        *(unsigned*)(base + (size_t)lo * s1 + (size_t)hi * s2 + col) = cvt_pk_bf16(v0, v1);
    }
    __device__ __forceinline__ void rows(int m, int col8, u32x4 v) const {
        const int hi = m >= Mh ? 1 : 0, lo = m - hi * Mh; *(u32x4*)(base + (size_t)lo * s1 + (size_t)hi * s2 + col8) = v;
    }
};
struct EpiSgu {
    bf16_t* sg; const bf16_t* u; const float* bs;
    __device__ __forceinline__ void operator()(int m, int col, float v0, float v1) const {
        const unsigned w = *(const unsigned*)(u + (size_t)m * PXW + col); const float b = bs[m];
        *(unsigned*)(sg + (size_t)m * DM + col) = cvt_pk_bf16((v0 + b) * gelu_tanh(bf_lo(w)), (v1 + b) * gelu_tanh(bf_hi(w)));
    }
    __device__ __forceinline__ void pre(int rbase, int lane, u32x4 (&uw)[8], float (&ub)[8]) const {
#pragma unroll
        for (int i = 0; i < 8; ++i) { const int m = rbase + 4 * i + (lane >> 4); uw[i] = *(const u32x4*)(u + (size_t)m * PXW + (lane & 15) * 8); ub[i] = bs[m]; }
    }
    __device__ __forceinline__ void rows2(int m, int col8, u32x4 v, u32x4 w, float b) const {
        u32x4 r;
        r.x = cvt_pk_bf16((bf_lo(v.x) + b) * gelu_tanh(bf_lo(w.x)), (bf_hi(v.x) + b) * gelu_tanh(bf_hi(w.x))); r.y = cvt_pk_bf16((bf_lo(v.y) + b) * gelu_tanh(bf_lo(w.y)), (bf_hi(v.y) + b) * gelu_tanh(bf_hi(w.y)));
        r.z = cvt_pk_bf16((bf_lo(v.z) + b) * gelu_tanh(bf_lo(w.z)), (bf_hi(v.z) + b) * gelu_tanh(bf_hi(w.z))); r.w = cvt_pk_bf16((bf_lo(v.w) + b) * gelu_tanh(bf_lo(w.w)), (bf_hi(v.w) + b) * gelu_tanh(bf_hi(w.w)));
        *(u32x4*)(sg + (size_t)m * DM + col8) = r;
    }
    __device__ __forceinline__ void rows(int m, int col8, u32x4 v) const {
        const u32x4 w = *(const u32x4*)(u + (size_t)m * PXW + col8); const float b = bs[m]; u32x4 r;
        r.x = cvt_pk_bf16((bf_lo(v.x) + b) * gelu_tanh(bf_lo(w.x)), (bf_hi(v.x) + b) * gelu_tanh(bf_hi(w.x))); r.y = cvt_pk_bf16((bf_lo(v.y) + b) * gelu_tanh(bf_lo(w.y)), (bf_hi(v.y) + b) * gelu_tanh(bf_hi(w.y)));
        r.z = cvt_pk_bf16((bf_lo(v.z) + b) * gelu_tanh(bf_lo(w.z)), (bf_hi(v.z) + b) * gelu_tanh(bf_hi(w.z))); r.w = cvt_pk_bf16((bf_lo(v.w) + b) * gelu_tanh(bf_lo(w.w)), (bf_hi(v.w) + b) * gelu_tanh(bf_hi(w.w)));
        *(u32x4*)(sg + (size_t)m * DM + col8) = r;
    }
};

constexpr int RT_R = 22, RT_P = 23;
__device__ __forceinline__ void p_route(Frame& F, int l, int nrows, int cbank = 0) {
    LAS float* hsT = (LAS float*)F.lds;
    LAS float* part = (LAS float*)(F.lds + 98304);
    LAS float* lgs = (LAS float*)(F.lds + 122880);
    LAS float* tval = (LAS float*)(F.lds + 122880 + 3072);
    LAS int* tk_e = (LAS int*)(F.lds + LDS_X_OFF);
    LAS float* tk_w = (LAS float*)(F.lds + LDS_X_OFF + 2048);
    LAS int* wcnt = (LAS int*)(F.lds + LDS_X_OFF + 4096);
    LAS int* ebase = (LAS int*)(F.lds + LDS_X_OFF + 4096 + 1024);
    const int chunk = (nrows + F.G - 1) / F.G;
    const int rA = F.vcu * chunk, rB = (rA + chunk < nrows) ? rA + chunk : nrows;
    const int e = F.lane & 31, kh = F.lane >> 5;
    float wreg[64];
    { const float* wr = INP(I_WROUTER) + (size_t)l * DM * NEXP + e;
#pragma unroll
      for (int m = 0; m < 64; ++m) { const int sidx = 128 * F.wave + 2 * m + kh; wreg[m] = wr[(size_t)(4 * (sidx & 255) + (sidx >> 8)) * NEXP]; } }
    const float* MOD = (const float*)(F.ws + WS_MOD) + (size_t)l * 3 * 6144;
    const float* XW = (const float*)(F.ws + WS_XW);
    __syncthreads();
    f32x4 v[3][4] = {};
#define RT_ROWS(r0_) do { const int nr_ = ((r0_) + RT_R < rB) ? RT_R : rB - (r0_); _Pragma("unroll") for (int t = 0; t < 3; ++t) { const int rr = F.wave + 8 * t; if (rr < nr_) { \
        const f32x4* xr = (const f32x4*)(XW + (size_t)((r0_) + rr) * DM) + F.lane; _Pragma("unroll") for (int j = 0; j < 4; ++j) v[t][j] = xr[64 * j]; } } } while (0)
    if (rA < rB) RT_ROWS(rA);
    for (int r0 = rA; r0 < rB; r0 += RT_R) {
        const int nr = (r0 + RT_R < rB) ? RT_R : rB - r0;
        {
#pragma unroll
            for (int t = 0; t < 3; ++t) { const int rr = F.wave + 8 * t;
              if (rr < nr) { const int row = r0 + rr; float ss = 0.f;
                const float* md = MOD + (size_t)modrow_of(row) * 6144;
                f32x4 sh[4], sc[4];
#pragma unroll
                for (int j = 0; j < 4; ++j) { const int c = 4 * F.lane + 256 * j; sh[j] = *(const f32x4*)(md + 3072 + c); sc[j] = *(const f32x4*)(md + 4096 + c); }
#pragma unroll
                for (int j = 0; j < 4; ++j) ss += (v[t][j].x * v[t][j].x + v[t][j].y * v[t][j].y) + (v[t][j].z * v[t][j].z + v[t][j].w * v[t][j].w);
                const float rstd = rsqrtf(wave_sum(ss) * (1.f / DM) + EPS);
                unsigned* o = (unsigned*)((unsigned char*)(F.ws + WS_HX) + (size_t)row * DM) + F.lane;
#pragma unroll
                for (int j = 0; j < 4; ++j) {
                    const f32x4 h = v[t][j] * rstd * (sc[j] + 1.0f) + sh[j]; o[64 * j] = pk4_fp8(h.x, h.y, h.z, h.w);
                    LAS float* d = hsT + (F.lane + 64 * j) * RT_P + rr;
                    d[0] = h.x; d[256 * RT_P] = h.y; d[512 * RT_P] = h.z; d[768 * RT_P] = h.w; } } }
            if (r0 + RT_R < rB) RT_ROWS(r0 + RT_R);
        }
        __syncthreads();
        {
            f32x16 D = {};
            const LAS float* hp = hsT + (128 * F.wave + kh) * RT_P + e;
#pragma unroll
            for (int m0 = 0; m0 < 64; m0 += 8) { float av[8];
#pragma unroll
                for (int q = 0; q < 8; ++q) av[q] = hp[(2 * (m0 + q)) * RT_P];
#pragma unroll
                for (int q = 0; q < 8; ++q) D = __builtin_amdgcn_mfma_f32_32x32x2f32(av[q], wreg[m0 + q], D, 0, 0, 0); }
#pragma unroll
            for (int r = 0; r < 16; ++r) { const int row = (r & 3) + 8 * (r >> 2) + 4 * kh; if (row < nr) part[(row * 8 + F.wave) * 32 + e] = D[r]; }
        }
        __syncthreads();
        for (int i = F.tid; i < nr * 32; i += 512) { const int r = i >> 5, ee = i & 31; float sacc = INP(I_BROUTER)[l * NEXP + ee];
#pragma unroll
            for (int w = 0; w < 8; ++w) sacc += part[(r * 8 + w) * 32 + ee];
            lgs[i] = sacc; }
        __syncthreads();
        for (int i = F.tid; i < nr * 32; i += 512) { const int r = i >> 5, ee = i & 31; const float mine = lgs[i]; int rank = 0;
#pragma unroll
            for (int q = 0; q < 8; ++q) { const f32x4 o4 = *(const LAS f32x4*)(lgs + r * 32 + 4 * q);
                rank += (o4.x > mine || (o4.x == mine && 4 * q + 0 < ee)) ? 1 : 0; rank += (o4.y > mine || (o4.y == mine && 4 * q + 1 < ee)) ? 1 : 0;
                rank += (o4.z > mine || (o4.z == mine && 4 * q + 2 < ee)) ? 1 : 0; rank += (o4.w > mine || (o4.w == mine && 4 * q + 3 < ee)) ? 1 : 0; }
            if (rank < 4) { tk_e[(r0 - rA + r) * 4 + rank] = ee; tval[r * 4 + rank] = mine; } }
        __syncthreads();
        for (int i = F.tid; i < nr * 4; i += 512) { const int r = i >> 2; const f32x4 t4 = *(const LAS f32x4*)(tval + r * 4);
            const float e1 = __expf(t4.y - t4.x), e2 = __expf(t4.z - t4.x), e3 = __expf(t4.w - t4.x), inv = __builtin_amdgcn_rcpf(1.0f + e1 + e2 + e3); const int k = i & 3;
            tk_w[(r0 - rA) * 4 + i] = (k == 0 ? 1.0f : k == 1 ? e1 : k == 2 ? e2 : e3) * inv; }
        __syncthreads();
    }
#undef RT_ROWS
    const int nent = (rB > rA ? rB - rA : 0) * 4;
    const int myent = F.tid < nent ? tk_e[F.tid] : -1; int rank_w = 0;
#pragma unroll 4
    for (int ee = 0; ee < 32; ++ee) { const unsigned long long m = __ballot(myent == ee); if (myent == ee) rank_w = __popcll(m & ((1ull << F.lane) - 1ull)); if (F.lane == 0) wcnt[F.wave * 32 + ee] = __popcll(m); }
    __syncthreads();
    if (F.tid < 32) { int c = 0;
#pragma unroll
        for (int w = 0; w < 8; ++w) { const int t = wcnt[w * 32 + F.tid]; wcnt[w * 32 + F.tid] = c; c += t; }
        unsigned* cnt = (unsigned*)(F.ws + WS_CTL) + CW_CNT + cbank * 4096 + l * 64 + F.tid;
        ebase[F.tid] = c ? (int)__hip_atomic_fetch_add(cnt, (unsigned)c, __ATOMIC_RELAXED, __HIP_MEMORY_SCOPE_AGENT) : 0; }
    __syncthreads();
    LAS int* tk_pos = (LAS int*)(F.lds + LDS_X_OFF + 5632);
    if (F.tid < nent) { const int pos = ebase[myent] + wcnt[F.wave * 32 + myent] + rank_w; const size_t gi = (size_t)rA * 4 + F.tid;
        ((unsigned*)(F.ws + WS_TSLOT))[gi] = ((unsigned)myent << 16) | (unsigned)pos; ((float*)(F.ws + WS_TW))[gi] = tk_w[F.tid]; tk_pos[F.tid] = pos; }
    asm volatile("s_waitcnt vmcnt(0)" ::: "memory");
    __syncthreads();
    {
        u32x4 v[4] = {}; size_t dst[4] = {};
#define RC_LOAD(i0_) _Pragma("unroll") for (int q = 0; q < 4; ++q) { const int i = (i0_) + 8 * q; const bool ok = i < nent; const int ii = ok ? i : (i0_); \
            dst[q] = (size_t)tk_e[ii] * CAPR + tk_pos[ii]; v[q] = ((const u32x4*)((const unsigned char*)(F.ws + WS_HX) + (size_t)(rA + (ii >> 2)) * DM))[F.lane]; }
        if (F.wave < nent) { RC_LOAD(F.wave) }
        for (int i0 = F.wave; i0 < nent; i0 += 32) {
            u32x4 cv[4]; size_t cd[4];
#pragma unroll
            for (int q = 0; q < 4; ++q) { cv[q] = v[q]; cd[q] = dst[q]; }
            if (i0 + 32 < nent) { RC_LOAD(i0 + 32) }
#pragma unroll
            for (int q = 0; q < 4; ++q) { const int i = i0 + 8 * q; if (i < nent) {
                ((u32x4*)((unsigned char*)(F.ws + WS_HXS) + cd[q] * DM))[F.lane] = cv[q];
                if (F.lane == 0) ((float*)(F.ws + WS_WSLOT))[cd[q]] = tk_w[i]; } }
        }
#undef RC_LOAD
    }
    __syncthreads();
}

__device__ __forceinline__ void moe_tables(Frame& F, int l) {
    LAS int* cum = (LAS int*)(F.lds + LDS_X_OFF + 8192); LAS int* texp = (LAS int*)(F.lds + LDS_X_OFF + 8192 + 256); LAS int* ntl = (LAS int*)(F.lds + LDS_X_OFF + 8192 + 256 + 1280);
    __syncthreads();
    if (F.tid < NEXP) { const unsigned* cnt = (const unsigned*)(F.ws + WS_CTL) + CW_CNT + l * 64;
        ntl[F.tid] = ((int)__hip_atomic_load(cnt + F.tid, __ATOMIC_RELAXED, __HIP_MEMORY_SCOPE_AGENT) + 255) >> 8; }
    __syncthreads();
    if (F.tid < NEXP) { int t = 0; for (int e = 0; e < F.tid; ++e) t += ntl[e]; const int n = ntl[F.tid];
        cum[F.tid] = t; if (F.tid == NEXP - 1) cum[NEXP] = t + n;
        for (int i = 0; i < n; ++i) texp[t + i] = F.tid; }
    __syncthreads();
}
__device__ __forceinline__ void p_scatter(Frame& F, int nrows) {
    const LAS int* cum = (const LAS int*)(F.lds + LDS_X_OFF + 8192);
    const int gw = F.vcu * 8 + F.wave, NGW = F.G * 8, nent = nrows * 4;
    for (int i0 = gw * 4; i0 < nent; i0 += NGW * 4) {
        const int row = i0 >> 2;
        const u32x4 ts = *(const u32x4*)((const unsigned*)(F.ws + WS_TSLOT) + i0);
        const f32x4 tw = *(const f32x4*)((const float*)(F.ws + WS_TW) + i0);
        const u32x4 o = ((const u32x4*)((const unsigned char*)(F.ws + WS_HX) + (size_t)row * DM))[F.lane];
#pragma unroll
        for (int k = 0; k < 4; ++k) { const unsigned t = ts[k]; const int slot = cum[t >> 16] * 256 + (int)(t & 0xffff);
            ((u32x4*)((unsigned char*)(F.ws + WS_HXS) + (size_t)slot * DM))[F.lane] = o;
            if (F.lane == 0) ((float*)(F.ws + WS_WSLOT))[slot] = tw[k]; }
    }
}
struct SchedMoe {
    const char* A; const char* B; size_t bstride; int G, c, ncol, total; const LAS int* texp; const LAS int* cum; size_t acap;
    __device__ __forceinline__ bool next(int i, g8::Unit& u) const {
        const int L = i * G + c; if (L >= total) return false;
        const int gt = L / ncol, pn = L % ncol; const int e = __builtin_amdgcn_readfirstlane(texp[gt]);
        const size_t arow = acap ? (size_t)e * acap + (size_t)(gt - __builtin_amdgcn_readfirstlane(cum[e])) * 256 : (size_t)gt * 256;
        u.A = A + arow * 1024; u.B = B + (size_t)e * bstride + (size_t)pn * 256 * 1024; u.nt = 8; u.pm = gt; u.pn = pn; u.aux = e; return true;
    }
};
struct EpiUp {
    static constexpr bool PERM = true; static constexpr int NAUX = 4;
    unsigned char* HID; const float* bgu;
    __device__ __forceinline__ const float* aux_src(const g8::Unit& u, int piece) const { return bgu + (size_t)u.aux * 2048 + (piece >> 1) * 1024 + u.pn * 128 + (piece & 1) * 64; }
    __device__ __forceinline__ bool operator()(f32x4 (&acc)[2][2][4][2], const g8::Unit& u, int wr, int wc, int fr, int fq, const LAS float* aux) const {
        const int row0 = u.pm * 256 + wr * 64 + fr, hl = wc * 32 + 8 * fq, hc0 = u.pn * 128 + hl;
        f32x4 bgt[2], bup[2];
#pragma unroll
        for (int n = 0; n < 2; ++n) { bgt[n] = *(const LAS f32x4*)(aux + hl + 4 * n); bup[n] = *(const LAS f32x4*)(aux + 128 + hl + 4 * n); }
#pragma unroll
        for (int ai = 0; ai < 2; ++ai)
#pragma unroll
            for (int m = 0; m < 4; ++m) { float h[8];
#pragma unroll
                for (int n = 0; n < 2; ++n) {
#pragma unroll
                    for (int jp = 0; jp < 2; ++jp) {
                        const f32x2 ga = {acc[ai][0][m][n][2 * jp], acc[ai][0][m][n][2 * jp + 1]}, ua = {acc[ai][1][m][n][2 * jp], acc[ai][1][m][n][2 * jp + 1]};
                        const f32x2 gb = {bgt[n][2 * jp], bgt[n][2 * jp + 1]}, ub = {bup[n][2 * jp], bup[n][2 * jp + 1]};
                        f32x2 g = ga * 0.015625f + gb, u = ua * 0.015625f + ub;
                        g.x = fminf(g.x, 7.0f); g.y = fminf(g.y, 7.0f); u.x = fminf(fmaxf(u.x, -7.0f), 7.0f); u.y = fminf(fmaxf(u.y, -7.0f), 7.0f);
                        const f32x2 t = g * -2.4554669595930157f;
                        f32x2 d; d.x = __builtin_amdgcn_exp2f(t.x); d.y = __builtin_amdgcn_exp2f(t.y); d = d + 1.0f;
                        f32x2 r; r.x = __builtin_amdgcn_rcpf(d.x); r.y = __builtin_amdgcn_rcpf(d.y);
                        const f32x2 hh = (u * g + g) * r;
                        h[4 * n + 2 * jp] = hh.x; h[4 * n + 2 * jp + 1] = hh.y; } }
                u32x2 w; w.x = pk4_fp8(h[0], h[1], h[2], h[3]); w.y = pk4_fp8(h[4], h[5], h[6], h[7]);
                *(u32x2*)(HID + (size_t)(row0 + ai * 128 + m * 16) * DM + hc0) = w; }
        return false;
    }
};
struct EpiDown {
    static constexpr bool PERM = true; static constexpr int NAUX = 8;
    bf16_t* Y; const float* bdn; const float* wslot; const LAS int* cum;
    __device__ __forceinline__ const float* aux_src(const g8::Unit& u, int piece) const { return piece < 4 ? bdn + (size_t)u.aux * DM + u.pn * 256 + piece * 64 : wslot + (size_t)u.aux * CAPR + (size_t)(u.pm - __builtin_amdgcn_readfirstlane(cum[u.aux])) * 256 + (piece - 4) * 64; }
    __device__ __forceinline__ bool operator()(f32x4 (&acc)[2][2][4][2], const g8::Unit& u, int wr, int wc, int fr, int fq, const LAS float* aux) const {
        const int row0 = u.pm * 256 + wr * 64 + fr, cl = wc * 32 + 8 * fq, col0 = u.pn * 256 + cl;
        f32x4 bv[2][2];
#pragma unroll
        for (int bj = 0; bj < 2; ++bj)
#pragma unroll
            for (int n = 0; n < 2; ++n) bv[bj][n] = *(const LAS f32x4*)(aux + bj * 128 + cl + 4 * n);
#pragma unroll
        for (int ai = 0; ai < 2; ++ai)
#pragma unroll
            for (int m = 0; m < 4; ++m) { const int rl = ai * 128 + wr * 64 + m * 16 + fr; const float wv = aux[256 + rl]; bf16_t* rowp = Y + (size_t)(u.pm * 256 + rl) * DM + col0;
#pragma unroll
                for (int bj = 0; bj < 2; ++bj) { const f32x4 v0 = (acc[ai][bj][m][0] * 0.015625f + bv[bj][0]) * wv, v1 = (acc[ai][bj][m][1] * 0.015625f + bv[bj][1]) * wv;
                    u32x4 w; w.x = cvt_pk_bf16(v0[0], v0[1]); w.y = cvt_pk_bf16(v0[2], v0[3]); w.z = cvt_pk_bf16(v1[0], v1[1]); w.w = cvt_pk_bf16(v1[2], v1[3]);
                    *(u32x4*)(rowp + bj * 128) = w; } }
        (void)row0;
        return false;
    }
};

struct SchedMerge {
    const char* ws; size_t woff; int G, c, nM, total;
    __device__ __forceinline__ bool next(int i, g8::Unit& u) const {
        const int br = i % 3, T = (i / 3) * G + c; if (T >= total) return false;
        int pm, pn; g8::tile_order(T, nM, 4, pm, pn);
        const size_t aoff = WS_ATT + (br > 0 ? (WS_FX - WS_ATT) : 0) + (br > 1 ? (WS_SG - WS_FX) : 0);
        const size_t boff = WS_WA + (br > 0 ? (WS_WFP - WS_WA) : 0) + (br > 1 ? (WS_WS - WS_WFP) : 0);
        u.A = ws + aoff + (size_t)pm * 256 * 2048; u.B = ws + boff + woff + (size_t)pn * 256 * 2048; u.nt = br == 2 ? 8 : 16; u.pm = pm; u.pn = pn; u.aux = br; return true;
    }
};
struct EpiMerge {
    static constexpr bool PERM = true; static constexpr int NAUX = 0;
    const bf16_t* GT; bf16_t* MRG;
    __device__ __forceinline__ bool operator()(f32x4 (&acc)[2][2][4][2], const g8::Unit& u, int wr, int wc, int fr, int fq, const LAS float* aux) const {
        const int row0 = u.pm * 256 + wr * 64 + fr, col0 = u.pn * 256 + wc * 32 + 8 * fq, br = u.aux;
        const bf16_t* gp = GT + (size_t)row0 * 3072 + br * 1024 + col0;
        if (br < 2) {
#pragma unroll
            for (int ai = 0; ai < 2; ++ai) { u32x4 gw[4][2], hw[4][2];
#pragma unroll
                for (int m = 0; m < 4; ++m)
#pragma unroll
                    for (int bj = 0; bj < 2; ++bj) { const bf16_t* p = gp + (size_t)(ai * 128 + m * 16) * 3072 + bj * 128; gw[m][bj] = *(const u32x4*)p; hw[m][bj] = *(const u32x4*)(p + 1024); }
#pragma unroll
                for (int m = 0; m < 4; ++m)
#pragma unroll
                    for (int bj = 0; bj < 2; ++bj) { const u32x4 g4 = gw[m][bj], h4 = hw[m][bj];
                        const float g[8] = {bf_lo(g4.x), bf_hi(g4.x), bf_lo(g4.y), bf_hi(g4.y), bf_lo(g4.z), bf_hi(g4.z), bf_lo(g4.w), bf_hi(g4.w)};
                        const float h[8] = {bf_lo(h4.x), bf_hi(h4.x), bf_lo(h4.y), bf_hi(h4.y), bf_lo(h4.z), bf_hi(h4.z), bf_lo(h4.w), bf_hi(h4.w)};
#pragma unroll
                        for (int j = 0; j < 8; ++j) { const float gg = br > 0 ? fmaxf(g[j], 1e-20f) : g[j]; acc[ai][bj][m][j >> 2][j & 3] *= gg * __builtin_amdgcn_rcpf(fmaxf(h[j], 1e-20f)); } } }
        } else {
            u32x4 gw[2][4][2];
#pragma unroll
            for (int ai = 0; ai < 2; ++ai)
#pragma unroll
                for (int m = 0; m < 4; ++m)
#pragma unroll
                    for (int bj = 0; bj < 2; ++bj) gw[ai][m][bj] = *(const u32x4*)(gp + (size_t)(ai * 128 + m * 16) * 3072 + bj * 128);
#pragma unroll
            for (int ai = 0; ai < 2; ++ai)
#pragma unroll
                for (int m = 0; m < 4; ++m)
#pragma unroll
                    for (int bj = 0; bj < 2; ++bj) { const u32x4 g4 = gw[ai][m][bj];
                        const float g[8] = {bf_lo(g4.x), bf_hi(g4.x), bf_lo(g4.y), bf_hi(g4.y), bf_lo(g4.z), bf_hi(g4.z), bf_lo(g4.w), bf_hi(g4.w)};
                        float v[8];
#pragma unroll
                        for (int j = 0; j < 8; ++j) v[j] = fmaxf(g[j], 1e-20f) * acc[ai][bj][m][j >> 2][j & 3];
                        u32x4 w; w.x = cvt_pk_bf16(v[0], v[1]); w.y = cvt_pk_bf16(v[2], v[3]); w.z = cvt_pk_bf16(v[4], v[5]); w.w = cvt_pk_bf16(v[6], v[7]);
                        *(u32x4*)(MRG + (size_t)(row0 + ai * 128 + m * 16) * DM + col0 + bj * 128) = w; }
        }
        return br < 2;
    }
};
struct SchedPlain {
    const char* A; const char* B; int G, c, nM, nN, nt;
    __device__ __forceinline__ bool next(int i, g8::Unit& u) const {
        const int L = i * G + c; if (L >= nM * nN) return false;
        int pm, pn; g8::tile_order(L, nM, nN, pm, pn);
        u.A = A + (size_t)pm * 256 * 2048; u.B = B + (size_t)pn * 256 * 2048; u.nt = nt; u.pm = pm; u.pn = pn; u.aux = 0; return true;
    }
};
struct EpiOut {
    static constexpr bool PERM = false; static constexpr int NAUX = 0;
    const float* rx; const float* rc; float* XW; const float* mod;
    __device__ __forceinline__ bool operator()(f32x4 (&acc)[2][2][4][2], const g8::Unit& u, int wr, int wc, int fr, int fq, const LAS float* aux) const {
        const int row0 = u.pm * 256 + wr * 64 + fr, col0 = u.pn * 256 + wc * 32 + 4 * fq;
        const float* res = u.pm < 64 ? rx : rc; const float* g1 = mod + (size_t)(u.pm < 32 ? 0 : (u.pm < 64 ? 1 : 2)) * 6144 + 2048;
        f32x4 gv[2][2];
#pragma unroll
        for (int bj = 0; bj < 2; ++bj)
#pragma unroll
            for (int n = 0; n < 2; ++n) gv[bj][n] = *(const f32x4*)(g1 + col0 + bj * 128 + n * 16);
        f32x4 r0[8], r1[8];
#define EO_OFF(gi, mm) ((size_t)(row0 + ((gi) >> 1) * 128 + ((((gi) & 1) << 1) + (mm)) * 16) * DM + col0)
#define EO_LD(r, gi) _Pragma("unroll") for (int mm = 0; mm < 2; ++mm) _Pragma("unroll") for (int bj = 0; bj < 2; ++bj) _Pragma("unroll") for (int n = 0; n < 2; ++n) \
            r[mm * 4 + bj * 2 + n] = *(const f32x4*)(res + EO_OFF(gi, mm) + bj * 128 + n * 16);
#define EO_ST(r, gi) _Pragma("unroll") for (int mm = 0; mm < 2; ++mm) _Pragma("unroll") for (int bj = 0; bj < 2; ++bj) _Pragma("unroll") for (int n = 0; n < 2; ++n) \
            *(f32x4*)(XW + EO_OFF(gi, mm) + bj * 128 + n * 16) = r[mm * 4 + bj * 2 + n] + gv[bj][n] * acc[(gi) >> 1][bj][(((gi) & 1) << 1) + mm][n];
        EO_LD(r0, 0) EO_LD(r1, 1)
        EO_ST(r0, 0) EO_LD(r0, 2)
        EO_ST(r1, 1) EO_LD(r1, 3)
        EO_ST(r0, 2) EO_ST(r1, 3)
#undef EO_OFF
#undef EO_LD
#undef EO_ST
        return false;
    }
};

__device__ __forceinline__ void p_combine(Frame& F, int l, int nrows, bool last) {
    const LAS int* cum = (const LAS int*)(F.lds + LDS_X_OFF + 8192);
    const int gw = F.vcu * 8 + F.wave, NGW = F.G * 8;
    const float* MOD = (const float*)(F.ws + WS_MOD) + (size_t)l * 3 * 6144;
    const bool poison = last && __hip_atomic_load((const unsigned*)(F.ws + WS_CTL) + CW_BAR + XB_TMO, __ATOMIC_RELAXED, __HIP_MEMORY_SCOPE_AGENT) != 0u;
    const float qn = __builtin_nanf("");
    float* outp = last ? OUTP() : (float*)(F.ws + WS_XW);
    const bf16_t* Y = (const bf16_t*)(F.ws + WS_Y);
    const float* MODN = MOD + 3 * 6144;
    u32x4 w[4][2] = {}; f32x4 xv[2][2] = {}, gv[2][2] = {}, shv[2][2] = {}, scv[2][2] = {};
#define CB_ISSUE(r_, ts_, W, XV, GV, SHV, SCV) do { \
        const u32x4* y0 = (const u32x4*)(Y + (size_t)(cum[(ts_).x >> 16] * 256 + (int)((ts_).x & 0xffff)) * DM) + F.lane; \
        const u32x4* y1 = (const u32x4*)(Y + (size_t)(cum[(ts_).y >> 16] * 256 + (int)((ts_).y & 0xffff)) * DM) + F.lane; \
        const u32x4* y2 = (const u32x4*)(Y + (size_t)(cum[(ts_).z >> 16] * 256 + (int)((ts_).z & 0xffff)) * DM) + F.lane; \
        const u32x4* y3 = (const u32x4*)(Y + (size_t)(cum[(ts_).w >> 16] * 256 + (int)((ts_).w & 0xffff)) * DM) + F.lane; \
        _Pragma("unroll") for (int j = 0; j < 2; ++j) { W[0][j] = y0[64 * j]; W[1][j] = y1[64 * j]; W[2][j] = y2[64 * j]; W[3][j] = y3[64 * j]; } \
        const float* xr_ = (const float*)(F.ws + WS_XW) + (size_t)(r_) * DM; const int mr_ = modrow_of(r_); const float* g2_ = MOD + (size_t)mr_ * 6144 + 5120; const float* md_ = MODN + (size_t)mr_ * 6144; \
        _Pragma("unroll") for (int j = 0; j < 2; ++j) { const int c = 8 * F.lane + 512 * j; XV[j][0] = *(const f32x4*)(xr_ + c); XV[j][1] = *(const f32x4*)(xr_ + c + 4); GV[j][0] = *(const f32x4*)(g2_ + c); GV[j][1] = *(const f32x4*)(g2_ + c + 4); \
            if (!last) { SHV[j][0] = *(const f32x4*)(md_ + c); SHV[j][1] = *(const f32x4*)(md_ + c + 4); SCV[j][0] = *(const f32x4*)(md_ + 1024 + c); SCV[j][1] = *(const f32x4*)(md_ + 1024 + c + 4); } } } while (0)
    u32x4 tsn = {};
    if (gw < nrows) { const u32x4 ts0 = *(const u32x4*)((const unsigned*)(F.ws + WS_TSLOT) + (size_t)gw * 4);
        if (gw + NGW < nrows) tsn = *(const u32x4*)((const unsigned*)(F.ws + WS_TSLOT) + (size_t)(gw + NGW) * 4);
        CB_ISSUE(gw, ts0, w, xv, gv, shv, scv); }
    for (int row = gw; row < nrows; row += NGW) {
        const int nrow = row + NGW; const bool hn = nrow < nrows;
        u32x4 ts2 = {}; if (nrow + NGW < nrows) ts2 = *(const u32x4*)((const unsigned*)(F.ws + WS_TSLOT) + (size_t)(nrow + NGW) * 4);
        f32x4 xn[2][2];
#pragma unroll
        for (int j = 0; j < 2; ++j) {
            f32x4 a0 = (f32x4){0.f, 0.f, 0.f, 0.f}, a1 = a0;
#pragma unroll
            for (int k = 0; k < 4; ++k) { const u32x4 q = w[k][j]; a0 += (f32x4){bf_lo(q.x), bf_hi(q.x), bf_lo(q.y), bf_hi(q.y)}; a1 += (f32x4){bf_lo(q.z), bf_hi(q.z), bf_lo(q.w), bf_hi(q.w)}; }
            f32x4 r0 = xv[j][0] + gv[j][0] * a0, r1 = xv[j][1] + gv[j][1] * a1;
            if (poison) { r0 = (f32x4){qn, qn, qn, qn}; r1 = r0; }
            xn[j][0] = r0; xn[j][1] = r1;
        }
        f32x4 sh[2][2], sc[2][2];
#pragma unroll
        for (int j = 0; j < 2; ++j)
#pragma unroll
            for (int q = 0; q < 2; ++q) { sh[j][q] = shv[j][q]; sc[j][q] = scv[j][q]; }
        if (hn) CB_ISSUE(nrow, tsn, w, xv, gv, shv, scv);
#pragma unroll
        for (int j = 0; j < 2; ++j) { const int c = 8 * F.lane + 512 * j; *(f32x4*)(outp + (size_t)row * DM + c) = xn[j][0]; *(f32x4*)(outp + (size_t)row * DM + c + 4) = xn[j][1]; }
        if (!last) {
            float ss = 0.f;
#pragma unroll
            for (int j = 0; j < 2; ++j)
#pragma unroll
                for (int q = 0; q < 2; ++q) ss += (xn[j][q].x * xn[j][q].x + xn[j][q].y * xn[j][q].y) + (xn[j][q].z * xn[j][q].z + xn[j][q].w * xn[j][q].w);
            const float rstd = rsqrtf(wave_sum(ss) * (1.f / DM) + EPS);
#pragma unroll
            for (int j = 0; j < 2; ++j) { const int c = 8 * F.lane + 512 * j;
                const f32x4 h0 = xn[j][0] * rstd * (sc[j][0] + 1.0f) + sh[j][0], h1 = xn[j][1] * rstd * (sc[j][1] + 1.0f) + sh[j][1];
                u32x2 w2; w2.x = pk4_fp8(h0.x, h0.y, h0.z, h0.w); w2.y = pk4_fp8(h1.x, h1.y, h1.z, h1.w);
                *(u32x2*)((unsigned char*)(F.ws + WS_HX8) + (size_t)row * DM + c) = w2; }
        }
        tsn = ts2;
    }
#undef CB_ISSUE
}

#ifndef EPI_ALIGN
#define EPI_ALIGN true
#endif
#ifndef BF_SP2
#define BF_SP2 true
#endif
#ifndef MOE_SP2
#define MOE_SP2 true
#endif
#ifndef DUP
#define DUP 0
#endif
#define REPB(bit, stmt) do { stmt; if (DUP & (bit)) { GRID_BAR(); refresh(F); stmt; } } while (0)
#define REP(bit) for (int rep_ = 0; rep_ < ((DUP & (bit)) ? 2 : 1); ++rep_)
#ifndef PHM
#define PHM 0xffff
#endif
__global__ void __launch_bounds__(512, 2) mk_fwd(KArgs args) {
    extern __shared__ __attribute__((aligned(16))) unsigned char lds_raw[];
    Frame F;
    F.lds = (LAS unsigned char*)lds_raw; F.ws = args.ws;
    F.tid = threadIdx.x; F.lane = F.tid & 63; F.wave = __builtin_amdgcn_readfirstlane(F.tid >> 6);
    F.G = gridDim.x; { const int bx = blockIdx.x; F.vcu = (F.G % 8 == 0) ? (bx % 8) * (F.G / 8) + bx / 8 : bx; }
    volatile LAS unsigned* MISC = (volatile LAS unsigned*)(F.lds + LDS_MISC_OFF);
    for (int u = F.tid; u < (LDS_BYTES - LDS_MISC_OFF) / 4; u += 512) MISC[u] = 0u;
    __syncthreads();
    XcdBarrier bar = xcd_barrier_post((unsigned*)(F.ws + WS_CTL) + CW_BAR, MISC + 8);
    const int bid = (int)blockIdx.x;
#define GRID_BAR() do { XcdBarrier b_ = bar; b_.seam = (unsigned)(__LINE__); asm volatile("" : "+s"(b_.x)); asm volatile("" : "+s"(b_.bar)); asm volatile("" : "+s"(b_.wave)); xcd_barrier(b_); if (DUP & 16384) xcd_barrier(b_); } while (0)

    refresh(F);
    REP(1) if (PHM & 1) p0_prologue(F);
    GRID_BAR();

    FillCur FC; FC.c0 = 0; FC.c1 = 0;
    for (int l_ = 0; l_ < DEPTH; ++l_) {
        const int l = launder_s(l_);
        const bool last = (l == DEPTH - 1);
        const int nrows = last ? NXR : NROW;
        const bf16_t* HX = (const bf16_t*)(F.ws + WS_HX);
        refresh(F);
        if (l == 0) { p_norm1(F, l, NROW); GRID_BAR(); }
        refresh(F);
        REP(4) if (PHM & 4) {
            SchedIn S{(const char*)(F.ws + WS_HX8), (const char*)(F.ws + WS_WIN) + (size_t)l * IN_DIM * DM, F.G, bid, 64 * 24 + (last ? 4 : 48), last ? 1 : 0};
            EpiIn E{(bf16_t*)(F.ws + WS_PX), (bf16_t*)(F.ws + WS_GT), INP(I_BGATE) + (size_t)l * 3072};
            g8::gemm_phase<EpiIn, SchedIn, true, BF_SP2, EPI_ALIGN>(F.lds, S, E, F.tid);
            fill_after(F, FC, l, 64 * 24 + (last ? 4 : 48), bid, 4);
        }
        GRID_BAR();
        refresh(F);
        if (PHM & 8) p_postproj(F, l, NROW);
        refresh(F);
        p_vblocks(F);
        refresh(F);
        if (PHM & 16) {
            const bf16_t* PX = (const bf16_t*)(F.ws + WS_PX);
            for (int u = F.vcu; u < 512; u += F.G) {
                const int n1 = u >> 3, b = (u >> 2) & 1, cb = u & 3;
                EpiStore2 E{(bf16_t*)(F.ws + WS_Y1) + ((size_t)b * 128 * 2 * 64 + n1) * 512 + cb * 128, 128, (size_t)2 * 64 * 512, (size_t)64 * 512};
                lm_unit<256, 128>(F, (const bf16_t*)(F.ws + WS_T1) + (size_t)n1 * 256 * 128, PX + ((size_t)b * SEQ + n1) * PXW + F_OFF + cb * 128, (size_t)64 * PXW, E);
            }
            if (!last) for (int u = (F.G >= 16 ? F.vcu - (F.G - 8) : F.vcu); u < 8; u += F.G) {
                if (u < 0) continue;
                const int b = u >> 2, cb = u & 3;
                EpiStore2 E{(bf16_t*)(F.ws + WS_FX) + (size_t)(NXR + b * CTX) * DM + cb * 128, 256, (size_t)DM, (size_t)512};
                lm_unit<512, 256>(F, (const bf16_t*)(F.ws + WS_TC), PX + (size_t)(NXR + b * CTX) * PXW + F_OFF + cb * 128, (size_t)PXW, E);
            }
        }
        GRID_BAR();
        refresh(F);
        REP(32) if (PHM & 32) {
            const unsigned char* QN = (const unsigned char*)(F.ws + WS_QN); const unsigned char* KN = (const unsigned char*)(F.ws + WS_KN); const unsigned char* VT = (const unsigned char*)(F.ws + WS_VN); bf16_t* ATT = (bf16_t*)(F.ws + WS_ATT);
            REP(8192) for (int u = bid; u < 512; u += F.G) {
                const int b = u >> 8, kvh = (u >> 7) & 1, hq = (u >> 5) & 3, qb = u & 31, h = kvh * 4 + hq;
                const size_t q0 = ((size_t)b * SEQ + qb * 256) * DM + h * 128, k0 = (size_t)b * LK * 256 + kvh * 128;
                att::attn_dense_body(QN + q0, KN + k0, VT + (size_t)((b * 2 + kvh) * 132) * 8192, ATT + q0, LK, (char*)lds_raw, F.tid);
            }
            if (!last) for (int u = bid; u < 16; u += F.G) {
                const int b = u >> 3, h = u & 7, kvh = h >> 2;
                const size_t q0 = (size_t)(NXR + b * CTX) * DM + h * 128, k0 = ((size_t)b * LK + SEQ) * 256 + kvh * 128;
                att::attn_dense_body(QN + q0, KN + k0, VT + (size_t)((b * 2 + kvh) * 132 + 128) * 8192, ATT + q0, CTX, (char*)lds_raw, F.tid);
            }
            refresh(F);
            const unsigned lo0 = lm_dma_lane_off(F.wave, F.lane, 0, 512u), lo1 = lm_dma_lane_off(F.wave, F.lane, 1, 512u);
            {
                const bf16_t* T2 = (const bf16_t*)(F.ws + WS_T2);
#define P2_IN(uu) ((const bf16_t*)(F.ws + WS_Y1) + ((size_t)((uu) >> 9) * 128 + (((uu) >> 2) & 127)) * 2 * 64 * 512 + ((uu) & 3) * 128)
                int p = F.vcu, buf = 0;
                __syncthreads();
                if (p < 512) lm_dma_pair(F, P2_IN(2 * p), P2_IN(2 * p + 1), 512u, 0, lo0, lo1);
                for (; p < 512; p += F.G) {
                    asm volatile("s_waitcnt vmcnt(0)" ::: "memory"); __syncthreads();
                    bf16x8 pw[2][4]; lm_load_w(F, pw, T2);
                    if (p + F.G < 512) lm_dma_pair(F, P2_IN(2 * (p + F.G)), P2_IN(2 * (p + F.G) + 1), 512u, (buf ^ 1) * 65536, lo0, lo1);
                    const int u = 2 * p + (F.wave >> 2), b = u >> 9, k2 = (u >> 2) & 127, cb = u & 3;
                    EpiStore2 E{(bf16_t*)(F.ws + WS_FX) + ((size_t)b * SEQ + k2) * DM + cb * 128, 64, (size_t)128 * DM, (size_t)512};
                    lm_pair_compute(F, pw, buf * 65536, E);
                    buf ^= 1;
                }
#undef P2_IN
            }
            {
                const int np = (nrows / 128) * 2;
                const bf16_t* WSPl = (const bf16_t*)(F.ws + WS_WSP) + (size_t)l * 4 * 128 * 128;
#define SG_IN(uu) ((const bf16_t*)(F.ws + WS_VGN) + (size_t)((uu) >> 2) * 128 * 512 + ((uu) & 3) * 128)
                int p = F.vcu, buf = 0;
                __syncthreads();
                if (p < np) lm_dma_pair(F, SG_IN(2 * p), SG_IN(2 * p + 1), 512u, 0, lo0, lo1);
                for (; p < np; p += F.G) {
                    asm volatile("s_waitcnt vmcnt(0)" ::: "memory"); __syncthreads();
                    const int u = 2 * p + (F.wave >> 2), ch = u >> 2, g = u & 3; const size_t row0 = (size_t)ch * 128;
                    bf16x8 pw[2][4]; lm_load_w(F, pw, WSPl + (size_t)g * 128 * 128);
                    EpiSgu E{(bf16_t*)(F.ws + WS_SG) + row0 * DM + g * 128, (const bf16_t*)(F.ws + WS_PX) + row0 * PXW + U_OFF + g * 128, INP(I_BSPAT) + (size_t)l * 512 + g * 128};
                    u32x4 uw[8]; float ub[8]; E.pre((F.wave & 3) * 32, F.lane, uw, ub);
                    if (p + F.G < np) lm_dma_pair(F, SG_IN(2 * (p + F.G)), SG_IN(2 * (p + F.G) + 1), 512u, (buf ^ 1) * 65536, lo0, lo1);
                    {
                        const int pb = F.wave >> 2, rb = F.wave & 3;
                        const int vb0 = (int)(unsigned)(uintptr_t)F.lds + buf * 65536 + att::v_rd_base(F.lane) + pb * 32768;
                        f32x16 o[4] = {};
#pragma unroll
                        for (int t = 0; t < 2; ++t) att::pv_d0(o, vb0 + t * 16384, pw[t][0], pw[t][1], pw[t][2], pw[t][3]);
                        __syncthreads();
                        att::wave_rows_out_i(F.lds + buf * 65536 + F.wave * 8192, o, F.lane, [&](int i, int row, int col8, u32x4 v) { E.rows2(rb * 32 + row, col8, v, uw[i], ub[i]); });
                    }
                    buf ^= 1;
                }
#undef SG_IN
            }
            __syncthreads();
        }
        GRID_BAR();
        refresh(F);
        REP(64) if (PHM & 64) {
            const int nM = nrows / 256;
            SchedMerge S{(const char*)F.ws, (size_t)l * DM * DM * 2, F.G, bid, nM, nM * 4};
            EpiMerge E{(const bf16_t*)(F.ws + WS_GT), (bf16_t*)(F.ws + WS_MRG)};
            g8::gemm_phase<EpiMerge, SchedMerge, false, BF_SP2, true>(F.lds, S, E, F.tid);
            fill_after(F, FC, l, nM * 4, bid, 12);
        }
        GRID_BAR();
        refresh(F);
        for (int rep_ = 0; rep_ < (((DUP & 128) && l == 0) ? 2 : 1); ++rep_) {
            SchedPlain S{(const char*)(F.ws + WS_MRG), (const char*)((const bf16_t*)(F.ws + WS_WO) + (size_t)l * DM * DM), F.G, bid, nrows / 256, 4, 16};
            const float* XWc = (const float*)(F.ws + WS_XW);
            EpiOut E{l == 0 ? INP(I_X) : XWc, l == 0 ? INP(I_CTX) - (size_t)NXR * DM : XWc, (float*)(F.ws + WS_XW), (const float*)(F.ws + WS_MOD) + (size_t)l * 3 * 6144};
            g8::gemm_phase<EpiOut, SchedPlain, false, BF_SP2, true>(F.lds, S, E, F.tid);
            fill_after(F, FC, l, (nrows / 256) * 4, bid, 5);
        }
        GRID_BAR();
        refresh(F);
        if (DUP & 256) { p_route(F, l, nrows, 1); GRID_BAR(); refresh(F); }
        if (PHM & 256) p_route(F, l, nrows);
        refresh(F);
        fill_cleanup(F, FC, l);
        GRID_BAR();
        moe_tables(F, l);
        refresh(F);
        const LAS int* cum = (const LAS int*)(F.lds + LDS_X_OFF + 8192); const LAS int* texp = (const LAS int*)(F.lds + LDS_X_OFF + 8192 + 256);
        const int ntile = __builtin_amdgcn_readfirstlane(cum[NEXP]);
        int vup = bid, vdn = bid;
        if (F.G == 256) { const int x = bid & 7, r = bid >> 3; vup = (8 * (x >> 1) + (r >> 2)) * 8 + 4 * (x & 1) + (r & 3); vdn = (8 * x + (r >> 2)) * 4 + (r & 3); }
        refresh(F);
        REP(1024) if (PHM & 1024) {
            SchedMoe S{(const char*)(F.ws + WS_HXS), (const char*)(F.ws + WS_WGU) + (size_t)l * NEXP * 2048 * DM, (size_t)2048 * DM, F.G, vup, 8, ntile * 8, texp, cum, (size_t)CAPR};
            EpiUp E{(unsigned char*)(F.ws + WS_HID), INP(I_BGU) + (size_t)l * NEXP * 2048};
            g8::gemm_phase<EpiUp, SchedMoe, true, MOE_SP2, EPI_ALIGN>(F.lds, S, E, F.tid);
            if (!last) fill_after(F, FC, l + 1, ntile * 8, vup, 4);
        }
        GRID_BAR();
        refresh(F);
        REP(2048) if (PHM & 2048) {
            SchedMoe S{(const char*)(F.ws + WS_HID), (const char*)(F.ws + WS_WDN) + (size_t)l * NEXP * DM * DM, (size_t)DM * DM, F.G, vdn, 4, ntile * 4, texp, cum, (size_t)0};
            EpiDown E{(bf16_t*)(F.ws + WS_Y), INP(I_BDN) + (size_t)l * NEXP * DM, (const float*)(F.ws + WS_WSLOT), cum};
            g8::gemm_phase<EpiDown, SchedMoe, true, MOE_SP2, EPI_ALIGN>(F.lds, S, E, F.tid);
            if (!last) fill_after(F, FC, l + 1, ntile * 4, vdn, 2);
        }
        GRID_BAR();
        refresh(F);
        if (last) { REPB(4096, p_combine(F, l, nrows, last)); } else p_combine(F, l, nrows, last);
        GRID_BAR();
    }
}

extern "C" void kernel_launch(void* const* d_in, const int* in_sizes, int n_in, void* d_out, int out_size, void* d_ws, size_t ws_size, hipStream_t stream) {
    static int grid = 0;
    if (grid == 0) {
        if (n_in != 23 || out_size != NXR * DM || ws_size < WS_END) { fprintf(stderr, "kernel_launch: unexpected shapes: n_in %d out %d ws %zu (need %zu)\n", n_in, out_size, ws_size, (size_t)WS_END); grid = -1; return; }
        int dev = 0, cus = 0, per_cu = 0;
        if (hipGetDevice(&dev) != hipSuccess || hipDeviceGetAttribute(&cus, hipDeviceAttributeMultiprocessorCount, dev) != hipSuccess) { grid = -1; return; }
        if (hipFuncSetAttribute((const void*)mk_fwd, hipFuncAttributeMaxDynamicSharedMemorySize, LDS_BYTES) != hipSuccess) { fprintf(stderr, "kernel_launch: hipFuncSetAttribute failed\n"); grid = -1; return; }
        if (hipOccupancyMaxActiveBlocksPerMultiprocessor(&per_cu, (const void*)mk_fwd, 512, LDS_BYTES) != hipSuccess || per_cu < 1) { fprintf(stderr, "kernel_launch: occupancy query says %d\n", per_cu); (void)hipGetLastError(); }
        grid = cus;
    }
    if (grid < 0) return;
    if (hipMemsetAsync((char*)d_ws + WS_CTL, 0, CTL_ZERO_BYTES, stream) != hipSuccess) return;
    KArgs a{};
    for (int i = 0; i < 23; ++i) a.in[i] = (const float*)d_in[i];
    a.out = (float*)d_out; a.ws = (unsigned char*)d_ws;
    hipLaunchKernelGGL(mk_fwd, dim3(grid), dim3(512), LDS_BYTES, stream, a);
}
```
